# Optimizing an MI355X kernel written in HIP

```python
import math
import jax
import jax.numpy as jnp
from jax import lax
import numpy as np

D_MODEL = 2048
BATCH = 4
SEQ = 2048
DEPTH = 2

CTX_LEN = 256
GRID_W = 64

N_BRANCH = 4
BRANCH_WIDTH = D_MODEL // 2

ROPE_DIM = 64
ROPE_BASE = 10000.0

SSD_WIDTH = BRANCH_WIDTH
SSD_HEAD_DIM = 64
SSD_HEADS = SSD_WIDTH // SSD_HEAD_DIM
SSD_GROUPS = 2
SSD_STATE = 128
SSD_CHUNK = 128
SSD_CONV = 3
SSD_CONV_CH = SSD_WIDTH + 2 * SSD_GROUPS * SSD_STATE

MLA_HEADS = 8
MLA_NOPE = 128
MLA_ROPE = ROPE_DIM
MLA_V = 128
MLA_Q_LORA = 512
MLA_KV_LORA = 256
MLA_WIDTH = MLA_HEADS * MLA_V
Q_BLOCK = 128

GQA_HEADS = 16
GQA_KV_HEADS = 2
GQA_HEAD_DIM = ROPE_DIM
GQA_WIDTH = GQA_HEADS * GQA_HEAD_DIM
GQA_KV_WIDTH = GQA_KV_HEADS * GQA_HEAD_DIM
WINDOW = 128
WIN_BLOCK = 128

HY_WIDTH = BRANCH_WIDTH
HY_CONV = 3
HY_POS_EMB = 33
HY_BANDS = (HY_POS_EMB - 1) // 2
HY_FILTER_HIDDEN = 64
HY_FAST_DECAY = 0.3
HY_SLOW_DECAY = 1.5
HY_DECAY_TARGET = 0.01

LN_EPS = 1e-6
NEG_INF = -1e30
DEEPNORM_ALPHA = (2 * DEPTH) ** 0.25
DEEPNORM_BETA = (8 * DEPTH) ** -0.25

IN_SPLITS = (
    SSD_WIDTH,
    SSD_CONV_CH,
    2 * SSD_HEADS,
    MLA_Q_LORA,
    MLA_KV_LORA,
    MLA_ROPE,
    MLA_WIDTH,
    GQA_WIDTH,
    GQA_KV_WIDTH,
    GQA_KV_WIDTH,
    GQA_WIDTH,
    3 * HY_WIDTH,
    HY_WIDTH,
    N_BRANCH * D_MODEL,
)
IN_WIDTH = sum(IN_SPLITS)

kernel_name = 'hybrid_ssd_mla_swa_hyena_prefix_dit'


def _split_cols(t):
    out, start = [], 0
    for size in IN_SPLITS:
        out.append(t[..., start:start + size])
        start += size
    return out


def _layernorm(t):
    tf = t.astype(jnp.float32)
    mu = jnp.mean(tf, axis=-1, keepdims=True)
    var = jnp.mean(jnp.square(tf - mu), axis=-1, keepdims=True)
    return ((tf - mu) * lax.rsqrt(var + LN_EPS)).astype(t.dtype)


def _rmsnorm(t, w):
    tf = t.astype(jnp.float32)
    out = tf * lax.rsqrt(jnp.mean(jnp.square(tf), axis=-1, keepdims=True) + LN_EPS)
    return (out * w.astype(jnp.float32)).astype(t.dtype)


def _dwconv_centred(u, w, b):
    k = w.shape[0]
    y = lax.conv_general_dilated(u, w[:, None, :].astype(u.dtype), window_strides=(1,),
                                 padding=[(k // 2, k // 2)], dimension_numbers=('NWC', 'WIO', 'NWC'),
                                 feature_group_count=u.shape[-1])
    return y + b


def _axial_rope_tables(n_tok, rot_dim):
    rows = n_tok // GRID_W
    row = jnp.repeat(jnp.arange(rows, dtype=jnp.float32), GRID_W)
    col = jnp.tile(jnp.arange(GRID_W, dtype=jnp.float32), rows)
    n_freq = rot_dim // 4
    inv_freq = ROPE_BASE ** (-jnp.arange(n_freq, dtype=jnp.float32) / n_freq)
    ang = jnp.concatenate([row[:, None] * inv_freq[None, :], col[:, None] * inv_freq[None, :]], axis=-1)
    return jnp.cos(ang), jnp.sin(ang)


def _apply_rope(t, cos, sin):
    half = t.shape[-1] // 2
    shape = (t.shape[1],) + (1,) * (t.ndim - 3) + (half,)
    cos = cos.reshape(shape).astype(t.dtype)
    sin = sin.reshape(shape).astype(t.dtype)
    t1, t2 = t[..., :half], t[..., half:]
    return jnp.concatenate([t1 * cos - t2 * sin, t1 * sin + t2 * cos], axis=-1)


def _segsum(a):
    t = a.shape[-1]
    rep = jnp.broadcast_to(a[..., :, None], a.shape + (t,))
    rep = jnp.where(jnp.tril(jnp.ones((t, t), dtype=bool), -1), rep, 0.0)
    cs = jnp.cumsum(rep, axis=-2)
    return jnp.where(jnp.tril(jnp.ones((t, t), dtype=bool), 0), cs, -jnp.inf)


def _ssd_chunked(xs, dt, a, bm, cm, init_state, with_y):
    bsz, n, nh, hp = xs.shape
    nc = n // SSD_CHUNK
    rep = nh // bm.shape[2]
    bh = jnp.repeat(bm, rep, axis=2).reshape(bsz, nc, SSD_CHUNK, nh, -1)
    xd = (xs * dt[..., None]).reshape(bsz, nc, SSD_CHUNK, nh, hp)
    la = (dt * a).reshape(bsz, nc, SSD_CHUNK, nh).transpose(0, 3, 1, 2)
    la_cum = jnp.cumsum(la, axis=-1)
    decay_to_end = jnp.exp(la_cum[..., -1:] - la_cum)
    local = jnp.einsum('bclhn,bhcl,bclhp->bchpn', bh, decay_to_end, xd)
    states = jnp.concatenate([init_state[:, None], local], axis=1)
    chunk_decay = jnp.exp(_segsum(jnp.pad(la_cum[..., -1], ((0, 0), (0, 0), (1, 0)))))
    states = jnp.einsum('bhzc,bchpn->bzhpn', chunk_decay, states)
    final_state = states[:, -1]
    if not with_y:
        return None, final_state
    ch = jnp.repeat(cm, rep, axis=2).reshape(bsz, nc, SSD_CHUNK, nh, -1)
    scores = jnp.einsum('bclhn,bcshn->bhcls', ch, bh) * jnp.exp(_segsum(la))
    y_diag = jnp.einsum('bhcls,bcshp->bclhp', scores, xd)
    y_off = jnp.einsum('bclhn,bchpn,bhcl->bclhp', ch, states[:, :-1], jnp.exp(la_cum))
    return (y_diag + y_off).reshape(bsz, n, nh, hp), final_state


def _ssd_prep(xbc, dt_raw, conv_w, conv_b, dt_bias):
    bsz, n, _ = xbc.shape
    u = jax.nn.silu(_dwconv_centred(xbc, conv_w, conv_b)).astype(jnp.float32)
    gn = SSD_GROUPS * SSD_STATE
    xs = u[..., :SSD_WIDTH].reshape(bsz, n, SSD_HEADS, SSD_HEAD_DIM)
    bm = u[..., SSD_WIDTH:SSD_WIDTH + gn].reshape(bsz, n, SSD_GROUPS, SSD_STATE)
    cm = u[..., SSD_WIDTH + gn:].reshape(bsz, n, SSD_GROUPS, SSD_STATE)
    dt = jax.nn.softplus(dt_raw.astype(jnp.float32).reshape(bsz, n, 2, SSD_HEADS) + dt_bias.astype(jnp.float32))
    return xs, bm, cm, dt


def _ssd_bidir(xs, bm, cm, dt, a, init_f, init_b, with_y):
    y_f, s_f = _ssd_chunked(xs, dt[:, :, 0], a[0], bm, cm, init_f, with_y)
    flip = lambda t: jnp.flip(t, axis=1)
    y_b, s_b = _ssd_chunked(flip(xs), flip(dt[:, :, 1]), a[1], flip(bm), flip(cm), init_b, with_y)
    y = y_f + flip(y_b) if with_y else None
    return y, s_f, s_b


def _ssd_branch(xbc, dt_raw, xbc_c, dt_raw_c, conv_w, conv_b, dt_bias, a_log, d_skip, with_ctx_out):
    bsz = xbc.shape[0]
    a = -jnp.exp(a_log.astype(jnp.float32))
    d_skip = d_skip.astype(jnp.float32)[:, None]
    zero = jnp.zeros((bsz, SSD_HEADS, SSD_HEAD_DIM, SSD_STATE), jnp.float32)
    xs_c, bm_c, cm_c, dt_c = _ssd_prep(xbc_c, dt_raw_c, conv_w, conv_b, dt_bias)
    y_c, s_f, s_b = _ssd_bidir(xs_c, bm_c, cm_c, dt_c, a, zero, zero, with_ctx_out)
    xs, bm, cm, dt = _ssd_prep(xbc, dt_raw, conv_w, conv_b, dt_bias)
    y, _, _ = _ssd_bidir(xs, bm, cm, dt, a, s_f, s_b, True)
    y = (y + xs * d_skip).reshape(bsz, xbc.shape[1], SSD_WIDTH)
    if with_ctx_out:
        y_c = (y_c + xs_c * d_skip).reshape(bsz, xbc_c.shape[1], SSD_WIDTH)
    return y, y_c


def _mla_attend(qn, qp, kn, kp, v, scale):
    s = (jnp.einsum('bqhd,bkhd->bhqk', qn, kn) + jnp.einsum('bqhr,bkr->bhqk', qp, kp)).astype(jnp.float32) * scale
    p = jax.nn.softmax(s, axis=-1).astype(v.dtype)
    return jnp.einsum('bhqk,bkhd->bqhd', p, v)


def _sweep_query_blocks(fn, *qs):
    bsz, n = qs[0].shape[:2]
    nb = n // Q_BLOCK
    blocks = tuple(jnp.moveaxis(q.reshape((bsz, nb, Q_BLOCK) + q.shape[2:]), 1, 0) for q in qs)
    out = lax.map(lambda blk: fn(*blk), blocks)
    out = jnp.moveaxis(out, 0, 1)
    return out.reshape((bsz, n) + out.shape[3:])


def _mla_branch(cq, ckv, kpe, cq_c, ckv_c, kpe_c, q_norm, w_uq, kv_norm, w_ukv, cos, sin, with_ctx_out):
    bsz, n, _ = cq.shape
    n_c = ckv_c.shape[1]
    scale = (MLA_NOPE + MLA_ROPE) ** -0.5

    def up_q(t):
        q = (_rmsnorm(t, q_norm) @ w_uq).reshape(t.shape[0], t.shape[1], MLA_HEADS, MLA_NOPE + MLA_ROPE)
        return q[..., :MLA_NOPE], q[..., MLA_NOPE:]

    def up_kv(t):
        kv = (_rmsnorm(t, kv_norm) @ w_ukv).reshape(t.shape[0], t.shape[1], MLA_HEADS, MLA_NOPE + MLA_V)
        return kv[..., :MLA_NOPE], kv[..., MLA_NOPE:]

    kn_c, v_c = up_kv(ckv_c)
    qn, qp = up_q(cq)
    qp = _apply_rope(qp, cos, sin)
    kn, v = up_kv(ckv)
    kp = _apply_rope(kpe, cos, sin)
    kn_all = jnp.concatenate([kn_c, kn], axis=1)
    kp_all = jnp.concatenate([kpe_c, kp], axis=1)
    v_all = jnp.concatenate([v_c, v], axis=1)
    y = _sweep_query_blocks(lambda a, b: _mla_attend(a, b, kn_all, kp_all, v_all, scale), qn, qp)
    y = y.reshape(bsz, n, MLA_WIDTH)
    y_c = None
    if with_ctx_out:
        qn_c, qp_c = up_q(cq_c)
        y_c = _mla_attend(qn_c, qp_c, kn_c, kpe_c, v_c, scale).reshape(bsz, n_c, MLA_WIDTH)
    return y, y_c


def _gqa_branch(q, k, v, q_c, k_c, v_c, sink, cos, sin, with_ctx_out):
    bsz, n, _ = q.shape
    n_c = k_c.shape[1]
    g = GQA_HEADS // GQA_KV_HEADS
    scale = GQA_HEAD_DIM ** -0.5
    q = _apply_rope(q.reshape(bsz, n, GQA_KV_HEADS, g, GQA_HEAD_DIM), cos, sin)
    k = _apply_rope(k.reshape(bsz, n, GQA_KV_HEADS, GQA_HEAD_DIM), cos, sin)
    v = v.reshape(bsz, n, GQA_KV_HEADS, GQA_HEAD_DIM)
    k_c = k_c.reshape(bsz, n_c, GQA_KV_HEADS, GQA_HEAD_DIM)
    v_c = v_c.reshape(bsz, n_c, GQA_KV_HEADS, GQA_HEAD_DIM)
    sink = sink.astype(jnp.float32).reshape(GQA_KV_HEADS, g)

    nb = n // WIN_BLOCK
    nw = 3 * WIN_BLOCK
    qb = q.reshape(bsz, nb, WIN_BLOCK, GQA_KV_HEADS, g, GQA_HEAD_DIM)

    def neighbours(t):
        tp = jnp.pad(t.reshape(bsz, nb, WIN_BLOCK, GQA_KV_HEADS, GQA_HEAD_DIM),
                     ((0, 0), (1, 1), (0, 0), (0, 0), (0, 0)))
        return jnp.concatenate([tp[:, :-2], tp[:, 1:-1], tp[:, 2:]], axis=2)

    kw, vw = neighbours(k), neighbours(v)
    s_loc = jnp.einsum('bnqkgd,bnjkd->bnkgqj', qb, kw).astype(jnp.float32) * scale
    blk = jnp.arange(nb)[:, None]
    qpos = blk * WIN_BLOCK + jnp.arange(WIN_BLOCK)[None, :]
    kpos = (blk - 1) * WIN_BLOCK + jnp.arange(nw)[None, :]
    valid = ((jnp.abs(qpos[:, :, None] - kpos[:, None, :]) <= WINDOW)
             & (kpos[:, None, :] >= 0) & (kpos[:, None, :] < n))
    s_loc = jnp.where(valid[None, :, None, None], s_loc, NEG_INF)
    s_ctx = jnp.einsum('bnqkgd,bjkd->bnkgqj', qb, k_c).astype(jnp.float32) * scale
    s_sink = jnp.broadcast_to(sink[None, None, :, :, None, None], s_loc.shape[:-1] + (1,))
    p = jax.nn.softmax(jnp.concatenate([s_loc, s_ctx, s_sink], axis=-1), axis=-1).astype(v.dtype)
    y = (jnp.einsum('bnkgqj,bnjkd->bnqkgd', p[..., :nw], vw)
         + jnp.einsum('bnkgqj,bjkd->bnqkgd', p[..., nw:nw + n_c], v_c))
    y = y.reshape(bsz, n, GQA_WIDTH)

    y_c = None
    if with_ctx_out:
        qc = q_c.reshape(bsz, n_c, GQA_KV_HEADS, g, GQA_HEAD_DIM)
        s = jnp.einsum('bqkgd,bjkd->bkgqj', qc, k_c).astype(jnp.float32) * scale
        s_sink_c = jnp.broadcast_to(sink[None, :, :, None, None], s.shape[:-1] + (1,))
        pc = jax.nn.softmax(jnp.concatenate([s, s_sink_c], axis=-1), axis=-1).astype(v_c.dtype)
        y_c = jnp.einsum('bkgqj,bjkd->bqkgd', pc[..., :n_c], v_c).reshape(bsz, n_c, GQA_WIDTH)
    return y, y_c


def _hyena_filter(n, w1, b1, w2, b2, w3, freq):
    f32 = jnp.float32
    t = jnp.linspace(0.0, 1.0, n, dtype=f32)[:, None]
    w_ang = (2.0 * math.pi / n) * jnp.arange(n, dtype=f32)[:, None]
    bands = jnp.linspace(1e-4, HY_BANDS - 1, HY_BANDS, dtype=f32)[None, :]
    feats = jnp.concatenate([t, jnp.cos(bands * w_ang), -jnp.sin(bands * w_ang)], axis=-1)
    freq = freq.astype(f32)
    hdn = jnp.sin(freq[0] * (feats @ w1.astype(f32) + b1.astype(f32)))
    hdn = jnp.sin(freq[1] * (hdn @ w2.astype(f32) + b2.astype(f32)))
    h = hdn @ w3.astype(f32)
    deltas = jnp.abs(jnp.linspace(math.log(HY_DECAY_TARGET) / HY_FAST_DECAY,
                                  math.log(HY_DECAY_TARGET) / HY_SLOW_DECAY, HY_WIDTH, dtype=f32))
    h = h * jnp.exp(-t * jnp.tile(deltas, 2)[None, :])
    h_fwd, h_bwd = h[:, :HY_WIDTH], h[:, HY_WIDTH:]
    return jnp.concatenate([h_fwd, jnp.zeros((1, HY_WIDTH), f32), h_bwd[:0:-1]], axis=0)


def _bidir_fftconv(u, filt, d_skip):
    n = u.shape[1]
    uf = jnp.fft.rfft(u.astype(jnp.float32), n=2 * n, axis=1)
    kf = jnp.fft.rfft(filt, axis=0)
    y = jnp.fft.irfft(uf * kf[None], n=2 * n, axis=1)[:, :n]
    return (y + u.astype(jnp.float32) * d_skip.astype(jnp.float32)).astype(u.dtype)


def _hyena_seq(xv, conv_w, conv_b, w1, b1, w2, b2, w3, freq, d_skip):
    n = xv.shape[1]
    u = _dwconv_centred(xv, conv_w, conv_b)
    x0, x1, v = u[..., :HY_WIDTH], u[..., HY_WIDTH:2 * HY_WIDTH], u[..., 2 * HY_WIDTH:]
    filt = _hyena_filter(n, w1, b1, w2, b2, w3, freq)
    return x0 * _bidir_fftconv(x1 * v, filt, d_skip)


def _merge(res, gate, merge_logits, ys, zs, ssd_norm_w, w_branch, w_out, ln_g, ln_b):
    y_ssd, y_mla, y_gqa, y_hy = ys
    z_ssd, z_mla, z_gqa, z_hy = zs
    dt = res.dtype
    lead = y_ssd.shape[:2]
    ssd_g = (y_ssd * jax.nn.silu(z_ssd.astype(jnp.float32))).reshape(lead + (SSD_GROUPS, SSD_WIDTH // SSD_GROUPS))
    ssd_g = _rmsnorm(ssd_g, ssd_norm_w.reshape(SSD_GROUPS, -1)).reshape(lead + (SSD_WIDTH,)).astype(dt)
    gated = jnp.stack([ssd_g,
                       y_mla * jax.nn.silu(z_mla),
                       y_gqa * jax.nn.silu(z_gqa),
                       y_hy * jax.nn.silu(z_hy)], axis=2)
    branch = jnp.einsum('blkw,kwd->blkd', gated, w_branch)
    gates = jax.nn.sigmoid(merge_logits.reshape(merge_logits.shape[:-1] + (N_BRANCH, D_MODEL)))
    mixed = jnp.sum(gates * branch, axis=2) @ w_out
    return _layernorm(DEEPNORM_ALPHA * res + gate * mixed) * ln_g + ln_b


def _layer(x, ctx, c, c_ctx, w_ada, b_ada, w_in, ssd_conv_w, ssd_conv_b, ssd_dt_bias, ssd_a_log, ssd_d,
           ssd_norm_w, mla_q_norm, mla_w_uq, mla_kv_norm, mla_w_ukv, gqa_sink, hy_conv_w, hy_conv_b,
           hy_w1, hy_b1, hy_w2, hy_b2, hy_w3, hy_freq, hy_d, w_branch, w_out, ln_g, ln_b, cos, sin, with_ctx_out):
    mod = jax.nn.silu(c) @ w_ada + b_ada
    shift, scale, gate = jnp.split(mod[:, None, :], 3, axis=-1)
    mod_c = jax.nn.silu(c_ctx) @ w_ada + b_ada
    shift_c, scale_c, gate_c = jnp.split(mod_c, 3, axis=-1)
    h = _layernorm(x) * (1.0 + scale) + shift
    h_c = _layernorm(ctx) * (1.0 + scale_c) + shift_c
    (s_z, s_xbc, s_dt, m_cq, m_ckv, m_kpe, m_z, g_q, g_k, g_v, g_z, hy_xv, hy_z, merge) = _split_cols(h @ w_in)
    (s_z_c, s_xbc_c, s_dt_c, m_cq_c, m_ckv_c, m_kpe_c, m_z_c, g_q_c, g_k_c, g_v_c, g_z_c, hy_xv_c, hy_z_c,
     merge_c) = _split_cols(h_c @ w_in)

    y_ssd, y_ssd_c = _ssd_branch(s_xbc, s_dt, s_xbc_c, s_dt_c, ssd_conv_w, ssd_conv_b, ssd_dt_bias, ssd_a_log,
                                 ssd_d, with_ctx_out)
    y_mla, y_mla_c = _mla_branch(m_cq, m_ckv, m_kpe, m_cq_c, m_ckv_c, m_kpe_c, mla_q_norm, mla_w_uq,
                                 mla_kv_norm, mla_w_ukv, cos, sin, with_ctx_out)
    y_gqa, y_gqa_c = _gqa_branch(g_q, g_k, g_v, g_q_c, g_k_c, g_v_c, gqa_sink, cos, sin, with_ctx_out)
    y_hy = _hyena_seq(hy_xv, hy_conv_w, hy_conv_b, hy_w1, hy_b1, hy_w2, hy_b2, hy_w3, hy_freq, hy_d)
    x_new = _merge(x, gate, merge, (y_ssd, y_mla, y_gqa, y_hy), (s_z, m_z, g_z, hy_z),
                   ssd_norm_w, w_branch, w_out, ln_g, ln_b)
    if not with_ctx_out:
        return x_new, None
    y_hy_c = _hyena_seq(hy_xv_c, hy_conv_w, hy_conv_b, hy_w1, hy_b1, hy_w2, hy_b2, hy_w3, hy_freq, hy_d)
    ctx_new = _merge(ctx, gate_c, merge_c, (y_ssd_c, y_mla_c, y_gqa_c, y_hy_c), (s_z_c, m_z_c, g_z_c, hy_z_c),
                     ssd_norm_w, w_branch, w_out, ln_g, ln_b)
    return x_new, ctx_new


def setup_inputs(seed: int = 0) -> dict:
    key = jax.random.key(seed)
    ks = iter(jax.random.split(key, 64))
    f32 = jnp.float32
    d = D_MODEL
    L = DEPTH

    def nrm(shape, scale):
        return jax.random.normal(next(ks), shape, f32) * scale

    u_dt = jax.random.uniform(next(ks), (L, 2, SSD_HEADS), f32)
    dt0 = jnp.exp(u_dt * (math.log(0.1) - math.log(0.001)) + math.log(0.001))
    ssd_dt_bias = dt0 + jnp.log(-jnp.expm1(-dt0))
    ssd_a_log = jnp.log(jax.random.uniform(next(ks), (L, 2, SSD_HEADS), f32, 1.0, 16.0))
    return {
        'x': nrm((BATCH, SEQ, d), 1.0),
        'c': nrm((BATCH, d), 1.0),
        'ctx': nrm((BATCH, CTX_LEN, d), 1.0),
        'c_ctx': nrm((d,), 1.0),
        'w_ada': nrm((L, d, 3 * d), d ** -0.5),
        'b_ada': nrm((L, 3 * d), 0.02),
        'w_in': nrm((L, d, IN_WIDTH), d ** -0.5),
        'ssd_conv_w': nrm((L, SSD_CONV, SSD_CONV_CH), SSD_CONV ** -0.5),
        'ssd_conv_b': nrm((L, SSD_CONV_CH), 0.02),
        'ssd_dt_bias': ssd_dt_bias,
        'ssd_a_log': ssd_a_log,
        'ssd_d': 1.0 + nrm((L, SSD_HEADS), 0.1),
        'ssd_norm_w': 1.0 + nrm((L, SSD_WIDTH), 0.02),
        'mla_q_norm': 1.0 + nrm((L, MLA_Q_LORA), 0.02),
        'mla_w_uq': nrm((L, MLA_Q_LORA, MLA_HEADS * (MLA_NOPE + MLA_ROPE)), MLA_Q_LORA ** -0.5),
        'mla_kv_norm': 1.0 + nrm((L, MLA_KV_LORA), 0.02),
        'mla_w_ukv': nrm((L, MLA_KV_LORA, MLA_HEADS * (MLA_NOPE + MLA_V)), MLA_KV_LORA ** -0.5),
        'gqa_sink': nrm((L, GQA_HEADS), 0.5),
        'hy_conv_w': nrm((L, HY_CONV, 3 * HY_WIDTH), HY_CONV ** -0.5),
        'hy_conv_b': nrm((L, 3 * HY_WIDTH), 0.02),
        'hy_w1': nrm((L, HY_POS_EMB, HY_FILTER_HIDDEN), HY_POS_EMB ** -0.5),
        'hy_b1': nrm((L, HY_FILTER_HIDDEN), 0.1),
        'hy_w2': nrm((L, HY_FILTER_HIDDEN, HY_FILTER_HIDDEN), HY_FILTER_HIDDEN ** -0.5),
        'hy_b2': nrm((L, HY_FILTER_HIDDEN), 0.1),
        'hy_w3': nrm((L, HY_FILTER_HIDDEN, 2 * HY_WIDTH), 0.1 * HY_FILTER_HIDDEN ** -0.5),
        'hy_freq': 1.0 + nrm((L, 2, HY_FILTER_HIDDEN), 0.1),
        'hy_d': nrm((L, HY_WIDTH), 0.5),
        'w_branch': nrm((L, N_BRANCH, BRANCH_WIDTH, d), DEEPNORM_BETA * BRANCH_WIDTH ** -0.5),
        'w_out': nrm((L, d, d), DEEPNORM_BETA * d ** -0.5),
        'ln_g': 1.0 + nrm((L, d), 0.02),
        'ln_b': nrm((L, d), 0.02),
    }


def reference(x, c, ctx, c_ctx, w_ada, b_ada, w_in, ssd_conv_w, ssd_conv_b, ssd_dt_bias, ssd_a_log, ssd_d,
              ssd_norm_w, mla_q_norm, mla_w_uq, mla_kv_norm, mla_w_ukv, gqa_sink, hy_conv_w, hy_conv_b,
              hy_w1, hy_b1, hy_w2, hy_b2, hy_w3, hy_freq, hy_d, w_branch, w_out, ln_g, ln_b):
    n_lat = x.shape[1]
    cos, sin = _axial_rope_tables(n_lat, ROPE_DIM)
    for i in range(DEPTH):
        x, ctx = _layer(x, ctx, c, c_ctx, w_ada[i], b_ada[i], w_in[i], ssd_conv_w[i], ssd_conv_b[i],
                        ssd_dt_bias[i], ssd_a_log[i], ssd_d[i], ssd_norm_w[i], mla_q_norm[i], mla_w_uq[i],
                        mla_kv_norm[i], mla_w_ukv[i], gqa_sink[i], hy_conv_w[i], hy_conv_b[i], hy_w1[i],
                        hy_b1[i], hy_w2[i], hy_b2[i], hy_w3[i], hy_freq[i], hy_d[i], w_branch[i], w_out[i],
                        ln_g[i], ln_b[i], cos, sin, i < DEPTH - 1)
    return x
```

```cpp
#include <hip/hip_runtime.h>
#include <cstdio>
#include <cstdint>
#include <cmath>

constexpr int DM = 2048, NB = 4, SEQ = 2048, CTXL = 256, DEPTH = 2;
constexpr int NLAT = NB * SEQ;
constexpr int NCTX = NB * CTXL;
constexpr int MROWS = NLAT + NCTX;
constexpr int INW = 19040;
constexpr int NPAD = 11008;
constexpr int NGATE = 8192;
constexpr int NTOT = NPAD + NGATE;
constexpr int NPT = NPAD / 256;
constexpr int C_SZ = 0, C_XBC = 1024, C_DT = 2560, C_CQ = 2592, C_CKV = 3104, C_KPE = 3360, C_MZ = 3424, C_GQ = 4448,
              C_GK = 5472, C_GV = 5600, C_GZ = 5728, C_HXV = 6752, C_HZ = 9824, C_MERGE = 10848;
constexpr float LN_EPS = 1e-6f;
constexpr float DN_ALPHA = 1.4142135623730951f;

enum { I_X = 0, I_C, I_CTX, I_CCTX, I_WADA, I_BADA, I_WIN, I_SCW, I_SCB, I_SDTB, I_SALOG, I_SD, I_SNW, I_MQN, I_MWUQ, I_MKVN, I_MWUKV,
       I_GSINK, I_HCW, I_HCB, I_HW1, I_HB1, I_HW2, I_HB2, I_HW3, I_HFREQ, I_HD, I_WBR, I_WOUT, I_LNG, I_LNB, N_IN };

constexpr size_t al256(size_t x) { return (x + 255) & ~(size_t)255; }
constexpr size_t WS_CTL = 0, CTL_BYTES = 1u << 20;
constexpr size_t WS_WTIN = CTL_BYTES;
constexpr size_t WS_WTUQ = WS_WTIN + (size_t)2 * NTOT * DM * 2;
constexpr size_t WS_WTUKV = WS_WTUQ + (size_t)2 * 1536 * 512 * 2;
constexpr size_t WS_WTBR = WS_WTUKV + (size_t)2 * 2048 * 256 * 2;
constexpr size_t WS_WTOUT = WS_WTBR + (size_t)2 * 4 * 2048 * 1024 * 2;
constexpr size_t WS_MOD = WS_WTOUT + (size_t)2 * 2048 * 2048 * 2;
constexpr size_t WS_ROPE = al256(WS_MOD + (size_t)2 * 5 * 6144 * 4);
constexpr size_t WS_HF = al256(WS_ROPE + (size_t)2 * 2048 * 32 * 4);
constexpr size_t HF_LAT = (size_t)4096 * 1024 * 2, HF_CTX = (size_t)512 * 1024 * 2, HF_LAYER = HF_LAT + HF_CTX;
constexpr size_t WS_H = al256(WS_HF + 2 * HF_LAYER);
constexpr size_t WS_P = WS_H + (size_t)MROWS * DM * 2;
constexpr size_t WS_G = WS_P + (size_t)MROWS * NPAD * 2;
constexpr size_t WS_RS = WS_G + (size_t)MROWS * NGATE * 2;
constexpr size_t WS_QM = al256(WS_RS + (size_t)2 * MROWS * 4);
constexpr size_t WS_KVM = WS_QM + (size_t)MROWS * 1536 * 2;
constexpr size_t WS_GATED = WS_KVM + (size_t)MROWS * 2048 * 2;
constexpr size_t WS_MIX = WS_GATED + (size_t)4 * MROWS * 1024 * 2;
constexpr size_t WS_Y = WS_MIX + (size_t)MROWS * DM * 2;
constexpr size_t WS_X1 = WS_Y + (size_t)MROWS * DM * 4;
constexpr size_t WS_SA = WS_X1 + (size_t)MROWS * DM * 4;
constexpr size_t SA_BYTES = (size_t)MROWS * 2048 * 4;
constexpr size_t WS_SB = WS_SA + SA_BYTES;
constexpr size_t WS_SC = WS_SB + SA_BYTES;
constexpr size_t SC_BYTES = (size_t)MROWS * 1024 * 4;
constexpr size_t WS_END = WS_SC + SC_BYTES;

#define GAS __attribute__((address_space(1)))
#define LAS __attribute__((address_space(3)))
typedef _Float16 f16;
typedef _Float16 f16x2 __attribute__((ext_vector_type(2)));
typedef _Float16 f16x4 __attribute__((ext_vector_type(4)));
typedef _Float16 f16x8 __attribute__((ext_vector_type(8)));
typedef float f32x2 __attribute__((ext_vector_type(2)));
typedef float f32x4 __attribute__((ext_vector_type(4)));
typedef float f32x16 __attribute__((ext_vector_type(16)));
typedef unsigned u32x2 __attribute__((ext_vector_type(2)));
typedef unsigned u32x4 __attribute__((ext_vector_type(4)));
typedef GAS unsigned gu32;
#define RLX_AGENT __ATOMIC_RELAXED, __HIP_MEMORY_SCOPE_AGENT
#define LDS_WAIT() asm volatile("s_waitcnt lgkmcnt(0)" ::: "memory")
#define VM_WAIT() asm volatile("s_waitcnt vmcnt(0)" ::: "memory")

__device__ __forceinline__ unsigned pkh(float lo, float hi) { f16x2 v = {(f16)lo, (f16)hi}; return __builtin_bit_cast(unsigned, v); }
__device__ __forceinline__ u32x4 pkh8(f32x4 a, f32x4 b) { u32x4 w; w.x = pkh(a[0], a[1]); w.y = pkh(a[2], a[3]); w.z = pkh(b[0], b[1]); w.w = pkh(b[2], b[3]); return w; }
__device__ __forceinline__ float fast_exp(float x) { return __builtin_amdgcn_exp2f(x * 1.4426950408889634f); }
__device__ __forceinline__ float sigmoidf_(float x) { return __builtin_amdgcn_rcpf(1.0f + fast_exp(-x)); }
__device__ __forceinline__ float siluf_(float x) { return x * sigmoidf_(x); }
__device__ __forceinline__ float softplusf_(float x) { return x > 20.f ? x : log1pf(expf(x)); }
__device__ __forceinline__ float wave_sum(float v) {
#pragma unroll
    for (int o = 1; o < 64; o <<= 1) v += __shfl_xor(v, o);
    return v;
}

namespace pg8 {
constexpr int BM = 256, BK = 64, HALF = 128, HTB = HALF * BK * 2, STAGE_BYTES = 8 * HTB, NXCD = 8, WGM = 8;
__host__ __device__ __forceinline__ int lds_byte(int r, int c) { const int st = (r >> 4) * 2 + (c >> 5), rr = r & 15, cc = c & 31, ob = rr * 64 + cc * 2; return st * 1024 + (ob ^ (((ob >> 9) & 1) << 5)); }
__host__ __device__ __forceinline__ void stage_rc(int b, int& R, int& C) { const int st = b / 1024, sb = b % 1024, swz = sb ^ (((sb >> 9) & 1) << 5); R = (st >> 1) * 16 + swz / 64; C = (st & 1) * 32 + (swz % 64) / 2; }
__host__ __device__ __forceinline__ int perm32(int rho) { const int n = rho >> 4, i = rho & 15; return 8 * (i >> 2) + 4 * n + (i & 3); }

struct Unit { int pm, pn, kz; };
struct Gemm { const f16* A; const f16* Bt; int M, N, K, lda, ldb, nz; size_t azs, bzs; };

struct StaticOrder {
    int nM, nN, nwg, G, c, nz;
    __device__ void init(int M, int N, int nz_, int G_, int c_) { nM = M / BM; nN = N / BM; nwg = nM * nN; G = G_; c = c_; nz = nz_; }
    __device__ bool next(int i, Unit& u) const {
        const int j = i / nz; u.kz = i - j * nz;
        const long L = (long)j * G + c; if (L >= nwg) return false;
        int wgid = (int)L; { const int q = nwg / NXCD, r = nwg % NXCD, xcd = wgid % NXCD, off = wgid / NXCD; wgid = (xcd < r ? xcd * (q + 1) : r * (q + 1) + (xcd - r) * q) + off; }
        const int nig = WGM * nN, gid = wgid / nig, fm = gid * WGM, gsz = (nM - fm) < WGM ? (nM - fm) : WGM;
        u.pm = fm + ((wgid % nig) % gsz); u.pn = (wgid % nig) / gsz; return true;
    }
};

template <class Epi>
__device__ __forceinline__ void gemm_phase(LAS unsigned char* lds, const Gemm g, const StaticOrder& S, const Epi& E) {
    int tid_ = threadIdx.x; asm volatile("" : "+v"(tid_));
    const int tid = tid_, wid = __builtin_amdgcn_readfirstlane(tid >> 6), lane = tid & 63, wr = wid >> 2, wc = wid & 3, fr = lane & 15, fq = lane >> 4;
    const int K = g.K, nt = K / BK;
    unsigned voffA[2], voffB[2];
#pragma unroll
    for (int i = 0; i < 2; ++i) { int R, C; stage_rc(tid * 16 + i * 8192, R, C); const int Rb = Epi::PERM ? ((R & ~31) + perm32(R & 31)) : R;
        voffA[i] = (unsigned)(R * g.lda + C) * 2u; voffB[i] = (unsigned)(Rb * g.ldb + C) * 2u; }
    const size_t kstep = (size_t)(BK * 2);
    const size_t hstepA = (size_t)HALF * g.lda * 2, hstepB = (size_t)HALF * g.ldb * 2;
    const size_t tstepA = 2 * hstepA, tstepB = 2 * hstepB;
    const unsigned ldsw = (unsigned)wid * 1024u;
    const int aoff = lds_byte(wr * 64 + fr, fq * 8), boff = lds_byte(wc * 32 + fr, fq * 8);
#define PG8_SA(b, h) (((b) * 2 + (h)) * HTB)
#define PG8_SB(b, h) ((4 + (b) * 2 + (h)) * HTB)
#define PG8_STAGE(bufoff, gbase, voff) do { _Pragma("unroll") for (int _i = 0; _i < 2; ++_i) \
        __builtin_amdgcn_global_load_lds((const unsigned*)((const char*)(gbase) + (voff)[_i]), (LAS unsigned*)(lds + (bufoff) + ldsw + _i * 8192), 16, 0, 0); } while (0)
#define PG8_LDA(dst, b, h) do { _Pragma("unroll") for (int m = 0; m < 4; ++m) _Pragma("unroll") for (int k = 0; k < 2; ++k) dst[m][k] = *(const LAS f16x8*)(lds + PG8_SA(b, h) + aoff + m * 2048 + k * 1024); } while (0)
#define PG8_LDB(dst, b, h) do { _Pragma("unroll") for (int n = 0; n < 2; ++n) _Pragma("unroll") for (int k = 0; k < 2; ++k) dst[n][k] = *(const LAS f16x8*)(lds + PG8_SB(b, h) + boff + n * 2048 + k * 1024); } while (0)
#define PG8_MMA(ai, bj, At, Bt) do { __builtin_amdgcn_s_setprio(1); _Pragma("unroll") for (int m = 0; m < 4; ++m) _Pragma("unroll") for (int n = 0; n < 2; ++n) _Pragma("unroll") for (int k = 0; k < 2; ++k) \
        acc[ai][bj][m][n] = __builtin_amdgcn_mfma_f32_16x16x32_f16(Bt[n][k], At[m][k], acc[ai][bj][m][n], 0, 0, 0); __builtin_amdgcn_s_setprio(0); } while (0)
#define PG8_WAIT_V(n) asm volatile("s_waitcnt vmcnt(" #n ")" ::: "memory")
#define PG8_WAIT_L(n) asm volatile("s_waitcnt lgkmcnt(" #n ")" ::: "memory")
#define PG8_BAR __builtin_amdgcn_s_barrier()
#define PG8_SCHED __builtin_amdgcn_sched_barrier(0)
    Unit cur, nxt; int ui = 0;
    if (!S.next(0, cur)) return;
    f32x4 acc[2][2][4][2];
#pragma unroll
    for (int a = 0; a < 2; ++a)
#pragma unroll
        for (int b = 0; b < 2; ++b)
#pragma unroll
            for (int m = 0; m < 4; ++m)
#pragma unroll
                for (int n = 0; n < 2; ++n) acc[a][b][m][n] = (f32x4){0.f, 0.f, 0.f, 0.f};
    f16x8 At[4][2], B0[2][2], B1[2][2];
    const char* cA = (const char*)(g.A + (size_t)cur.kz * g.azs) + (size_t)cur.pm * tstepA;
    const char* cB = (const char*)(g.Bt + (size_t)cur.kz * g.bzs) + (size_t)cur.pn * tstepB;
    PG8_STAGE(PG8_SB(0, 0), cB, voffB); PG8_STAGE(PG8_SB(0, 1), cB + hstepB, voffB); PG8_STAGE(PG8_SA(0, 0), cA, voffA); PG8_STAGE(PG8_SA(0, 1), cA + hstepA, voffA);
    if (wr == 1) PG8_BAR;
    PG8_WAIT_V(2); PG8_BAR;
    PG8_STAGE(PG8_SB(1, 0), cB + kstep, voffB); PG8_STAGE(PG8_SA(1, 0), cA + kstep, voffA); PG8_STAGE(PG8_SB(1, 1), cB + hstepB + kstep, voffB);
    PG8_WAIT_V(6); PG8_BAR;
    for (;;) {
        const bool has_next = S.next(ui + 1, nxt);
        const char* nA = has_next ? (const char*)(g.A + (size_t)nxt.kz * g.azs) + (size_t)nxt.pm * tstepA : cA;
        const char* nB = has_next ? (const char*)(g.Bt + (size_t)nxt.kz * g.bzs) + (size_t)nxt.pn * tstepB : cB;
        for (int t = 0; t < nt; t += 2) {
            const bool last = (t == nt - 2);
            const char* a1 = cA + (size_t)(t + 1) * kstep;
            const char* a2 = last ? nA : cA + (size_t)(t + 2) * kstep; const char* b2 = last ? nB : cB + (size_t)(t + 2) * kstep;
            const char* a3 = a2 + kstep; const char* b3 = b2 + kstep;
            PG8_LDB(B0, 0, 0); PG8_LDB(B1, 0, 1); PG8_SCHED; PG8_LDA(At, 0, 0); PG8_STAGE(PG8_SA(1, 1), a1 + hstepA, voffA);
            PG8_WAIT_V(8); PG8_WAIT_L(0); PG8_BAR; PG8_MMA(0, 0, At, B0); PG8_MMA(0, 1, At, B1); PG8_BAR; PG8_SCHED;
            PG8_LDA(At, 0, 1); PG8_STAGE(PG8_SB(0, 0), b2, voffB); PG8_STAGE(PG8_SB(0, 1), b2 + hstepB, voffB); PG8_STAGE(PG8_SA(0, 0), a2, voffA);
            PG8_WAIT_V(8); PG8_WAIT_L(0); PG8_BAR; PG8_MMA(1, 0, At, B0); PG8_MMA(1, 1, At, B1); PG8_BAR; PG8_SCHED;
            PG8_LDB(B0, 1, 0); PG8_LDB(B1, 1, 1); PG8_SCHED; PG8_LDA(At, 1, 0); PG8_STAGE(PG8_SA(0, 1), a2 + hstepA, voffA);
            PG8_WAIT_V(8); PG8_WAIT_L(0); PG8_BAR; PG8_MMA(0, 0, At, B0); PG8_MMA(0, 1, At, B1); PG8_BAR; PG8_SCHED;
            PG8_LDA(At, 1, 1); PG8_STAGE(PG8_SB(1, 0), b3, voffB); PG8_STAGE(PG8_SB(1, 1), b3 + hstepB, voffB); PG8_STAGE(PG8_SA(1, 0), a3, voffA);
            PG8_WAIT_V(8); PG8_WAIT_L(0); PG8_BAR; PG8_MMA(1, 0, At, B0); PG8_MMA(1, 1, At, B1); PG8_BAR; PG8_SCHED;
        }
        if (wr == 0) PG8_BAR;
        E(acc, cur, wr, wc, fr, fq);
        if (!has_next) break;
#pragma unroll
        for (int a = 0; a < 2; ++a)
#pragma unroll
            for (int b = 0; b < 2; ++b)
#pragma unroll
                for (int m = 0; m < 4; ++m)
#pragma unroll
                    for (int n = 0; n < 2; ++n) acc[a][b][m][n] = (f32x4){0.f, 0.f, 0.f, 0.f};
        cur = nxt; cA = nA; cB = nB; ++ui;
        if (wr == 1) PG8_BAR;
    }
    PG8_WAIT_V(0);
    PG8_BAR;
#undef PG8_SA
#undef PG8_SB
#undef PG8_STAGE
#undef PG8_LDA
#undef PG8_LDB
#undef PG8_MMA
#undef PG8_WAIT_V
#undef PG8_WAIT_L
#undef PG8_BAR
#undef PG8_SCHED
}
}

constexpr int RING_BYTES = 131072;
constexpr int LDSCTL_OFF = RING_BYTES, MISC_OFF = LDSCTL_OFF + 320;
constexpr int LDS_BYTES = 147456;
constexpr int NWAVES = 8, NTHREADS = 512;

#define XB_TMO      128
#define XB_XCNT(j)  (256  + 64 * (j))
#define XB_XSUB(j)  (1280 + 64 * (j))
#define XB_XGEN(j)  (2304 + 64 * (j))
#define XB_TOP      3328
#define XB_TOPGEN   3392
#define XCD_BAR_WORDS 3456
#define XB_SPIN_CAP (1u << 24)
__device__ __forceinline__ unsigned xb_ld(unsigned* p)              { return __hip_atomic_load(p, __ATOMIC_RELAXED, __HIP_MEMORY_SCOPE_AGENT); }
__device__ __forceinline__ unsigned xb_add(unsigned* p, unsigned v) { return __hip_atomic_fetch_add(p, v, __ATOMIC_RELAXED, __HIP_MEMORY_SCOPE_AGENT); }
__device__ __forceinline__ unsigned xb_xcc_id() { return (unsigned)__builtin_amdgcn_s_getreg((3 << 11) | 20) & 0xFu; }
#define XB_SPIN(cond, bar) do { unsigned _sp = 0; while (cond) { __builtin_amdgcn_s_sleep(1); \
    if ((++_sp & 255u) == 0u) { if (xb_ld(&(bar)[XB_TMO])) break; if (_sp > XB_SPIN_CAP) { atomicAdd(&(bar)[XB_TMO], 1u); break; } } } } while (0)
struct XcdBarrier { unsigned* bar; unsigned x; volatile LAS unsigned* st; };
__device__ __forceinline__ XcdBarrier xcd_barrier_post(unsigned* bar, volatile LAS unsigned* st) {
    XcdBarrier b; b.bar = bar; b.x = xb_xcc_id(); b.st = st;
    if (threadIdx.x == 0) (void)xb_add(&bar[XB_XCNT(b.x)], 1u);
    return b;
}
__device__ __forceinline__ void xcd_barrier_complete(unsigned* bar, unsigned x, unsigned& nloc, unsigned& nx) {
    const unsigned G = gridDim.x * gridDim.y * gridDim.z;
    unsigned sum, cnt, mine, sp = 0u;
    for (;;) {
        sum = 0u; cnt = 0u; mine = 0u;
#pragma unroll
        for (unsigned j = 0; j < 16; ++j) { const unsigned c = xb_ld(&bar[XB_XCNT(j)]); sum += c; cnt += (c > 0u) ? 1u : 0u; mine = (j == x) ? c : mine; }
        if (sum == G) break;
        __builtin_amdgcn_s_sleep(1);
        if ((++sp & 255u) == 0u) { if (xb_ld(&bar[XB_TMO])) break; if (sp > XB_SPIN_CAP) { atomicAdd(&bar[XB_TMO], 1u); break; } }
    }
    nloc = mine > 0u ? mine : 1u; nx = cnt > 0u ? cnt : 1u;
}
__device__ __forceinline__ void xcd_barrier(const XcdBarrier& b) {
    asm volatile("s_waitcnt vmcnt(0)" ::: "memory");
    __syncthreads();
    if (threadIdx.x == 0) {
        unsigned* bar = b.bar;
        __builtin_amdgcn_s_waitcnt(0);
        unsigned nloc = b.st[0], nx = b.st[1];
        if (nloc == 0u) { xcd_barrier_complete(bar, b.x, nloc, nx); b.st[0] = nloc; b.st[1] = nx; }
        const unsigned old = xb_add(&bar[XB_XSUB(b.x)], 1u);
        const unsigned gen = old / nloc;
        if (old + 1u == (gen + 1u) * nloc) {
            __builtin_amdgcn_fence(__ATOMIC_RELEASE, "agent");
            asm volatile("s_waitcnt vmcnt(0)" ::: "memory");
            const unsigned og = xb_add(&bar[XB_TOP], 1u);
            const unsigned tg = og / nx;
            if (og + 1u == (tg + 1u) * nx) xb_add(&bar[XB_TOPGEN], 1u);
            else XB_SPIN(xb_ld(&bar[XB_TOPGEN]) == tg, bar);
            __builtin_amdgcn_fence(__ATOMIC_ACQUIRE, "agent");
            xb_add(&bar[XB_XGEN(b.x)], 1u);
            asm volatile("s_waitcnt vmcnt(0)" ::: "memory");
        } else {
            XB_SPIN(xb_ld(&bar[XB_XGEN(b.x)]) == gen, bar);
            __builtin_amdgcn_fence(__ATOMIC_ACQUIRE, "agent");
            asm volatile("s_waitcnt vmcnt(0)" ::: "memory");
        }
    }
    __syncthreads();
}

struct Args { const float* in[N_IN]; float* out; unsigned char* ws; int ph_lo, ph_hi; };
struct Frame {
    LAS unsigned char* lds;
    unsigned char* ws;
    const float* const* in;
    float* out;
    int tid, lane, wave, G, gw, NGW;
};
#define WSP(T, off) ((T*)(F.ws + (off)))
#define INP(i, l, per) (F.in[i] + (size_t)(l) * (per))

__device__ __forceinline__ void transpose_item(const float* W, int K, int N, f16* WT, int k0, int n0, int drow0, const float* kscale, LAS float* scr, int lane) {
#pragma unroll 8
    for (int i = 0; i < 32; ++i) { const int kk = 2 * i + (lane >> 5); float v = W[(size_t)(k0 + kk) * N + n0 + (lane & 31)]; if (kscale) v *= kscale[k0 + kk]; scr[kk * 33 + (lane & 31)] = v; }
    LDS_WAIT(); asm volatile("" ::: "memory");
    const int c = lane & 7;
#pragma unroll
    for (int j = 0; j < 4; ++j) { const int n = (lane >> 3) + 8 * j; const LAS float* s = scr + (8 * c) * 33 + n;
        u32x4 o; o.x = pkh(s[0 * 33], s[1 * 33]); o.y = pkh(s[2 * 33], s[3 * 33]); o.z = pkh(s[4 * 33], s[5 * 33]); o.w = pkh(s[6 * 33], s[7 * 33]);
        *(u32x4*)(WT + (size_t)(drow0 + n) * K + k0 + 8 * c) = o; }
    LDS_WAIT(); asm volatile("" ::: "memory");
}

__device__ __forceinline__ void prologue_a(Frame& F) {
    LAS float* scr = (LAS float*)(F.lds + F.wave * 16384);
    const int lane = F.lane;
    constexpr int IT_IN = 32 * 595, IT_BR = 16 * 64, IT_OUT = 32 * 64, IT_UQ = 8 * 48, IT_UKV = 4 * 64;
    constexpr int IT_LAYER = IT_IN + 4 * IT_BR + IT_OUT + IT_UQ + IT_UKV;
    for (int it = F.gw; it < 2 * IT_LAYER; it += F.NGW) {
        const int l = it / IT_LAYER; int r = it % IT_LAYER;
        if (r < IT_IN) { const int kb = r / 595, nb = r % 595, n0 = nb * 32;
            transpose_item(INP(I_WIN, l, (size_t)DM * INW), DM, INW, WSP(f16, WS_WTIN) + (size_t)l * NTOT * DM, kb * 64, n0, n0 < C_MERGE ? n0 : n0 + (NPAD - C_MERGE), nullptr, scr, lane); continue; }
        r -= IT_IN;
        if (r < 4 * IT_BR) { const int kz = r / IT_BR, q = r % IT_BR, kb = q / 64, nb = q % 64;
            transpose_item(INP(I_WBR, l, (size_t)4 * 1024 * DM) + (size_t)kz * 1024 * DM, 1024, DM, WSP(f16, WS_WTBR) + ((size_t)l * 4 + kz) * DM * 1024, kb * 64, nb * 32, nb * 32,
                           kz == 0 ? INP(I_SNW, l, 1024) : nullptr, scr, lane); continue; }
        r -= 4 * IT_BR;
        if (r < IT_OUT) { const int kb = r / 64, nb = r % 64;
            transpose_item(INP(I_WOUT, l, (size_t)DM * DM), DM, DM, WSP(f16, WS_WTOUT) + (size_t)l * DM * DM, kb * 64, nb * 32, nb * 32, nullptr, scr, lane); continue; }
        r -= IT_OUT;
        if (r < IT_UQ) { const int kb = r / 48, nb = r % 48;
            transpose_item(INP(I_MWUQ, l, (size_t)512 * 1536), 512, 1536, WSP(f16, WS_WTUQ) + (size_t)l * 1536 * 512, kb * 64, nb * 32, nb * 32, INP(I_MQN, l, 512), scr, lane); continue; }
        r -= IT_UQ;
        { const int kb = r / 64, nb = r % 64;
            transpose_item(INP(I_MWUKV, l, (size_t)256 * 2048), 256, 2048, WSP(f16, WS_WTUKV) + (size_t)l * 2048 * 256, kb * 64, nb * 32, nb * 32, INP(I_MKVN, l, 256), scr, lane); }
    }
    for (int i = F.gw * 64 + lane; i < 2 * 40960; i += F.NGW * 64) { const int l = i / 40960, q = i % 40960;
        *(u32x4*)(WSP(f16, WS_WTIN) + ((size_t)l * NTOT + C_MERGE) * DM + (size_t)q * 8) = (u32x4){0u, 0u, 0u, 0u}; }
    for (int it = F.gw; it < 2 * 96; it += F.NGW) {
        const int l = it / 96, n = (it % 96) * 64 + lane;
        const float* wa = INP(I_WADA, l, (size_t)DM * 6144) + n;
        const float* cv = F.in[I_C]; const float* cc = F.in[I_CCTX];
        float a0 = 0.f, a1 = 0.f, a2 = 0.f, a3 = 0.f, a4 = 0.f;
#pragma unroll 8
        for (int k = 0; k < DM; ++k) { const float w = wa[(size_t)k * 6144];
            a0 += siluf_(cv[k]) * w; a1 += siluf_(cv[DM + k]) * w; a2 += siluf_(cv[2 * DM + k]) * w; a3 += siluf_(cv[3 * DM + k]) * w; a4 += siluf_(cc[k]) * w; }
        const float bb = INP(I_BADA, l, 6144)[n];
        float* mo = WSP(float, WS_MOD) + (size_t)l * 5 * 6144 + n;
        mo[0] = a0 + bb; mo[6144] = a1 + bb; mo[2 * 6144] = a2 + bb; mo[3 * 6144] = a3 + bb; mo[4 * 6144] = a4 + bb;
    }
    for (int i = F.gw * 64 + lane; i < 2048 * 32; i += F.NGW * 64) {
        const int p = i >> 5, f = i & 31;
        const float invf = powf(10000.0f, -(float)(f & 15) / 16.0f);
        const float ang = (float)(f < 16 ? (p >> 6) : (p & 63)) * invf;
        WSP(float, WS_ROPE)[i] = cosf(ang); WSP(float, WS_ROPE)[2048 * 32 + i] = sinf(ang);
    }
    for (int it = F.gw; it < 2 * 2304; it += F.NGW) {
        const int l = it / 2304, q = it % 2304, isctx = q >= 2048, m = isctx ? q - 2048 : q, n = isctx ? 256 : 2048;
        const float t = (float)m / (float)(n - 1), wang = (6.283185307179586f / (float)n) * (float)m;
        const float* w1 = INP(I_HW1, l, 33 * 64); const float* w2 = INP(I_HW2, l, 64 * 64); const float* w3 = INP(I_HW3, l, 64 * 2048);
        float pre = INP(I_HB1, l, 64)[lane] + t * w1[lane];
#pragma unroll
        for (int i = 0; i < 16; ++i) { const float band = 1e-4f + (float)i * ((15.0f - 1e-4f) / 15.0f); const float a = band * wang;
            pre += cosf(a) * w1[(1 + i) * 64 + lane] - sinf(a) * w1[(17 + i) * 64 + lane]; }
        const float hd1 = sinf(INP(I_HFREQ, l, 128)[lane] * pre);
        float pre2 = INP(I_HB2, l, 64)[lane];
        for (int k = 0; k < 64; ++k) pre2 += __shfl(hd1, k) * w2[k * 64 + lane];
        const float hd2 = sinf(INP(I_HFREQ, l, 128)[64 + lane] * pre2);
        f16* hf = (f16*)(F.ws + WS_HF + (size_t)l * HF_LAYER + (isctx ? HF_LAT : 0));
        for (int cc = 0; cc < 32; ++cc) { const int c = cc * 64 + lane;
            float o = 0.f;
            for (int k = 0; k < 64; ++k) o += __shfl(hd2, k) * w3[k * 2048 + c];
            const int ch = c & 1023;
            const float delta = fabsf(-15.350567286626973f + (float)ch * ((-3.0701134573253945f + 15.350567286626973f) / 1023.0f));
            o *= expf(-t * delta);
            if (c < 1024) hf[(size_t)(n - m) * 1024 + ch] = (f16)o;
            else if (m >= 1) hf[(size_t)(n + m) * 1024 + ch] = (f16)o;
            if (m == 0 && c < 1024) hf[ch] = (f16)0.f;
        }
    }
}

__device__ __forceinline__ void row_stats(const f32x4 (&v)[8], float& mean, float& rstd) {
    float s = 0.f;
#pragma unroll
    for (int j = 0; j < 8; ++j) s += (v[j][0] + v[j][1]) + (v[j][2] + v[j][3]);
    mean = wave_sum(s) * (1.f / DM); float s2 = 0.f;
#pragma unroll
    for (int j = 0; j < 8; ++j) { const f32x4 d = v[j] - mean; s2 += (d[0] * d[0] + d[1] * d[1]) + (d[2] * d[2] + d[3] * d[3]); }
    rstd = 1.0f / sqrtf(wave_sum(s2) * (1.f / DM) + LN_EPS);
}
__device__ __forceinline__ void write_h_row(Frame& F, const f32x4 (&v)[8], int row, int l) {
    float mean, rstd; row_stats(v, mean, rstd);
    const int bidx = row < NLAT ? row / SEQ : 4;
    const float* mo = WSP(float, WS_MOD) + ((size_t)l * 5 + bidx) * 6144;
    f16* hr = WSP(f16, WS_H) + (size_t)row * DM;
#pragma unroll
    for (int j = 0; j < 8; ++j) { const int col = 4 * F.lane + 256 * j;
        const f32x4 sh = *(const f32x4*)(mo + col), sc = *(const f32x4*)(mo + 2048 + col);
        const f32x4 h = (v[j] - mean) * rstd * (sc + 1.0f) + sh;
        u32x2 w; w.x = pkh(h[0], h[1]); w.y = pkh(h[2], h[3]); *(u32x2*)(hr + col) = w; }
}
__device__ __forceinline__ void prologue_b(Frame& F) {
    for (int row = F.gw; row < MROWS; row += F.NGW) {
        const float* xr = row < NLAT ? F.in[I_X] + (size_t)row * DM : F.in[I_CTX] + (size_t)(row - NLAT) * DM;
        f32x4 v[8];
#pragma unroll
        for (int j = 0; j < 8; ++j) v[j] = *(const f32x4*)(xr + 4 * F.lane + 256 * j);
        write_h_row(F, v, row, 0);
    }
}
__device__ __forceinline__ void ln_phase(Frame& F, int l) {
    const int nrows = (l == DEPTH - 1) ? NLAT : MROWS;
    const float* lg = INP(I_LNG, l, DM); const float* lb = INP(I_LNB, l, DM);
    for (int row = F.gw; row < nrows; row += F.NGW) {
        const float* yr = WSP(float, WS_Y) + (size_t)row * DM;
        f32x4 v[8];
#pragma unroll
        for (int j = 0; j < 8; ++j) v[j] = *(const f32x4*)(yr + 4 * F.lane + 256 * j);
        float mean, rstd; row_stats(v, mean, rstd);
        float* xo = (l == DEPTH - 1) ? F.out + (size_t)row * DM : WSP(float, WS_X1) + (size_t)row * DM;
#pragma unroll
        for (int j = 0; j < 8; ++j) { const int col = 4 * F.lane + 256 * j;
            v[j] = (v[j] - mean) * rstd * *(const f32x4*)(lg + col) + *(const f32x4*)(lb + col);
            *(f32x4*)(xo + col) = v[j]; }
        if (l < DEPTH - 1) write_h_row(F, v, row, l + 1);
    }
}

struct EpiInProj {
    static constexpr bool PERM = true;
    f16* P; f16* G;
    __device__ __forceinline__ void operator()(const f32x4 (&acc)[2][2][4][2], const pg8::Unit& u, int wr, int wc, int fr, int fq) const {
        const int row0 = u.pm * 256 + wr * 64 + fr;
        const bool sig = u.pn >= NPT;
        f16* base = sig ? G : P; const int ld = sig ? NGATE : NPAD;
        const int col0 = (sig ? u.pn - NPT : u.pn) * 256 + wc * 32 + 8 * fq;
#pragma unroll
        for (int ai = 0; ai < 2; ++ai)
#pragma unroll
            for (int m = 0; m < 4; ++m) { f16* rowp = base + (size_t)(row0 + ai * 128 + m * 16) * ld + col0;
#pragma unroll
                for (int bj = 0; bj < 2; ++bj) { f32x4 v0 = acc[ai][bj][m][0], v1 = acc[ai][bj][m][1];
                    if (sig) {
#pragma unroll
                        for (int e = 0; e < 4; ++e) { v0[e] = sigmoidf_(v0[e]); v1[e] = sigmoidf_(v1[e]); } }
                    *(u32x4*)(rowp + bj * 128) = pkh8(v0, v1); } }
    }
};
struct EpiRowScale {
    static constexpr bool PERM = true;
    f16* O; int ldc; const float* rs;
    __device__ __forceinline__ void operator()(const f32x4 (&acc)[2][2][4][2], const pg8::Unit& u, int wr, int wc, int fr, int fq) const {
        const int row0 = u.pm * 256 + wr * 64 + fr, col0 = u.pn * 256 + wc * 32 + 8 * fq;
#pragma unroll
        for (int ai = 0; ai < 2; ++ai)
#pragma unroll
            for (int m = 0; m < 4; ++m) { const int row = row0 + ai * 128 + m * 16; const float s = rs[row]; f16* rowp = O + (size_t)row * ldc + col0;
#pragma unroll
                for (int bj = 0; bj < 2; ++bj) *(u32x4*)(rowp + bj * 128) = pkh8(acc[ai][bj][m][0] * s, acc[ai][bj][m][1] * s); }
    }
};
struct EpiMerge {
    static constexpr bool PERM = true;
    const f16* G; float* part; f16* MIX;
    __device__ __forceinline__ void operator()(const f32x4 (&acc)[2][2][4][2], const pg8::Unit& u, int wr, int wc, int fr, int fq) const {
        const int row0 = u.pm * 256 + wr * 64 + fr, col0 = u.pn * 256 + wc * 32 + 8 * fq;
#pragma unroll
        for (int ai = 0; ai < 2; ++ai)
#pragma unroll
            for (int m = 0; m < 4; ++m) { const int row = row0 + ai * 128 + m * 16;
#pragma unroll
                for (int bj = 0; bj < 2; ++bj) { const int col = col0 + bj * 128;
                    const f16x8 gt = *(const f16x8*)(G + (size_t)row * NGATE + u.kz * 2048 + col);
                    f32x4 v0 = acc[ai][bj][m][0], v1 = acc[ai][bj][m][1];
#pragma unroll
                    for (int e = 0; e < 4; ++e) { v0[e] *= (float)gt[e]; v1[e] *= (float)gt[4 + e]; }
                    float* pp = part + (size_t)row * DM + col;
                    if (u.kz > 0) { v0 += *(const f32x4*)pp; v1 += *(const f32x4*)(pp + 4); }
                    if (u.kz < 3) { *(f32x4*)pp = v0; *(f32x4*)(pp + 4) = v1; }
                    else *(u32x4*)(MIX + (size_t)row * DM + col) = pkh8(v0, v1); } }
    }
};
struct EpiOut {
    static constexpr bool PERM = false;
    const float* res_lat; const float* res_ctx; const float* mod; float* Y;
    __device__ __forceinline__ void operator()(const f32x4 (&acc)[2][2][4][2], const pg8::Unit& u, int wr, int wc, int fr, int fq) const {
        const int row0 = u.pm * 256 + wr * 64 + fr, col0 = u.pn * 256 + wc * 32 + 4 * fq;
        const bool lat = u.pm < NLAT / 256;
        const float* res = lat ? res_lat : res_ctx - (size_t)NLAT * DM;
        const float* gv = mod + (size_t)(lat ? u.pm / 8 : 4) * 6144 + 4096;
        f32x4 g4[2][2];
#pragma unroll
        for (int bj = 0; bj < 2; ++bj)
#pragma unroll
            for (int n = 0; n < 2; ++n) g4[bj][n] = *(const f32x4*)(gv + col0 + bj * 128 + n * 16);
#pragma unroll
        for (int ai = 0; ai < 2; ++ai)
#pragma unroll
            for (int m = 0; m < 4; ++m) { const size_t off = (size_t)(row0 + ai * 128 + m * 16) * DM + col0;
#pragma unroll
                for (int bj = 0; bj < 2; ++bj)
#pragma unroll
                    for (int n = 0; n < 2; ++n) { const f32x4 r = *(const f32x4*)(res + off + bj * 128 + n * 16);
                        *(f32x4*)(Y + off + bj * 128 + n * 16) = r * DN_ALPHA + g4[bj][n] * acc[ai][bj][m][n]; } }
    }
};

constexpr size_t SA_U = 0, SA_DT = (size_t)MROWS * 1536 * 4, SA_KPE = SA_DT + (size_t)MROWS * 32 * 4, SA_GK = SA_KPE + (size_t)MROWS * 64 * 4;
static_assert(SA_GK + (size_t)MROWS * 128 * 4 <= SA_BYTES, "scratch A");

__device__ __forceinline__ bool has_prev(int row) { return row < NLAT ? (row & (SEQ - 1)) != 0 : ((row - NLAT) & (CTXL - 1)) != 0; }
__device__ __forceinline__ bool has_next(int row) { return row < NLAT ? (row & (SEQ - 1)) != SEQ - 1 : ((row - NLAT) & (CTXL - 1)) != CTXL - 1; }
__device__ __forceinline__ float conv3(const f16* P, int row, int col, const float* w, int wc, int nch, float bias) {
    float a = w[nch + wc] * (float)P[(size_t)row * NPAD + col] + bias;
    if (has_prev(row)) a += w[wc] * (float)P[(size_t)(row - 1) * NPAD + col];
    if (has_next(row)) a += w[2 * nch + wc] * (float)P[(size_t)(row + 1) * NPAD + col];
    return a;
}
__device__ __forceinline__ void prep_naive(Frame& F, int l) {
    const f16* P = WSP(f16, WS_P); f16* Pw = WSP(f16, WS_P);
    const int gt = F.gw * 64 + F.lane, NT = F.NGW * 64;
    float* U = (float*)(F.ws + WS_SA + SA_U); float* DT = (float*)(F.ws + WS_SA + SA_DT);
    float* HW = (float*)(F.ws + WS_SB); float* HM = HW + (size_t)MROWS * 1024;
    const float* scw = INP(I_SCW, l, 3 * 1536); const float* scb = INP(I_SCB, l, 1536);
    const float* hcw = INP(I_HCW, l, 3 * 3072); const float* hcb = INP(I_HCB, l, 3072);
    const float* cosT = WSP(float, WS_ROPE); const float* sinT = cosT + 2048 * 32;
    for (int i = gt; i < MROWS * 1536; i += NT) { const int row = i / 1536, c = i % 1536;
        U[i] = siluf_(conv3(P, row, C_XBC + c, scw, c, 1536, scb[c])); }
    for (int i = gt; i < MROWS * 32; i += NT) { const int row = i >> 5, j = i & 31;
        DT[i] = softplusf_((float)P[(size_t)row * NPAD + C_DT + j] + INP(I_SDTB, l, 32)[j]); }
    for (int row = F.gw; row < MROWS; row += F.NGW) {
        float sq = 0.f, sk = 0.f;
#pragma unroll
        for (int j = 0; j < 8; ++j) { const float v = (float)P[(size_t)row * NPAD + C_CQ + j * 64 + F.lane]; sq += v * v; }
#pragma unroll
        for (int j = 0; j < 4; ++j) { const float v = (float)P[(size_t)row * NPAD + C_CKV + j * 64 + F.lane]; sk += v * v; }
        sq = wave_sum(sq); sk = wave_sum(sk);
        if (F.lane == 0) { WSP(float, WS_RS)[row] = 1.0f / sqrtf(sq * (1.f / 512.f) + LN_EPS); WSP(float, WS_RS)[MROWS + row] = 1.0f / sqrtf(sk * (1.f / 256.f) + LN_EPS); }
    }
    for (int i = gt; i < NLAT * 32; i += NT) { const int row = i >> 5, f = i & 31, p = row & (SEQ - 1);
        f16* a = Pw + (size_t)row * NPAD + C_KPE; const float c = cosT[p * 32 + f], s = sinT[p * 32 + f], t1 = (float)a[f], t2 = (float)a[32 + f];
        a[f] = (f16)(t1 * c - t2 * s); a[32 + f] = (f16)(t1 * s + t2 * c); }
    for (int i = gt; i < NLAT * 64; i += NT) { const int row = i >> 6, kv = (i >> 5) & 1, f = i & 31, p = row & (SEQ - 1);
        f16* a = Pw + (size_t)row * NPAD + C_GK + kv * 64; const float c = cosT[p * 32 + f], s = sinT[p * 32 + f], t1 = (float)a[f], t2 = (float)a[32 + f];
        a[f] = (f16)(t1 * c - t2 * s); a[32 + f] = (f16)(t1 * s + t2 * c); }
    for (int i = gt; i < MROWS * 1024; i += NT) { const int row = i >> 10, c = i & 1023;
        const float x0 = conv3(P, row, C_HXV + c, hcw, c, 3072, hcb[c]);
        const float x1 = conv3(P, row, C_HXV + 1024 + c, hcw, 1024 + c, 3072, hcb[1024 + c]);
        const float v = conv3(P, row, C_HXV + 2048 + c, hcw, 2048 + c, 3072, hcb[2048 + c]);
        HW[i] = x1 * v; HM[i] = x0 * siluf_((float)P[(size_t)row * NPAD + C_HZ + c]); }
}

__device__ __forceinline__ void ssd_naive(Frame& F, int l) {
    const float* U = (const float*)(F.ws + WS_SA + SA_U); const float* DT = (const float*)(F.ws + WS_SA + SA_DT);
    float* YD = WSP(float, WS_Y);
    LAS float* tile = (LAS float*)F.lds;
    for (int item = blockIdx.x; item < 256; item += F.G) {
        const int b = item >> 6, h = (item >> 2) & 15, dir = (item >> 1) & 1, ph = item & 1, g = h >> 3;
        const float a = -expf(INP(I_SALOG, l, 32)[dir * 16 + h]);
        const int pl = F.tid >> 4, nc = F.tid & 15;
        float st[8];
#pragma unroll
        for (int j = 0; j < 8; ++j) st[j] = 0.f;
        for (int s0 = 0; s0 < CTXL + SEQ; s0 += 16) {
            __syncthreads();
            for (int e = F.tid; e < 16 * 290; e += NTHREADS) { const int k = e / 290, q = e % 290, s = s0 + k;
                int row; if (s < CTXL) row = NLAT + b * CTXL + (dir ? CTXL - 1 - s : s); else row = b * SEQ + (dir ? SEQ - 1 - (s - CTXL) : (s - CTXL));
                float v;
                if (q < 32) v = U[(size_t)row * 1536 + h * 64 + ph * 32 + q];
                else if (q < 160) v = U[(size_t)row * 1536 + 1024 + g * 128 + (q - 32)];
                else if (q < 288) v = U[(size_t)row * 1536 + 1280 + g * 128 + (q - 160)];
                else if (q == 288) v = DT[(size_t)row * 32 + dir * 16 + h];
                else v = __int_as_float(row);
                tile[k * 292 + q] = v; }
            __syncthreads();
            for (int k = 0; k < 16; ++k) {
                const LAS float* tk = tile + k * 292;
                const float dtv = tk[288], dec = expf(dtv * a), xv = tk[pl] * dtv;
                float yp = 0.f;
#pragma unroll
                for (int j = 0; j < 8; ++j) { st[j] = dec * st[j] + xv * tk[32 + nc * 8 + j]; yp += st[j] * tk[160 + nc * 8 + j]; }
                yp += __shfl_xor(yp, 1); yp += __shfl_xor(yp, 2); yp += __shfl_xor(yp, 4); yp += __shfl_xor(yp, 8);
                if (nc == 0) { const int row = __float_as_int(tk[289]); YD[((size_t)dir * MROWS + row) * 1024 + h * 64 + ph * 32 + pl] = yp; }
            }
        }
        __syncthreads();
    }
}
__device__ __forceinline__ void ssd_gate_naive(Frame& F, int l) {
    const f16* P = WSP(f16, WS_P); const float* U = (const float*)(F.ws + WS_SA + SA_U); const float* YD = WSP(float, WS_Y);
    f16* GT = WSP(f16, WS_GATED);
    const int nrows = l == 0 ? MROWS : NLAT;
    for (int row = F.gw; row < nrows; row += F.NGW) {
        float gv[16]; float ss = 0.f;
#pragma unroll
        for (int j = 0; j < 16; ++j) { const int c = F.lane * 16 + j;
            const float y = YD[(size_t)row * 1024 + c] + YD[((size_t)MROWS + row) * 1024 + c] + U[(size_t)row * 1536 + c] * INP(I_SD, l, 16)[c >> 6];
            const float g = y * siluf_((float)P[(size_t)row * NPAD + C_SZ + c]); gv[j] = g; ss += g * g; }
#pragma unroll
        for (int o = 1; o < 32; o <<= 1) ss += __shfl_xor(ss, o);
        const float r = 1.0f / sqrtf(ss * (1.f / 512.f) + LN_EPS);
#pragma unroll
        for (int j = 0; j < 16; ++j) GT[(size_t)row * 1024 + F.lane * 16 + j] = (f16)(gv[j] * r);
    }
}
__device__ __forceinline__ void gqa_naive(Frame& F, int l) {
    const f16* P = WSP(f16, WS_P);
    const float* cosT = WSP(float, WS_ROPE); const float* sinT = cosT + 2048 * 32;
    f16* GT = WSP(f16, WS_GATED) + (size_t)2 * MROWS * 1024;
    const int nrows = l == 0 ? MROWS : NLAT;
    const int d = F.lane, f = d & 31;
    for (int it = F.gw; it < nrows * 16; it += F.NGW) {
        const int row = it >> 4, hq = it & 15, kv = hq >> 3;
        const bool lat = row < NLAT; const int b = lat ? row / SEQ : (row - NLAT) / CTXL, p = row & (SEQ - 1);
        const float t1 = (float)P[(size_t)row * NPAD + C_GQ + hq * 64 + f], t2 = (float)P[(size_t)row * NPAD + C_GQ + hq * 64 + 32 + f];
        float q;
        if (lat) { const float c = cosT[p * 32 + f], s = sinT[p * 32 + f]; q = d < 32 ? t1 * c - t2 * s : t1 * s + t2 * c; } else q = d < 32 ? t1 : t2;
        q *= 0.125f;
        float m = INP(I_GSINK, l, 16)[hq], lsum = 1.0f, acc = 0.f;
        const int nkeys = CTXL + (lat ? (min(p + 128, SEQ - 1) - max(p - 128, 0) + 1) : 0);
        for (int j = 0; j < nkeys; ++j) {
            const int krow = j < CTXL ? NLAT + b * CTXL + j : b * SEQ + max(p - 128, 0) + (j - CTXL);
            const float s = wave_sum(q * (float)P[(size_t)krow * NPAD + C_GK + kv * 64 + d]);
            const float v = (float)P[(size_t)krow * NPAD + C_GV + kv * 64 + d];
            const float mn = fmaxf(m, s), corr = fast_exp(m - mn), pe = fast_exp(s - mn);
            lsum = lsum * corr + pe; acc = acc * corr + pe * v; m = mn;
        }
        const float y = acc / lsum;
        GT[(size_t)row * 1024 + hq * 64 + d] = (f16)(y * siluf_((float)P[(size_t)row * NPAD + C_GZ + hq * 64 + d]));
    }
}
__device__ __forceinline__ void mla_naive(Frame& F, int l) {
    const f16* P = WSP(f16, WS_P); const f16* QM = WSP(f16, WS_QM); const f16* KVM = WSP(f16, WS_KVM);
    const float* cosT = WSP(float, WS_ROPE); const float* sinT = cosT + 2048 * 32;
    f16* GT = WSP(f16, WS_GATED) + (size_t)1 * MROWS * 1024;
    const int nrows = l == 0 ? MROWS : NLAT;
    const int d = F.lane, f = d & 31;
    const float scale = 0.07216878364870322f;
    for (int it = F.gw; it < nrows * 8; it += F.NGW) {
        const int row = it >> 3, h = it & 7;
        const bool lat = row < NLAT; const int b = lat ? row / SEQ : (row - NLAT) / CTXL, p = row & (SEQ - 1);
        const f16* qr = QM + (size_t)row * 1536 + h * 192;
        const float q0 = (float)qr[d] * scale, q1 = (float)qr[64 + d] * scale;
        const float t1 = (float)qr[128 + f], t2 = (float)qr[128 + 32 + f];
        float qp;
        if (lat) { const float c = cosT[p * 32 + f], s = sinT[p * 32 + f]; qp = d < 32 ? t1 * c - t2 * s : t1 * s + t2 * c; } else qp = d < 32 ? t1 : t2;
        qp *= scale;
        float m = -1e30f, lsum = 0.f, a0 = 0.f, a1 = 0.f;
        const int nkeys = CTXL + (lat ? SEQ : 0);
        for (int j = 0; j < nkeys; ++j) {
            const int krow = j < CTXL ? NLAT + b * CTXL + j : b * SEQ + (j - CTXL);
            const f16* kr = KVM + (size_t)krow * 2048 + h * 256;
            const float s = wave_sum(q0 * (float)kr[d] + q1 * (float)kr[64 + d] + qp * (float)P[(size_t)krow * NPAD + C_KPE + d]);
            const float v0 = (float)kr[128 + d], v1 = (float)kr[192 + d];
            const float mn = fmaxf(m, s), corr = fast_exp(m - mn), pe = fast_exp(s - mn);
            lsum = lsum * corr + pe; a0 = a0 * corr + pe * v0; a1 = a1 * corr + pe * v1; m = mn;
        }
        const float inv = 1.0f / lsum;
        const f16* zr = P + (size_t)row * NPAD + C_MZ + h * 128;
        GT[(size_t)row * 1024 + h * 128 + d] = (f16)(a0 * inv * siluf_((float)zr[d]));
        GT[(size_t)row * 1024 + h * 128 + 64 + d] = (f16)(a1 * inv * siluf_((float)zr[64 + d]));
    }
}
__device__ __forceinline__ void hyena_naive(Frame& F, int l) {
    const float* HW = (const float*)(F.ws + WS_SB); const float* HM = HW + (size_t)MROWS * 1024;
    f16* GT = WSP(f16, WS_GATED) + (size_t)3 * MROWS * 1024;
    const int nlat_items = NB * (SEQ / 8) * 16, nctx_items = (l == 0) ? NB * (CTXL / 8) * 16 : 0;
    for (int it = blockIdx.x; it < nlat_items + nctx_items; it += F.G) {
        const bool isctx = it >= nlat_items; const int q = isctx ? it - nlat_items : it;
        const int n = isctx ? CTXL : SEQ, cg = q & 15, pb = (q >> 4) % (n / 8), b = (q >> 4) / (n / 8);
        const int i = pb * 8 + F.wave, c = cg * 64 + F.lane;
        const int row0 = isctx ? NLAT + b * CTXL : b * SEQ;
        const f16* hf = (const f16*)(F.ws + WS_HF + (size_t)l * HF_LAYER + (isctx ? HF_LAT : 0));
        float acc = 0.f;
#pragma unroll 4
        for (int j = 0; j < n; ++j) acc += (float)hf[(size_t)(n - (i - j)) * 1024 + c] * HW[(size_t)(row0 + j) * 1024 + c];
        const size_t o = (size_t)(row0 + i) * 1024 + c;
        GT[o] = (f16)(HM[o] * (acc + HW[o] * INP(I_HD, l, 1024)[c]));
    }
}

namespace att {
typedef short s16x4 __attribute__((ext_vector_type(4)));
__device__ __forceinline__ int crow(int r, int hi) { return (r & 3) + 8 * (r >> 2) + 4 * hi; }
#define ATT_SBAR() __builtin_amdgcn_sched_barrier(0)
__device__ __forceinline__ int v_rd_base(int lane) { return ((lane & 3) << 3) | (((lane >> 2) & 3) << 6) | (((lane >> 4) & 1) << 5) | (((lane >> 5) & 1) << 8); }
template <int OFF> __device__ __forceinline__ s16x4 tr_read(int vb) { s16x4 r; asm volatile("ds_read_b64_tr_b16 %0, %1 offset:%2" : "=&v"(r) : "v"(vb), "i"(OFF) : "memory"); return r; }

template <bool MLA> struct Cfg {
    static constexpr int DQK = MLA ? 192 : 64, DV = MLA ? 128 : 64, NCB = DV / 32, ND0 = DQK / 16;
    static constexpr int KROWB = DQK * 2 + 16, SHM_K = 64 * KROWB, SHM_V = 64 * DV * 2;
    static constexpr int OFF_V = 0, OFF_K = 2 * SHM_V, OFF_WS = 2 * SHM_V + 2 * SHM_K, LDS_TOTAL = OFF_WS + 8 * 64 * 4;
};
template <int NCB> __device__ __forceinline__ int v_st(int k, int c) { const int kk = (k & ~0xC) | ((k & 4) << 1) | ((k & 8) >> 1); return ((kk >> 3) * NCB + (c >> 5)) * 512 + ((kk & 7) * 32 + (c & 31)) * 2; }

__device__ __forceinline__ void partialSM(f32x16& p0, f32x16& p1, float& m_reg, float& alpha, const float C, const float thr_raw) {
    float pmax = p0[0];
#pragma unroll
    for (int r = 1; r < 16; ++r) pmax = fmaxf(pmax, p0[r]);
#pragma unroll
    for (int r = 0; r < 16; ++r) pmax = fmaxf(pmax, p1[r]);
    { auto rr = __builtin_amdgcn_permlane32_swap(__float_as_uint(pmax), __float_as_uint(pmax), false, false); pmax = fmaxf(__uint_as_float(rr[0]), __uint_as_float(rr[1])); }
    float mn;
    if (__builtin_expect(__all(pmax - m_reg <= thr_raw), 1)) { mn = m_reg; alpha = 1.f; }
    else { mn = fmaxf(m_reg, pmax); alpha = __builtin_amdgcn_exp2f((m_reg - mn) * C); m_reg = mn; }
    const float mnC = -mn * C;
#pragma unroll
    for (int r = 0; r < 16; ++r) p0[r] = fmaf(p0[r], C, mnC);
#pragma unroll
    for (int r = 0; r < 16; ++r) p1[r] = fmaf(p1[r], C, mnC);
#pragma unroll
    for (int r = 0; r < 16; ++r) p0[r] = __builtin_amdgcn_exp2f(p0[r]);
}
__device__ __forceinline__ void finishSM(f32x16& p0, f32x16& p1, float alpha, float& l_reg, f16x8& pa0, f16x8& pa1, f16x8& pa2, f16x8& pa3) {
#pragma unroll
    for (int r = 0; r < 16; ++r) p1[r] = __builtin_amdgcn_exp2f(p1[r]);
    float ps = 0;
#pragma unroll
    for (int r = 0; r < 16; ++r) ps += p0[r];
#pragma unroll
    for (int r = 0; r < 16; ++r) ps += p1[r];
    { auto rr = __builtin_amdgcn_permlane32_swap(__float_as_uint(ps), __float_as_uint(ps), false, false); ps = __uint_as_float(rr[0]) + __uint_as_float(rr[1]); }
    l_reg = l_reg * alpha + ps;
#define ATT_PK4(P, BASE, OUT) do { unsigned a0 = pkh(P[BASE + 0], P[BASE + 1]), a1 = pkh(P[BASE + 2], P[BASE + 3]); \
    unsigned b0 = pkh(P[BASE + 4], P[BASE + 5]), b1 = pkh(P[BASE + 6], P[BASE + 7]); \
    auto r0 = __builtin_amdgcn_permlane32_swap(a0, b0, false, false); auto r1 = __builtin_amdgcn_permlane32_swap(a1, b1, false, false); \
    u32x4 w = {r0[0], r1[0], r0[1], r1[1]}; OUT = __builtin_bit_cast(f16x8, w); } while (0)
    ATT_PK4(p0, 0, pa0); ATT_PK4(p0, 8, pa1); ATT_PK4(p1, 0, pa2); ATT_PK4(p1, 8, pa3);
#undef ATT_PK4
}
template <int ND0, int KROWB> __device__ __forceinline__ void qkt(f32x16& p0, f32x16& p1, const LAS char* Ks, const f16x8* qr, int r32, int hi) {
    p0 = f32x16{}; p1 = f32x16{};
#pragma unroll
    for (int d0 = 0; d0 < ND0; ++d0) { const int cb = (d0 * 16 + hi * 8) * 2;
        const f16x8 b0 = *(const LAS f16x8*)(Ks + r32 * KROWB + cb);
        const f16x8 b1 = *(const LAS f16x8*)(Ks + (32 + r32) * KROWB + cb);
        p0 = __builtin_amdgcn_mfma_f32_32x32x16_f16(b0, qr[d0], p0, 0, 0, 0);
        p1 = __builtin_amdgcn_mfma_f32_32x32x16_f16(b1, qr[d0], p1, 0, 0, 0); }
}
template <int NCB, int D0> __device__ __forceinline__ void pv_one(f32x16& od, int vb, f16x8 pa0, f16x8 pa1, f16x8 pa2, f16x8 pa3) {
    constexpr int KS = 2 * NCB * 512, HF = NCB * 512, B0 = D0 * 512;
    const s16x4 l0 = tr_read<B0 + 0 * KS>(vb), h0 = tr_read<B0 + 0 * KS + HF>(vb), l1 = tr_read<B0 + 1 * KS>(vb), h1 = tr_read<B0 + 1 * KS + HF>(vb);
    const s16x4 l2 = tr_read<B0 + 2 * KS>(vb), h2 = tr_read<B0 + 2 * KS + HF>(vb), l3 = tr_read<B0 + 3 * KS>(vb), h3 = tr_read<B0 + 3 * KS + HF>(vb);
    asm volatile("s_waitcnt lgkmcnt(0)" ::: "memory"); ATT_SBAR();
#define ATT_PK(L, H) __builtin_bit_cast(f16x8, (short __attribute__((ext_vector_type(8)))){L[0], L[1], L[2], L[3], H[0], H[1], H[2], H[3]})
    od = __builtin_amdgcn_mfma_f32_32x32x16_f16(pa0, ATT_PK(l0, h0), od, 0, 0, 0);
    od = __builtin_amdgcn_mfma_f32_32x32x16_f16(pa1, ATT_PK(l1, h1), od, 0, 0, 0);
    od = __builtin_amdgcn_mfma_f32_32x32x16_f16(pa2, ATT_PK(l2, h2), od, 0, 0, 0);
    od = __builtin_amdgcn_mfma_f32_32x32x16_f16(pa3, ATT_PK(l3, h3), od, 0, 0, 0);
#undef ATT_PK
}
template <int NCB> __device__ __forceinline__ void pv_all(f32x16* o, int vb, f16x8 pa0, f16x8 pa1, f16x8 pa2, f16x8 pa3) {
    pv_one<NCB, 0>(o[0], vb, pa0, pa1, pa2, pa3); pv_one<NCB, 1>(o[1], vb, pa0, pa1, pa2, pa3);
    if constexpr (NCB == 4) { pv_one<NCB, 2>(o[2], vb, pa0, pa1, pa2, pa3); pv_one<NCB, 3>(o[3], vb, pa0, pa1, pa2, pa3); }
}

struct UnitDesc { int b, h, qb, isctx, hp; };
template <bool MLA>
__device__ __forceinline__ void attn_unit(Frame& F, const UnitDesc u, int l, LAS char* lds) {
    typedef Cfg<MLA> C_;
    constexpr int DQK = C_::DQK, DV = C_::DV, NCB = C_::NCB, ND0 = C_::ND0, KROWB = C_::KROWB;
    const int tid = F.tid, wid = F.wave, lane = F.lane, r32 = lane & 31, hi = lane >> 5;
    LAS char* V_lds = lds + C_::OFF_V; LAS char* K_lds = lds + C_::OFF_K;
    LAS float* ws = (LAS float*)(lds + C_::OFF_WS) + wid * 64; LAS float* li_l = ws; LAS float* al_l = ws + 32;
    const f16* P = WSP(f16, WS_P); const f16* KVM = WSP(f16, WS_KVM);
    const float scale = MLA ? 0.07216878364870322f : 0.125f, Cc = scale * 1.4426950408889634f, thr_raw = 8.0f / scale;
    int qrow0, qpos0, hq;
    if constexpr (MLA) { hq = u.h; qpos0 = u.qb * 256 + wid * 32; qrow0 = (u.isctx ? NLAT + u.b * CTXL : u.b * SEQ) + qpos0; }
    else { hq = u.h * 8 + u.hp * 2 + (wid >> 2); qpos0 = u.qb * 128 + (wid & 3) * 32; qrow0 = (u.isctx ? NLAT + u.b * CTXL : u.b * SEQ) + qpos0; }
    f16x8 qr[ND0];
    { const f16* Qw = MLA ? WSP(f16, WS_QM) + (size_t)(qrow0 + r32) * 1536 + hq * 192 + hi * 8 : P + (size_t)(qrow0 + r32) * NPAD + C_GQ + hq * 64 + hi * 8;
#pragma unroll
      for (int d0 = 0; d0 < ND0; ++d0) qr[d0] = *reinterpret_cast<const f16x8*>(Qw + d0 * 16);
      if (!u.isctx) {
          constexpr int R0 = ND0 - 4;
          const float* cosT = WSP(float, WS_ROPE) + (size_t)(qpos0 + r32) * 32; const float* sinT = cosT + 2048 * 32;
#pragma unroll
          for (int i = 0; i < 2; ++i) {
              const f32x4 c0 = *(const f32x4*)(cosT + 16 * i + 8 * hi), c1 = *(const f32x4*)(cosT + 16 * i + 8 * hi + 4);
              const f32x4 s0 = *(const f32x4*)(sinT + 16 * i + 8 * hi), s1 = *(const f32x4*)(sinT + 16 * i + 8 * hi + 4);
              f16x8 a = qr[R0 + i], b2 = qr[R0 + i + 2], oa, ob;
#pragma unroll
              for (int j = 0; j < 8; ++j) { const float cc = j < 4 ? c0[j] : c1[j - 4], ss = j < 4 ? s0[j] : s1[j - 4]; const float t1 = (float)a[j], t2 = (float)b2[j];
                  oa[j] = (f16)(t1 * cc - t2 * ss); ob[j] = (f16)(t1 * ss + t2 * cc); }
              qr[R0 + i] = oa; qr[R0 + i + 2] = ob; }
      } }
    const int kstart = MLA ? 0 : max(0, 128 * (u.qb - 1));
    const int nlat_tiles = u.isctx ? 0 : (MLA ? 32 : ((u.qb == 0 || u.qb == 15) ? 4 : 6));
    const int NT = 4 + nlat_tiles;
    const int sk = tid >> 3, sj = tid & 7;
    const int ctxrow0 = NLAT + u.b * CTXL, latrow0 = u.b * SEQ + kstart;
#define ATT_KROW(t) ((t) < 4 ? ctxrow0 + 64 * (t) : latrow0 + 64 * ((t) - 4))
    u32x4 sK0, sK1, sK2, sV0, sV1;
#define ATT_KLOAD(t) do { const int kr_ = ATT_KROW(t) + sk; \
      if constexpr (MLA) { const f16* kp_ = KVM + (size_t)kr_ * 2048 + u.h * 256 + sj * 8; \
          sK0 = *(const u32x4*)kp_; sK1 = *(const u32x4*)(kp_ + 64); sK2 = *(const u32x4*)(P + (size_t)kr_ * NPAD + C_KPE + sj * 8); } \
      else { sK0 = *(const u32x4*)(P + (size_t)kr_ * NPAD + C_GK + u.h * 64 + sj * 8); } } while (0)
#define ATT_VLOAD(t) do { const int kr_ = ATT_KROW(t) + sk; \
      if constexpr (MLA) { const f16* kp_ = KVM + (size_t)kr_ * 2048 + u.h * 256 + 128 + sj * 8; sV0 = *(const u32x4*)kp_; sV1 = *(const u32x4*)(kp_ + 64); } \
      else { sV0 = *(const u32x4*)(P + (size_t)kr_ * NPAD + C_GV + u.h * 64 + sj * 8); } } while (0)
#define ATT_KWRITE(bf) do { LAS char* kb_ = K_lds + (bf) * C_::SHM_K + sk * KROWB + sj * 16; *(LAS u32x4*)kb_ = sK0; \
      if constexpr (MLA) { *(LAS u32x4*)(kb_ + 128) = sK1; *(LAS u32x4*)(kb_ + 256) = sK2; } } while (0)
#define ATT_VWRITE(bf) do { LAS char* vb_ = V_lds + (bf) * C_::SHM_V; *(LAS u32x4*)(vb_ + v_st<NCB>(sk, sj * 8)) = sV0; \
      if constexpr (MLA) { *(LAS u32x4*)(vb_ + v_st<NCB>(sk, 64 + sj * 8)) = sV1; } } while (0)
#define ATT_RESC(a) do { if (__any((a) < 1.f)) { if (hi == 0) al_l[r32] = (a); asm volatile("s_waitcnt lgkmcnt(0)" ::: "memory"); \
      _Pragma("unroll") for (int d = 0; d < NCB; ++d) _Pragma("unroll") for (int r = 0; r < 16; ++r) o[d][r] *= al_l[crow(r, hi)]; } } while (0)
#define ATT_MASK(p0, p1, t) do { if constexpr (!MLA) { if ((t) >= 4) { const int kb_ = kstart + 64 * ((t) - 4) + 4 * hi - (qpos0 + r32); \
      if (kb_ < -128 || kb_ + 63 > 128) { _Pragma("unroll") for (int r = 0; r < 16; ++r) { const int dk = kb_ + (r & 3) + 8 * (r >> 2); \
          if (dk < -128 || dk > 128) p0[r] = -1e30f; if (dk + 32 < -128 || dk + 32 > 128) p1[r] = -1e30f; } } } } } while (0)
    const int vb0 = (int)(unsigned)(uintptr_t)V_lds + v_rd_base(lane);
    float m_reg = -1e30f, l_reg = 0.f, alA; f32x16 o[NCB];
#pragma unroll
    for (int d = 0; d < NCB; ++d) o[d] = f32x16{};
    f32x16 pA0, pA1; f16x8 pa0, pa1, pa2, pa3;
    __syncthreads();
    ATT_KLOAD(0); ATT_VLOAD(0); ATT_KWRITE(0); ATT_VWRITE(0); __syncthreads();
#pragma unroll 1
    for (int t = 0; t < NT; ++t) {
        const int bf = t & 1; const bool more = t + 1 < NT;
        if (more) ATT_KLOAD(t + 1);
        qkt<ND0, KROWB>(pA0, pA1, K_lds + bf * C_::SHM_K, qr, r32, hi); ATT_MASK(pA0, pA1, t);
        partialSM(pA0, pA1, m_reg, alA, Cc, thr_raw);
        ATT_RESC(alA);
        finishSM(pA0, pA1, alA, l_reg, pa0, pa1, pa2, pa3); ATT_SBAR();
        if (more) { ATT_KWRITE(bf ^ 1); ATT_VLOAD(t + 1); } ATT_SBAR();
        pv_all<NCB>(o, vb0 + bf * C_::SHM_V, pa0, pa1, pa2, pa3);
        if (more) ATT_VWRITE(bf ^ 1);
        __syncthreads();
    }
    if constexpr (!MLA) l_reg += __builtin_amdgcn_exp2f(INP(I_GSINK, l, 16)[hq] * 1.4426950408889634f - m_reg * Cc);
    if (hi == 0) li_l[r32] = l_reg; asm volatile("s_waitcnt lgkmcnt(0)" ::: "memory");
    f16* GT = WSP(f16, WS_GATED) + (size_t)(MLA ? 1 : 2) * MROWS * 1024;
    const int zc = MLA ? C_MZ + hq * 128 : C_GZ + hq * 64, oc = MLA ? hq * 128 : hq * 64;
#pragma unroll
    for (int r = 0; r < 16; ++r) { const int row = qrow0 + crow(r, hi); const float rl = __builtin_amdgcn_rcpf(li_l[crow(r, hi)]);
#pragma unroll
        for (int d0 = 0; d0 < NCB; ++d0) { const float z = (float)P[(size_t)row * NPAD + zc + d0 * 32 + r32];
            GT[(size_t)row * 1024 + oc + d0 * 32 + r32] = (f16)(o[d0][r] * rl * siluf_(z)); } }
#undef ATT_KROW
#undef ATT_KLOAD
#undef ATT_VLOAD
#undef ATT_KWRITE
#undef ATT_VWRITE
#undef ATT_RESC
#undef ATT_MASK
}
#undef ATT_SBAR
}

__device__ __forceinline__ void mla_phase(Frame& F, int l) {
    const int nunits = 256 + (l == 0 ? 32 : 0);
    for (int it = blockIdx.x; it < nunits; it += F.G) {
        att::UnitDesc u;
        if (it < 256) { u.b = it >> 6; u.h = (it >> 3) & 7; u.qb = it & 7; u.isctx = 0; } else { const int q = it - 256; u.b = q >> 3; u.h = q & 7; u.qb = 0; u.isctx = 1; }
        u.hp = 0;
        att::attn_unit<true>(F, u, l, (LAS char*)F.lds);
    }
}
__device__ __forceinline__ void gqa_phase(Frame& F, int l) {
    const int nunits = 512 + (l == 0 ? 64 : 0);
    for (int it = blockIdx.x; it < nunits; it += F.G) {
        att::UnitDesc u;
        if (it < 512) { u.b = it >> 7; u.h = (it >> 6) & 1; u.qb = (it >> 2) & 15; u.hp = it & 3; u.isctx = 0; }
        else { const int q = it - 512; u.b = q >> 4; u.h = (q >> 3) & 1; u.qb = (q >> 2) & 1; u.hp = q & 3; u.isctx = 1; }
        att::attn_unit<false>(F, u, l, (LAS char*)F.lds);
    }
}

#ifndef USE_MFMA_GQA
#define USE_MFMA_GQA 1
#endif
#ifndef USE_MFMA_MLA
#define USE_MFMA_MLA 1
#endif
#ifndef MK_ONE_LAUNCH
#define MK_ONE_LAUNCH 1
#endif
constexpr int PH_PER_LAYER = 7, N_PHASES = 2 + PH_PER_LAYER * DEPTH;
constexpr int CW_BAR = 4096;

__global__ void __launch_bounds__(NTHREADS, 2) fwd_kernel(Args args) {
    extern __shared__ __attribute__((aligned(16))) unsigned char lds_raw[];
    Frame F;
    F.lds = (LAS unsigned char*)lds_raw; F.ws = args.ws; F.in = args.in; F.out = args.out;
    F.tid = threadIdx.x; F.lane = F.tid & 63; F.wave = __builtin_amdgcn_readfirstlane(F.tid >> 6);
    F.G = gridDim.x; F.gw = blockIdx.x * NWAVES + F.wave; F.NGW = F.G * NWAVES;
    volatile LAS unsigned* MISC = (volatile LAS unsigned*)(F.lds + MISC_OFF);
    for (int u = F.tid; u < (LDS_BYTES - LDSCTL_OFF) / 4; u += NTHREADS) ((LAS unsigned*)(F.lds + LDSCTL_OFF))[u] = 0u;
    __syncthreads();
    XcdBarrier bar; bar.bar = (unsigned*)(F.ws + WS_CTL) + CW_BAR; bar.x = 0; bar.st = nullptr;
    if (MK_ONE_LAUNCH) bar = xcd_barrier_post((unsigned*)(F.ws + WS_CTL) + CW_BAR, MISC + 8);
    const int lo = args.ph_lo, hi = args.ph_hi;
#define IN_PH(k) (lo <= (k) && (k) < hi)
#define FENCE() asm volatile("" : "+v"(F.tid), "+v"(F.lane))
#define SEAM(k) do { if (IN_PH(k) && IN_PH((k) + 1)) xcd_barrier(bar); } while (0)

    if (IN_PH(0)) { FENCE(); prologue_a(F); __syncthreads(); } SEAM(0);
    if (IN_PH(1)) { FENCE(); prologue_b(F); } SEAM(1);
#pragma unroll 1
    for (int l = 0; l < DEPTH; ++l) {
        const int base = 2 + PH_PER_LAYER * l;
        const int mrows = (l == DEPTH - 1) ? NLAT : MROWS;
        if (IN_PH(base + 0)) {
            pg8::Gemm g{WSP(f16, WS_H), WSP(f16, WS_WTIN) + (size_t)l * NTOT * DM, MROWS, NTOT, DM, DM, DM, 1, 0, 0};
            pg8::StaticOrder S; S.init(MROWS, NTOT, 1, F.G, (int)blockIdx.x);
            EpiInProj E{WSP(f16, WS_P), WSP(f16, WS_G)};
            pg8::gemm_phase<EpiInProj>(F.lds, g, S, E);
        }
        SEAM(base + 0);
        if (IN_PH(base + 1)) { FENCE(); prep_naive(F, l); }
        SEAM(base + 1);
        if (IN_PH(base + 2)) {
            { pg8::Gemm g{WSP(f16, WS_P) + C_CQ, WSP(f16, WS_WTUQ) + (size_t)l * 1536 * 512, MROWS, 1536, 512, NPAD, 512, 1, 0, 0};
              pg8::StaticOrder S; S.init(MROWS, 1536, 1, F.G, (int)blockIdx.x);
              EpiRowScale E{WSP(f16, WS_QM), 1536, WSP(float, WS_RS)};
              pg8::gemm_phase<EpiRowScale>(F.lds, g, S, E); }
            { pg8::Gemm g{WSP(f16, WS_P) + C_CKV, WSP(f16, WS_WTUKV) + (size_t)l * 2048 * 256, MROWS, 2048, 256, NPAD, 256, 1, 0, 0};
              pg8::StaticOrder S; S.init(MROWS, 2048, 1, F.G, (int)((blockIdx.x + 128) % F.G));
              EpiRowScale E{WSP(f16, WS_KVM), 2048, WSP(float, WS_RS) + MROWS};
              pg8::gemm_phase<EpiRowScale>(F.lds, g, S, E); }
            __syncthreads();
            FENCE(); ssd_naive(F, l);
#if USE_MFMA_GQA
            FENCE(); gqa_phase(F, l);
#else
            FENCE(); gqa_naive(F, l);
#endif
            FENCE(); hyena_naive(F, l);
        }
        SEAM(base + 2);
        if (IN_PH(base + 3)) {
#if USE_MFMA_MLA
            FENCE(); mla_phase(F, l);
#else
            FENCE(); mla_naive(F, l);
#endif
            FENCE(); ssd_gate_naive(F, l); }
        SEAM(base + 3);
        if (IN_PH(base + 4)) {
            pg8::Gemm g{WSP(f16, WS_GATED), WSP(f16, WS_WTBR) + (size_t)l * 4 * DM * 1024, mrows, DM, 1024, 1024, 1024, 4, (size_t)MROWS * 1024, (size_t)DM * 1024};
            pg8::StaticOrder S; S.init(mrows, DM, 4, F.G, (int)blockIdx.x);
            EpiMerge E{WSP(f16, WS_G), WSP(float, WS_Y), WSP(f16, WS_MIX)};
            pg8::gemm_phase<EpiMerge>(F.lds, g, S, E);
        }
        SEAM(base + 4);
        if (IN_PH(base + 5)) {
            pg8::Gemm g{WSP(f16, WS_MIX), WSP(f16, WS_WTOUT) + (size_t)l * DM * DM, mrows, DM, DM, DM, DM, 1, 0, 0};
            pg8::StaticOrder S; S.init(mrows, DM, 1, F.G, (int)blockIdx.x);
            EpiOut E{l == 0 ? F.in[I_X] : WSP(float, WS_X1), l == 0 ? F.in[I_CTX] : WSP(float, WS_X1) + (size_t)NLAT * DM, WSP(float, WS_MOD) + (size_t)l * 5 * 6144, WSP(float, WS_Y)};
            pg8::gemm_phase<EpiOut>(F.lds, g, S, E);
        }
        SEAM(base + 5);
        if (IN_PH(base + 6)) { FENCE(); ln_phase(F, l); }
        SEAM(base + 6);
    }
#undef IN_PH
#undef SEAM
}

extern "C" void kernel_launch(void* const* d_in, const int* in_sizes, int n_in, void* d_out, int out_size, void* d_ws, size_t ws_size, hipStream_t stream) {
    static int grid = 0;
    if (grid == 0) {
        if (n_in != N_IN || out_size != NLAT * DM || ws_size < WS_END) { fprintf(stderr, "kernel_launch: unexpected shapes: n_in %d out %d ws %zu (need %zu)\n", n_in, out_size, ws_size, (size_t)WS_END); grid = -1; return; }
        int dev = 0, cus = 0, per_cu = 0;
        if (hipGetDevice(&dev) != hipSuccess || hipDeviceGetAttribute(&cus, hipDeviceAttributeMultiprocessorCount, dev) != hipSuccess) { grid = -1; return; }
        if (hipFuncSetAttribute((const void*)fwd_kernel, hipFuncAttributeMaxDynamicSharedMemorySize, LDS_BYTES) != hipSuccess) { fprintf(stderr, "kernel_launch: hipFuncSetAttribute failed\n"); grid = -1; return; }
        if (hipOccupancyMaxActiveBlocksPerMultiprocessor(&per_cu, (const void*)fwd_kernel, NTHREADS, LDS_BYTES) != hipSuccess || per_cu < 1) { fprintf(stderr, "kernel_launch: occupancy query says %d blocks per CU\n", per_cu); (void)hipGetLastError(); grid = -1; return; }
        grid = cus;
    }
    if (grid < 0) return;
    (void)hipMemsetAsync((char*)d_ws + WS_CTL, 0, CTL_BYTES, stream);
    Args a{};
    for (int i = 0; i < N_IN; ++i) a.in[i] = (const float*)d_in[i];
    a.out = (float*)d_out; a.ws = (unsigned char*)d_ws;
#if MK_ONE_LAUNCH
    a.ph_lo = 0; a.ph_hi = N_PHASES;
    hipLaunchKernelGGL(fwd_kernel, dim3(grid), dim3(NTHREADS), LDS_BYTES, stream, a);
#else
    for (int ph = 0; ph < N_PHASES; ++ph) { a.ph_lo = ph; a.ph_hi = ph + 1; hipLaunchKernelGGL(fwd_kernel, dim3(grid), dim3(NTHREADS), LDS_BYTES, stream, a); }
#endif
}
```

```cpp
#ifndef USE_MFMA_GQA
#define USE_MFMA_GQA 1
#endif
#ifndef USE_MFMA_MLA
#define USE_MFMA_MLA 1
#endif
#ifndef USE_MFMA_HY
#define USE_MFMA_HY 1
#endif
#ifndef USE_MFMA_SSD
#define USE_MFMA_SSD 1
#endif
#include <hip/hip_runtime.h>
#include <cstdio>
#include <cstdint>
#include <cmath>

constexpr int DM = 2048, NB = 4, SEQ = 2048, CTXL = 256, DEPTH = 2;
constexpr int NLAT = NB * SEQ;
constexpr int NCTX = NB * CTXL;
constexpr int MROWS = NLAT + NCTX;
constexpr int INW = 19040;
constexpr int NPAD = 11008;
constexpr int NGATE = 8192;
constexpr int NTOT = NPAD + NGATE;
constexpr int NPT = NPAD / 256;
constexpr int C_SZ = 0, C_XBC = 1024, C_DT = 2560, C_CQ = 2592, C_CKV = 3104, C_KPE = 3360, C_MZ = 3424, C_GQ = 4448,
              C_GK = 5472, C_GV = 5600, C_GZ = 5728, C_HXV = 6752, C_HZ = 9824, C_MERGE = 10848;
constexpr float LN_EPS = 1e-6f;
constexpr float DN_ALPHA = 1.4142135623730951f;

enum { I_X = 0, I_C, I_CTX, I_CCTX, I_WADA, I_BADA, I_WIN, I_SCW, I_SCB, I_SDTB, I_SALOG, I_SD, I_SNW, I_MQN, I_MWUQ, I_MKVN, I_MWUKV,
       I_GSINK, I_HCW, I_HCB, I_HW1, I_HB1, I_HW2, I_HB2, I_HW3, I_HFREQ, I_HD, I_WBR, I_WOUT, I_LNG, I_LNB, N_IN };

constexpr size_t al256(size_t x) { return (x + 255) & ~(size_t)255; }
constexpr size_t WS_CTL = 0, CTL_BYTES = 1u << 20;
constexpr size_t WS_WTIN = CTL_BYTES;
constexpr size_t WS_WTUQ = WS_WTIN + (size_t)2 * NTOT * DM * 2;
constexpr size_t WS_WTUKV = WS_WTUQ + (size_t)2 * 1536 * 512 * 2;
constexpr size_t WS_WTBR = WS_WTUKV + (size_t)2 * 2048 * 256 * 2;
constexpr size_t WS_WTOUT = WS_WTBR + (size_t)2 * 4 * 2048 * 1024 * 2;
constexpr size_t WS_MOD = WS_WTOUT + (size_t)2 * 2048 * 2048 * 2;
constexpr size_t WS_ROPE = al256(WS_MOD + (size_t)2 * 5 * 6144 * 4);
constexpr size_t WS_HF = al256(WS_ROPE + (size_t)2 * 2048 * 32 * 4);
constexpr size_t HF_LAT = (size_t)4096 * 1024 * 2, HF_CTX = (size_t)512 * 1024 * 2, HF_LAYER = HF_LAT + HF_CTX;
constexpr size_t WS_H = al256(WS_HF + 2 * HF_LAYER);
constexpr size_t WS_P = WS_H + (size_t)MROWS * DM * 2;
constexpr size_t WS_G = WS_P + (size_t)MROWS * NPAD * 2;
constexpr size_t WS_RS = WS_G + (size_t)MROWS * NGATE * 2;
constexpr size_t WS_QM = al256(WS_RS + (size_t)2 * MROWS * 4);
constexpr size_t WS_KVM = WS_QM + (size_t)MROWS * 1536 * 2;
constexpr size_t WS_GATED = WS_KVM + (size_t)MROWS * 2048 * 2;
constexpr size_t WS_MIX = WS_GATED + (size_t)4 * MROWS * 1024 * 2;
constexpr size_t WS_Y = WS_MIX + (size_t)MROWS * DM * 2;
constexpr size_t WS_X1 = WS_Y + (size_t)MROWS * DM * 4;
constexpr size_t WS_SA = WS_X1 + (size_t)MROWS * DM * 4;
constexpr size_t SA_BYTES = (size_t)MROWS * 2048 * 4;
constexpr size_t WS_SB = WS_SA + SA_BYTES;
constexpr size_t WS_SC = WS_SB + SA_BYTES;
constexpr size_t SC_BYTES = (size_t)MROWS * 1024 * 4;
constexpr size_t WS_END = WS_SC + SC_BYTES;

#define GAS __attribute__((address_space(1)))
#define LAS __attribute__((address_space(3)))
typedef _Float16 f16;
typedef _Float16 f16x2 __attribute__((ext_vector_type(2)));
typedef _Float16 f16x4 __attribute__((ext_vector_type(4)));
typedef _Float16 f16x8 __attribute__((ext_vector_type(8)));
typedef float f32x2 __attribute__((ext_vector_type(2)));
typedef float f32x4 __attribute__((ext_vector_type(4)));
typedef float f32x16 __attribute__((ext_vector_type(16)));
typedef unsigned u32x2 __attribute__((ext_vector_type(2)));
typedef unsigned u32x4 __attribute__((ext_vector_type(4)));
typedef GAS unsigned gu32;
#define RLX_AGENT __ATOMIC_RELAXED, __HIP_MEMORY_SCOPE_AGENT
#define LDS_WAIT() asm volatile("s_waitcnt lgkmcnt(0)" ::: "memory")
#define VM_WAIT() asm volatile("s_waitcnt vmcnt(0)" ::: "memory")

__device__ __forceinline__ unsigned pkh(float lo, float hi) { f16x2 v = {(f16)lo, (f16)hi}; return __builtin_bit_cast(unsigned, v); }
__device__ __forceinline__ u32x4 pkh8(f32x4 a, f32x4 b) { u32x4 w; w.x = pkh(a[0], a[1]); w.y = pkh(a[2], a[3]); w.z = pkh(b[0], b[1]); w.w = pkh(b[2], b[3]); return w; }
__device__ __forceinline__ float fast_exp(float x) { return __builtin_amdgcn_exp2f(x * 1.4426950408889634f); }
__device__ __forceinline__ float sigmoidf_(float x) { return __builtin_amdgcn_rcpf(1.0f + fast_exp(-x)); }
__device__ __forceinline__ float siluf_(float x) { return x * sigmoidf_(x); }
__device__ __forceinline__ float softplusf_(float x) { return x > 20.f ? x : log1pf(expf(x)); }
__device__ __forceinline__ int lane_id_opaque() { int l; asm volatile("v_mbcnt_lo_u32_b32 %0, -1, 0\n\tv_mbcnt_hi_u32_b32 %0, -1, %0" : "=v"(l)); return l; }
__device__ __forceinline__ float wave_sum(float v) {
#pragma unroll
    for (int o = 1; o < 64; o <<= 1) v += __shfl_xor(v, o);
    return v;
}

namespace pg8 {
constexpr int BM = 256, BK = 64, HALF = 128, HTB = HALF * BK * 2, STAGE_BYTES = 8 * HTB, NXCD = 8, WGM = 8;
__host__ __device__ __forceinline__ int lds_byte(int r, int c) { const int st = (r >> 4) * 2 + (c >> 5), rr = r & 15, cc = c & 31, ob = rr * 64 + cc * 2; return st * 1024 + (ob ^ (((ob >> 9) & 1) << 5)); }
__host__ __device__ __forceinline__ void stage_rc(int b, int& R, int& C) { const int st = b / 1024, sb = b % 1024, swz = sb ^ (((sb >> 9) & 1) << 5); R = (st >> 1) * 16 + swz / 64; C = (st & 1) * 32 + (swz % 64) / 2; }
__host__ __device__ __forceinline__ int perm32(int rho) { const int n = rho >> 4, i = rho & 15; return 8 * (i >> 2) + 4 * n + (i & 3); }

struct Unit { int pm, pn, kz; };
struct Gemm { const f16* A; const f16* Bt; };
template <int N_, int K_, int LDA_, int LDB_, int NZ_, long AZS_, long BZS_> struct Shape { static constexpr int N = N_, K = K_, LDA = LDA_, LDB = LDB_, NZ = NZ_; static constexpr long AZS = AZS_, BZS = BZS_; };

template <int NN, int NZ> struct StaticOrder {
    int nM, nwg, G, c;
    __device__ __forceinline__ void init(int M, int G_, int c_) { nM = M / BM; nwg = nM * NN; G = G_; c = c_; }
    __device__ __forceinline__ bool next(int i, Unit& u) const {
        const int j = i / NZ; u.kz = i - j * NZ;
        const int L = j * G + c; if (L >= nwg) return false;
        int wgid = L; { const int q = nwg / NXCD, r = nwg % NXCD, xcd = wgid % NXCD, off = wgid / NXCD; wgid = (xcd < r ? xcd * (q + 1) : r * (q + 1) + (xcd - r) * q) + off; }
        constexpr int nig = WGM * NN; const int gid = wgid / nig, fm = gid * WGM, gsz = (nM - fm) < WGM ? (nM - fm) : WGM;
        u.pm = fm + ((wgid % nig) % gsz); u.pn = (wgid % nig) / gsz; return true;
    }
};

template <class SH, class Epi>
__device__ __forceinline__ void gemm_phase(LAS unsigned char* lds, const Gemm g, const StaticOrder<SH::N / 256, SH::NZ>& S, const Epi& E, const int wid) {
    const int lane = lane_id_opaque(), tid = wid * 64 + lane,
               wr = wid >> 2, wc = wid & 3, fr = lane & 15, fq = lane >> 4;
    constexpr int K = SH::K, nt = K / BK;
    unsigned voffA[2], voffB[2];
#pragma unroll
    for (int i = 0; i < 2; ++i) { int R, C; stage_rc(tid * 16 + i * 8192, R, C); const int Rb = Epi::PERM ? ((R & ~31) + perm32(R & 31)) : R;
        voffA[i] = (unsigned)(R * SH::LDA + C) * 2u; voffB[i] = (unsigned)(Rb * SH::LDB + C) * 2u; }
    constexpr size_t kstep = (size_t)(BK * 2);
    constexpr size_t hstepA = (size_t)HALF * SH::LDA * 2, hstepB = (size_t)HALF * SH::LDB * 2;
    constexpr size_t tstepA = 2 * hstepA, tstepB = 2 * hstepB;
    const unsigned ldsw = (unsigned)wid * 1024u;
    const int aoff = lds_byte(wr * 64 + fr, fq * 8), boff = lds_byte(wc * 32 + fr, fq * 8);
#define PG8_SA(b, h) (((b) * 2 + (h)) * HTB)
#define PG8_SB(b, h) ((4 + (b) * 2 + (h)) * HTB)
#define PG8_STAGE(bufoff, gbase, voff) do { _Pragma("unroll") for (int _i = 0; _i < 2; ++_i) \
        __builtin_amdgcn_global_load_lds((const unsigned*)((const char*)(gbase) + (voff)[_i]), (LAS unsigned*)(lds + (bufoff) + ldsw + _i * 8192), 16, 0, 0); } while (0)
#define PG8_LDA(dst, b, h) do { _Pragma("unroll") for (int m = 0; m < 4; ++m) _Pragma("unroll") for (int k = 0; k < 2; ++k) dst[m][k] = *(const LAS f16x8*)(lds + PG8_SA(b, h) + aoff + m * 2048 + k * 1024); } while (0)
#define PG8_LDB(dst, b, h) do { _Pragma("unroll") for (int n = 0; n < 2; ++n) _Pragma("unroll") for (int k = 0; k < 2; ++k) dst[n][k] = *(const LAS f16x8*)(lds + PG8_SB(b, h) + boff + n * 2048 + k * 1024); } while (0)
#define PG8_MMA(ai, bj, At, Bt) do { __builtin_amdgcn_s_setprio(1); _Pragma("unroll") for (int m = 0; m < 4; ++m) _Pragma("unroll") for (int n = 0; n < 2; ++n) _Pragma("unroll") for (int k = 0; k < 2; ++k) \
        acc[ai][bj][m][n] = __builtin_amdgcn_mfma_f32_16x16x32_f16(Bt[n][k], At[m][k], acc[ai][bj][m][n], 0, 0, 0); __builtin_amdgcn_s_setprio(0); } while (0)
#define PG8_WAIT_V(n) asm volatile("s_waitcnt vmcnt(" #n ")" ::: "memory")
#define PG8_WAIT_L(n) asm volatile("s_waitcnt lgkmcnt(" #n ")" ::: "memory")
#define PG8_BAR __builtin_amdgcn_s_barrier()
#define PG8_SCHED __builtin_amdgcn_sched_barrier(0)
    Unit cur, nxt; int ui = 0;
    if (!S.next(0, cur)) return;
    f32x4 acc[2][2][4][2];
#pragma unroll
    for (int a = 0; a < 2; ++a)
#pragma unroll
        for (int b = 0; b < 2; ++b)
#pragma unroll
            for (int m = 0; m < 4; ++m)
#pragma unroll
                for (int n = 0; n < 2; ++n) acc[a][b][m][n] = (f32x4){0.f, 0.f, 0.f, 0.f};
    f16x8 At[4][2], B0[2][2], B1[2][2];
    const char* cA = (const char*)(g.A + (size_t)cur.kz * SH::AZS) + (size_t)cur.pm * tstepA;
    const char* cB = (const char*)(g.Bt + (size_t)cur.kz * SH::BZS) + (size_t)cur.pn * tstepB;
    PG8_STAGE(PG8_SB(0, 0), cB, voffB); PG8_STAGE(PG8_SB(0, 1), cB + hstepB, voffB); PG8_STAGE(PG8_SA(0, 0), cA, voffA); PG8_STAGE(PG8_SA(0, 1), cA + hstepA, voffA);
    if (wr == 1) PG8_BAR;
    PG8_WAIT_V(2); PG8_BAR;
    PG8_STAGE(PG8_SB(1, 0), cB + kstep, voffB); PG8_STAGE(PG8_SA(1, 0), cA + kstep, voffA); PG8_STAGE(PG8_SB(1, 1), cB + hstepB + kstep, voffB);
    PG8_WAIT_V(6); PG8_BAR;
    for (;;) {
        const bool has_next = S.next(ui + 1, nxt);
        const char* nA = has_next ? (const char*)(g.A + (size_t)nxt.kz * SH::AZS) + (size_t)nxt.pm * tstepA : cA;
        const char* nB = has_next ? (const char*)(g.Bt + (size_t)nxt.kz * SH::BZS) + (size_t)nxt.pn * tstepB : cB;
        for (int t = 0; t < nt; t += 2) {
            const bool last = (t == nt - 2);
            const char* a1 = cA + (size_t)(t + 1) * kstep;
            const char* a2 = last ? nA : cA + (size_t)(t + 2) * kstep; const char* b2 = last ? nB : cB + (size_t)(t + 2) * kstep;
            const char* a3 = a2 + kstep; const char* b3 = b2 + kstep;
            PG8_LDB(B0, 0, 0); PG8_LDB(B1, 0, 1); PG8_SCHED; PG8_LDA(At, 0, 0); PG8_STAGE(PG8_SA(1, 1), a1 + hstepA, voffA);
            PG8_WAIT_V(8); PG8_WAIT_L(0); PG8_BAR; PG8_MMA(0, 0, At, B0); PG8_MMA(0, 1, At, B1); PG8_BAR; PG8_SCHED;
            PG8_LDA(At, 0, 1); PG8_STAGE(PG8_SB(0, 0), b2, voffB); PG8_STAGE(PG8_SB(0, 1), b2 + hstepB, voffB); PG8_STAGE(PG8_SA(0, 0), a2, voffA);
            PG8_WAIT_V(8); PG8_WAIT_L(0); PG8_BAR; PG8_MMA(1, 0, At, B0); PG8_MMA(1, 1, At, B1); PG8_BAR; PG8_SCHED;
            PG8_LDB(B0, 1, 0); PG8_LDB(B1, 1, 1); PG8_SCHED; PG8_LDA(At, 1, 0); PG8_STAGE(PG8_SA(0, 1), a2 + hstepA, voffA);
            PG8_WAIT_V(8); PG8_WAIT_L(0); PG8_BAR; PG8_MMA(0, 0, At, B0); PG8_MMA(0, 1, At, B1); PG8_BAR; PG8_SCHED;
            PG8_LDA(At, 1, 1); PG8_STAGE(PG8_SB(1, 0), b3, voffB); PG8_STAGE(PG8_SB(1, 1), b3 + hstepB, voffB); PG8_STAGE(PG8_SA(1, 0), a3, voffA);
            PG8_WAIT_V(8); PG8_WAIT_L(0); PG8_BAR; PG8_MMA(1, 0, At, B0); PG8_MMA(1, 1, At, B1); PG8_BAR; PG8_SCHED;
        }
        if (wr == 0) PG8_BAR;
        E(acc, cur, wr, wc, fr, fq);
        if (!has_next) break;
#pragma unroll
        for (int a = 0; a < 2; ++a)
#pragma unroll
            for (int b = 0; b < 2; ++b)
#pragma unroll
                for (int m = 0; m < 4; ++m)
#pragma unroll
                    for (int n = 0; n < 2; ++n) acc[a][b][m][n] = (f32x4){0.f, 0.f, 0.f, 0.f};
        cur = nxt; cA = nA; cB = nB; ++ui;
        if (wr == 1) PG8_BAR;
    }
    PG8_WAIT_V(0);
    PG8_BAR;
#undef PG8_SA
#undef PG8_SB
#undef PG8_STAGE
#undef PG8_LDA
#undef PG8_LDB
#undef PG8_MMA
#undef PG8_WAIT_V
#undef PG8_WAIT_L
#undef PG8_BAR
#undef PG8_SCHED
}
}

constexpr int RING_BYTES = 131072;
constexpr int LDSCTL_OFF = RING_BYTES, MISC_OFF = LDSCTL_OFF + 320;
constexpr int LDS_BYTES = 147456;
constexpr int NWAVES = 8, NTHREADS = 512;

#define XB_TMO      128
#define XB_XCNT(j)  (256  + 64 * (j))
#define XB_XSUB(j)  (1280 + 64 * (j))
#define XB_XGEN(j)  (2304 + 64 * (j))
#define XB_TOP      3328
#define XB_TOPGEN   3392
#define XCD_BAR_WORDS 3456
#define XB_SPIN_CAP (1u << 24)
__device__ __forceinline__ unsigned xb_ld(unsigned* p)              { return __hip_atomic_load(p, __ATOMIC_RELAXED, __HIP_MEMORY_SCOPE_AGENT); }
__device__ __forceinline__ unsigned xb_add(unsigned* p, unsigned v) { return __hip_atomic_fetch_add(p, v, __ATOMIC_RELAXED, __HIP_MEMORY_SCOPE_AGENT); }
__device__ __forceinline__ unsigned xb_xcc_id() { return (unsigned)__builtin_amdgcn_s_getreg((3 << 11) | 20) & 0xFu; }
#define XB_SPIN(cond, bar) do { unsigned _sp = 0; while (cond) { __builtin_amdgcn_s_sleep(1); \
    if ((++_sp & 255u) == 0u) { if (xb_ld(&(bar)[XB_TMO])) break; if (_sp > XB_SPIN_CAP) { atomicAdd(&(bar)[XB_TMO], 1u); break; } } } } while (0)
struct XcdBarrier { unsigned* bar; unsigned x; volatile LAS unsigned* st; };
__device__ __forceinline__ XcdBarrier xcd_barrier_post(unsigned* bar, volatile LAS unsigned* st) {
    XcdBarrier b; b.bar = bar; b.x = xb_xcc_id(); b.st = st;
    if (threadIdx.x == 0) (void)xb_add(&bar[XB_XCNT(b.x)], 1u);
    return b;
}
__device__ __forceinline__ void xcd_barrier_complete(unsigned* bar, unsigned x, unsigned& nloc, unsigned& nx) {
    const unsigned G = gridDim.x * gridDim.y * gridDim.z;
    unsigned sum, cnt, mine, sp = 0u;
    for (;;) {
        sum = 0u; cnt = 0u; mine = 0u;
#pragma unroll
        for (unsigned j = 0; j < 16; ++j) { const unsigned c = xb_ld(&bar[XB_XCNT(j)]); sum += c; cnt += (c > 0u) ? 1u : 0u; mine = (j == x) ? c : mine; }
        if (sum == G) break;
        __builtin_amdgcn_s_sleep(1);
        if ((++sp & 255u) == 0u) { if (xb_ld(&bar[XB_TMO])) break; if (sp > XB_SPIN_CAP) { atomicAdd(&bar[XB_TMO], 1u); break; } }
    }
    nloc = mine > 0u ? mine : 1u; nx = cnt > 0u ? cnt : 1u;
}
__device__ __forceinline__ void xcd_barrier(const XcdBarrier& b) {
    asm volatile("s_waitcnt vmcnt(0)" ::: "memory");
    __syncthreads();
    if (threadIdx.x == 0) {
        unsigned* bar = b.bar;
        __builtin_amdgcn_s_waitcnt(0);
        unsigned nloc = b.st[0], nx = b.st[1];
        if (nloc == 0u) { xcd_barrier_complete(bar, b.x, nloc, nx); b.st[0] = nloc; b.st[1] = nx; }
        const unsigned old = xb_add(&bar[XB_XSUB(b.x)], 1u);
        const unsigned gen = old / nloc;
        if (old + 1u == (gen + 1u) * nloc) {
            __builtin_amdgcn_fence(__ATOMIC_RELEASE, "agent");
            asm volatile("s_waitcnt vmcnt(0)" ::: "memory");
            const unsigned og = xb_add(&bar[XB_TOP], 1u);
            const unsigned tg = og / nx;
            if (og + 1u == (tg + 1u) * nx) xb_add(&bar[XB_TOPGEN], 1u);
            else XB_SPIN(xb_ld(&bar[XB_TOPGEN]) == tg, bar);
            __builtin_amdgcn_fence(__ATOMIC_ACQUIRE, "agent");
            xb_add(&bar[XB_XGEN(b.x)], 1u);
            asm volatile("s_waitcnt vmcnt(0)" ::: "memory");
        } else {
            XB_SPIN(xb_ld(&bar[XB_XGEN(b.x)]) == gen, bar);
            __builtin_amdgcn_fence(__ATOMIC_ACQUIRE, "agent");
            asm volatile("s_waitcnt vmcnt(0)" ::: "memory");
        }
    }
    __syncthreads();
}

struct Args { const float* in[N_IN]; float* out; unsigned char* ws; int ph_lo, ph_hi; };
struct Frame {
    LAS unsigned char* lds;
    unsigned char* ws;
    const float* const* in;
    float* out;
    int tid, lane, wave, G, gw, NGW, bid, zin;
};
#define WSP(T, off) ((T*)(F.ws + (off)))
#define INP(i, l, per) (F.in[(i) + F.zin] + (size_t)(l) * (per))

__device__ __forceinline__ void transpose_item(const float* W, int K, int N, f16* WT, int k0, int n0, int drow0, const float* kscale, LAS float* scr, int lane) {
#pragma unroll 8
    for (int i = 0; i < 32; ++i) { const int kk = 2 * i + (lane >> 5); float v = W[(size_t)(k0 + kk) * N + n0 + (lane & 31)]; if (kscale) v *= kscale[k0 + kk]; scr[kk * 33 + (lane & 31)] = v; }
    LDS_WAIT(); asm volatile("" ::: "memory");
    const int c = lane & 7;
#pragma unroll
    for (int j = 0; j < 4; ++j) { const int n = (lane >> 3) + 8 * j; const LAS float* s = scr + (8 * c) * 33 + n;
        u32x4 o; o.x = pkh(s[0 * 33], s[1 * 33]); o.y = pkh(s[2 * 33], s[3 * 33]); o.z = pkh(s[4 * 33], s[5 * 33]); o.w = pkh(s[6 * 33], s[7 * 33]);
        *(u32x4*)(WT + (size_t)(drow0 + n) * K + k0 + 8 * c) = o; }
    LDS_WAIT(); asm volatile("" ::: "memory");
}

__device__ __forceinline__ void prologue_a(Frame& F) {
    LAS float* scr = (LAS float*)(F.lds + F.wave * 16384);
    const int lane = F.lane;
    constexpr int IT_IN = 32 * 595, IT_BR = 16 * 64, IT_OUT = 32 * 64, IT_UQ = 8 * 48, IT_UKV = 4 * 64;
    constexpr int IT_LAYER = IT_IN + 4 * IT_BR + IT_OUT + IT_UQ + IT_UKV;
    for (int it = F.gw; it < 2 * IT_LAYER; it += F.NGW) {
        const int l = it / IT_LAYER; int r = it % IT_LAYER;
        if (r < IT_IN) { const int kb = r / 595, nb = r % 595, n0 = nb * 32;
            transpose_item(INP(I_WIN, l, (size_t)DM * INW), DM, INW, WSP(f16, WS_WTIN) + (size_t)l * NTOT * DM, kb * 64, n0, n0 < C_MERGE ? n0 : n0 + (NPAD - C_MERGE), nullptr, scr, lane); continue; }
        r -= IT_IN;
        if (r < 4 * IT_BR) { const int kz = r / IT_BR, q = r % IT_BR, kb = q / 64, nb = q % 64;
            transpose_item(INP(I_WBR, l, (size_t)4 * 1024 * DM) + (size_t)kz * 1024 * DM, 1024, DM, WSP(f16, WS_WTBR) + ((size_t)l * 4 + kz) * DM * 1024, kb * 64, nb * 32, nb * 32,
                           kz == 0 ? INP(I_SNW, l, 1024) : nullptr, scr, lane); continue; }
        r -= 4 * IT_BR;
        if (r < IT_OUT) { const int kb = r / 64, nb = r % 64;
            transpose_item(INP(I_WOUT, l, (size_t)DM * DM), DM, DM, WSP(f16, WS_WTOUT) + (size_t)l * DM * DM, kb * 64, nb * 32, nb * 32, nullptr, scr, lane); continue; }
        r -= IT_OUT;
        if (r < IT_UQ) { const int kb = r / 48, nb = r % 48;
            transpose_item(INP(I_MWUQ, l, (size_t)512 * 1536), 512, 1536, WSP(f16, WS_WTUQ) + (size_t)l * 1536 * 512, kb * 64, nb * 32, nb * 32, INP(I_MQN, l, 512), scr, lane); continue; }
        r -= IT_UQ;
        { const int kb = r / 64, nb = r % 64;
            transpose_item(INP(I_MWUKV, l, (size_t)256 * 2048), 256, 2048, WSP(f16, WS_WTUKV) + (size_t)l * 2048 * 256, kb * 64, nb * 32, nb * 32, INP(I_MKVN, l, 256), scr, lane); }
    }
    for (int i = F.gw * 64 + lane; i < 2 * 40960; i += F.NGW * 64) { const int l = i / 40960, q = i % 40960;
        *(u32x4*)(WSP(f16, WS_WTIN) + ((size_t)l * NTOT + C_MERGE) * DM + (size_t)q * 8) = (u32x4){0u, 0u, 0u, 0u}; }
    {
        LAS float* sl = (LAS float*)F.lds;
        LAS float* part = (LAS float*)(F.lds + 5 * 2048 * 4);
        if (F.bid < 2 * 96) {
            __syncthreads();
            for (int i = F.tid; i < 5 * DM; i += NTHREADS) { const int j = i / DM, k = i % DM; sl[i] = siluf_(j < 4 ? F.in[F.zin + I_C][j * DM + k] : F.in[F.zin + I_CCTX][k]); }
            __syncthreads();
        }
        for (int it = F.bid; it < 2 * 96; it += F.G) {
            const int l = it / 96, n = (it % 96) * 64 + lane;
            const float* wa = INP(I_WADA, l, (size_t)DM * 6144) + n + (size_t)(F.wave * 256) * 6144;
            const LAS float* s0 = sl + F.wave * 256;
            float a0 = 0.f, a1 = 0.f, a2 = 0.f, a3 = 0.f, a4 = 0.f;
#pragma unroll 16
            for (int k = 0; k < 256; ++k) { const float w = wa[(size_t)k * 6144];
                a0 += s0[k] * w; a1 += s0[DM + k] * w; a2 += s0[2 * DM + k] * w; a3 += s0[3 * DM + k] * w; a4 += s0[4 * DM + k] * w; }
            LAS float* pw = part + F.wave * 320 + lane;
            pw[0] = a0; pw[64] = a1; pw[128] = a2; pw[192] = a3; pw[256] = a4;
            __syncthreads();
            if (F.tid < 320) { float t = 0.f;
#pragma unroll
                for (int w = 0; w < 8; ++w) t += part[w * 320 + F.tid];
                const int j = F.tid >> 6, nn = (it % 96) * 64 + (F.tid & 63);
                WSP(float, WS_MOD)[((size_t)l * 5 + j) * 6144 + nn] = t + INP(I_BADA, l, 6144)[nn]; }
            __syncthreads();
        }
        __syncthreads();
    }
    for (int i = F.gw * 64 + lane; i < 2048 * 32; i += F.NGW * 64) {
        const int p = i >> 5, f = i & 31;
        const float invf = powf(10000.0f, -(float)(f & 15) / 16.0f);
        const float ang = (float)(f < 16 ? (p >> 6) : (p & 63)) * invf;
        WSP(float, WS_ROPE)[i] = cosf(ang); WSP(float, WS_ROPE)[2048 * 32 + i] = sinf(ang);
    }
    for (int it = F.gw; it < 2 * 1152; it += F.NGW) {
        const int l = it / 1152, q = it % 1152, isctx = q >= 1024, m0 = 2 * (isctx ? q - 1024 : q), n = isctx ? 256 : 2048;
        const float* w1 = INP(I_HW1, l, 33 * 64); const float* w2 = INP(I_HW2, l, 64 * 64); const float* w3 = INP(I_HW3, l, 64 * 2048);
        float hd2[2], tt[2];
#pragma unroll
        for (int e = 0; e < 2; ++e) { const int m = m0 + e;
            const float t = (float)m / (float)(n - 1), wang = (6.283185307179586f / (float)n) * (float)m; tt[e] = t;
            float pre = INP(I_HB1, l, 64)[lane] + t * w1[lane];
#pragma unroll
            for (int i = 0; i < 16; ++i) { const float band = 1e-4f + (float)i * ((15.0f - 1e-4f) / 15.0f); const float a = band * wang;
                pre += cosf(a) * w1[(1 + i) * 64 + lane] - sinf(a) * w1[(17 + i) * 64 + lane]; }
            const float hd1 = sinf(INP(I_HFREQ, l, 128)[lane] * pre);
            float pre2 = INP(I_HB2, l, 64)[lane];
            for (int k = 0; k < 64; ++k) pre2 += __shfl(hd1, k) * w2[k * 64 + lane];
            hd2[e] = sinf(INP(I_HFREQ, l, 128)[64 + lane] * pre2); }
        float o0[32], o1[32];
#pragma unroll
        for (int cc = 0; cc < 32; ++cc) { o0[cc] = 0.f; o1[cc] = 0.f; }
#pragma unroll 2
        for (int k = 0; k < 64; ++k) { const float h0 = __shfl(hd2[0], k), h1 = __shfl(hd2[1], k);
#pragma unroll
            for (int cc = 0; cc < 32; ++cc) { const float w = w3[k * 2048 + cc * 64 + lane]; o0[cc] += h0 * w; o1[cc] += h1 * w; } }
        f16* hf = (f16*)(F.ws + WS_HF + (size_t)l * HF_LAYER + (isctx ? HF_LAT : 0));
#pragma unroll
        for (int cc = 0; cc < 32; ++cc) { const int c = cc * 64 + lane, ch = c & 1023;
            const float delta = fabsf(-15.350567286626973f + (float)ch * ((-3.0701134573253945f + 15.350567286626973f) / 1023.0f));
#pragma unroll
            for (int e = 0; e < 2; ++e) { const int m = m0 + e; const float o = (e ? o1[cc] : o0[cc]) * expf(-tt[e] * delta);
                if (cc < 16) hf[(size_t)(n - m) * 1024 + ch] = (f16)o;
                else if (m >= 1) hf[(size_t)(n + m) * 1024 + ch] = (f16)o;
                if (m == 0 && cc < 16) hf[ch] = (f16)0.f; } }
    }
}

__device__ __forceinline__ void row_stats(const f32x4 (&v)[8], float& mean, float& rstd) {
    float s = 0.f;
#pragma unroll
    for (int j = 0; j < 8; ++j) s += (v[j][0] + v[j][1]) + (v[j][2] + v[j][3]);
    mean = wave_sum(s) * (1.f / DM); float s2 = 0.f;
#pragma unroll
    for (int j = 0; j < 8; ++j) { const f32x4 d = v[j] - mean; s2 += (d[0] * d[0] + d[1] * d[1]) + (d[2] * d[2] + d[3] * d[3]); }
    rstd = 1.0f / sqrtf(wave_sum(s2) * (1.f / DM) + LN_EPS);
}
__device__ __forceinline__ void write_h_row(Frame& F, const f32x4 (&v)[8], int row, int l) {
    float mean, rstd; row_stats(v, mean, rstd);
    const int bidx = row < NLAT ? row / SEQ : 4;
    const float* mo = WSP(float, WS_MOD) + ((size_t)l * 5 + bidx) * 6144;
    f16* hr = WSP(f16, WS_H) + (size_t)row * DM;
#pragma unroll
    for (int j = 0; j < 8; ++j) { const int col = 4 * F.lane + 256 * j;
        const f32x4 sh = *(const f32x4*)(mo + col), sc = *(const f32x4*)(mo + 2048 + col);
        const f32x4 h = (v[j] - mean) * rstd * (sc + 1.0f) + sh;
        u32x2 w; w.x = pkh(h[0], h[1]); w.y = pkh(h[2], h[3]); *(u32x2*)(hr + col) = w; }
}
__device__ __forceinline__ void prologue_b(Frame& F) {
    for (int row = F.gw; row < MROWS; row += F.NGW) {
        const float* xr = row < NLAT ? F.in[F.zin + I_X] + (size_t)row * DM : F.in[F.zin + I_CTX] + (size_t)(row - NLAT) * DM;
        f32x4 v[8];
#pragma unroll
        for (int j = 0; j < 8; ++j) v[j] = *(const f32x4*)(xr + 4 * F.lane + 256 * j);
        write_h_row(F, v, row, 0);
    }
}
__device__ __forceinline__ void ln_phase(Frame& F, int l) {
    const int nrows = (l == DEPTH - 1) ? NLAT : MROWS;
    const float* lg = INP(I_LNG, l, DM); const float* lb = INP(I_LNB, l, DM);
    for (int row = F.gw; row < nrows; row += F.NGW) {
        const float* yr = WSP(float, WS_Y) + (size_t)row * DM;
        f32x4 v[8];
#pragma unroll
        for (int j = 0; j < 8; ++j) v[j] = *(const f32x4*)(yr + 4 * F.lane + 256 * j);
        float mean, rstd; row_stats(v, mean, rstd);
        float* xo = (l == DEPTH - 1) ? F.out + (size_t)row * DM : WSP(float, WS_X1) + (size_t)row * DM;
#pragma unroll
        for (int j = 0; j < 8; ++j) { const int col = 4 * F.lane + 256 * j;
            v[j] = (v[j] - mean) * rstd * *(const f32x4*)(lg + col) + *(const f32x4*)(lb + col);
            *(f32x4*)(xo + col) = v[j]; }
        if (l < DEPTH - 1) write_h_row(F, v, row, l + 1);
    }
}

struct EpiInProj {
    static constexpr bool PERM = true;
    f16* P; f16* G;
    __device__ __forceinline__ void operator()(const f32x4 (&acc)[2][2][4][2], const pg8::Unit& u, int wr, int wc, int fr, int fq) const {
        const int row0 = u.pm * 256 + wr * 64 + fr;
        const bool sig = u.pn >= NPT;
        f16* base = sig ? G : P; const int ld = sig ? NGATE : NPAD;
        const int col0 = (sig ? u.pn - NPT : u.pn) * 256 + wc * 32 + 8 * fq;
#pragma unroll
        for (int ai = 0; ai < 2; ++ai)
#pragma unroll
            for (int m = 0; m < 4; ++m) { f16* rowp = base + (size_t)(row0 + ai * 128 + m * 16) * ld + col0;
#pragma unroll
                for (int bj = 0; bj < 2; ++bj) { f32x4 v0 = acc[ai][bj][m][0], v1 = acc[ai][bj][m][1];
                    if (sig) {
#pragma unroll
                        for (int e = 0; e < 4; ++e) { v0[e] = sigmoidf_(v0[e]); v1[e] = sigmoidf_(v1[e]); } }
                    *(u32x4*)(rowp + bj * 128) = pkh8(v0, v1); } }
    }
};
struct EpiRowScale {
    static constexpr bool PERM = true;
    f16* O; int ldc; const float* rs;
    __device__ __forceinline__ void operator()(const f32x4 (&acc)[2][2][4][2], const pg8::Unit& u, int wr, int wc, int fr, int fq) const {
        const int row0 = u.pm * 256 + wr * 64 + fr, col0 = u.pn * 256 + wc * 32 + 8 * fq;
#pragma unroll
        for (int ai = 0; ai < 2; ++ai)
#pragma unroll
            for (int m = 0; m < 4; ++m) { const int row = row0 + ai * 128 + m * 16; const float s = rs[row]; f16* rowp = O + (size_t)row * ldc + col0;
#pragma unroll
                for (int bj = 0; bj < 2; ++bj) *(u32x4*)(rowp + bj * 128) = pkh8(acc[ai][bj][m][0] * s, acc[ai][bj][m][1] * s); }
    }
};
struct EpiMerge {
    static constexpr bool PERM = true;
    const f16* G; float* part; f16* MIX;
    __device__ __forceinline__ void operator()(const f32x4 (&acc)[2][2][4][2], const pg8::Unit& u, int wr, int wc, int fr, int fq) const {
        const int row0 = u.pm * 256 + wr * 64 + fr, col0 = u.pn * 256 + wc * 32 + 8 * fq;
#pragma unroll
        for (int ai = 0; ai < 2; ++ai)
#pragma unroll
            for (int m = 0; m < 4; ++m) { const int row = row0 + ai * 128 + m * 16;
#pragma unroll
                for (int bj = 0; bj < 2; ++bj) { const int col = col0 + bj * 128;
                    const f16x8 gt = *(const f16x8*)(G + (size_t)row * NGATE + u.kz * 2048 + col);
                    f32x4 v0 = acc[ai][bj][m][0], v1 = acc[ai][bj][m][1];
#pragma unroll
                    for (int e = 0; e < 4; ++e) { v0[e] *= (float)gt[e]; v1[e] *= (float)gt[4 + e]; }
                    float* pp = part + (size_t)row * DM + col;
                    if (u.kz > 0) { v0 += *(const f32x4*)pp; v1 += *(const f32x4*)(pp + 4); }
                    if (u.kz < 3) { *(f32x4*)pp = v0; *(f32x4*)(pp + 4) = v1; }
                    else *(u32x4*)(MIX + (size_t)row * DM + col) = pkh8(v0, v1); } }
    }
};
struct EpiOut {
    static constexpr bool PERM = false;
    const float* res_lat; const float* res_ctx; const float* mod; float* Y;
    __device__ __forceinline__ void operator()(const f32x4 (&acc)[2][2][4][2], const pg8::Unit& u, int wr, int wc, int fr, int fq) const {
        const int row0 = u.pm * 256 + wr * 64 + fr, col0 = u.pn * 256 + wc * 32 + 4 * fq;
        const bool lat = u.pm < NLAT / 256;
        const float* res = lat ? res_lat : res_ctx - (size_t)NLAT * DM;
        const float* gv = mod + (size_t)(lat ? u.pm / 8 : 4) * 6144 + 4096;
        f32x4 g4[2][2];
#pragma unroll
        for (int bj = 0; bj < 2; ++bj)
#pragma unroll
            for (int n = 0; n < 2; ++n) g4[bj][n] = *(const f32x4*)(gv + col0 + bj * 128 + n * 16);
#pragma unroll
        for (int ai = 0; ai < 2; ++ai)
#pragma unroll
            for (int m = 0; m < 4; ++m) { const size_t off = (size_t)(row0 + ai * 128 + m * 16) * DM + col0;
#pragma unroll
                for (int bj = 0; bj < 2; ++bj)
#pragma unroll
                    for (int n = 0; n < 2; ++n) { const f32x4 r = *(const f32x4*)(res + off + bj * 128 + n * 16);
                        *(f32x4*)(Y + off + bj * 128 + n * 16) = r * DN_ALPHA + g4[bj][n] * acc[ai][bj][m][n]; } }
    }
};

constexpr size_t SA_U = 0, SA_DT = (size_t)MROWS * 1536 * 4, SA_KPE = SA_DT + (size_t)MROWS * 32 * 4, SA_GK = SA_KPE + (size_t)MROWS * 64 * 4;
static_assert(SA_GK + (size_t)MROWS * 128 * 4 <= SA_BYTES, "scratch A");

__device__ __forceinline__ bool has_prev(int row) { return row < NLAT ? (row & (SEQ - 1)) != 0 : ((row - NLAT) & (CTXL - 1)) != 0; }
__device__ __forceinline__ bool has_next(int row) { return row < NLAT ? (row & (SEQ - 1)) != SEQ - 1 : ((row - NLAT) & (CTXL - 1)) != CTXL - 1; }
__device__ __forceinline__ float conv3(const f16* P, int row, int col, const float* w, int wc, int nch, float bias) {
    float a = w[nch + wc] * (float)P[(size_t)row * NPAD + col] + bias;
    if (has_prev(row)) a += w[wc] * (float)P[(size_t)(row - 1) * NPAD + col];
    if (has_next(row)) a += w[2 * nch + wc] * (float)P[(size_t)(row + 1) * NPAD + col];
    return a;
}
__device__ __forceinline__ void prep_naive(Frame& F, int l) {
    const f16* P = WSP(f16, WS_P); f16* Pw = WSP(f16, WS_P);
    const int gt = F.gw * 64 + F.lane, NT = F.NGW * 64;
    float* U = (float*)(F.ws + WS_SA + SA_U); float* DT = (float*)(F.ws + WS_SA + SA_DT);
    float* HW = (float*)(F.ws + WS_SB); float* HM = HW + (size_t)MROWS * 1024;
    const float* scw = INP(I_SCW, l, 3 * 1536); const float* scb = INP(I_SCB, l, 1536);
    const float* hcw = INP(I_HCW, l, 3 * 3072); const float* hcb = INP(I_HCB, l, 3072);
    const float* cosT = WSP(float, WS_ROPE); const float* sinT = cosT + 2048 * 32;
#if !USE_MFMA_SSD
    for (int i = gt; i < MROWS * 1536; i += NT) { const int row = i / 1536, c = i % 1536;
        U[i] = siluf_(conv3(P, row, C_XBC + c, scw, c, 1536, scb[c])); }
    for (int i = gt; i < MROWS * 32; i += NT) { const int row = i >> 5, j = i & 31;
        DT[i] = softplusf_((float)P[(size_t)row * NPAD + C_DT + j] + INP(I_SDTB, l, 32)[j]); }
#endif
    for (int row = F.gw; row < MROWS; row += F.NGW) {
        float sq = 0.f, sk = 0.f;
#pragma unroll
        for (int j = 0; j < 8; ++j) { const float v = (float)P[(size_t)row * NPAD + C_CQ + j * 64 + F.lane]; sq += v * v; }
#pragma unroll
        for (int j = 0; j < 4; ++j) { const float v = (float)P[(size_t)row * NPAD + C_CKV + j * 64 + F.lane]; sk += v * v; }
        sq = wave_sum(sq); sk = wave_sum(sk);
        if (F.lane == 0) { WSP(float, WS_RS)[row] = 1.0f / sqrtf(sq * (1.f / 512.f) + LN_EPS); WSP(float, WS_RS)[MROWS + row] = 1.0f / sqrtf(sk * (1.f / 256.f) + LN_EPS); }
    }
    for (int i = gt; i < NLAT * 32; i += NT) { const int row = i >> 5, f = i & 31, p = row & (SEQ - 1);
        f16* a = Pw + (size_t)row * NPAD + C_KPE; const float c = cosT[p * 32 + f], s = sinT[p * 32 + f], t1 = (float)a[f], t2 = (float)a[32 + f];
        a[f] = (f16)(t1 * c - t2 * s); a[32 + f] = (f16)(t1 * s + t2 * c); }
    for (int i = gt; i < NLAT * 64; i += NT) { const int row = i >> 6, kv = (i >> 5) & 1, f = i & 31, p = row & (SEQ - 1);
        f16* a = Pw + (size_t)row * NPAD + C_GK + kv * 64; const float c = cosT[p * 32 + f], s = sinT[p * 32 + f], t1 = (float)a[f], t2 = (float)a[32 + f];
        a[f] = (f16)(t1 * c - t2 * s); a[32 + f] = (f16)(t1 * s + t2 * c); }
#if !USE_MFMA_HY
    for (int i = gt; i < MROWS * 1024; i += NT) { const int row = i >> 10, c = i & 1023;
        const float x0 = conv3(P, row, C_HXV + c, hcw, c, 3072, hcb[c]);
        const float x1 = conv3(P, row, C_HXV + 1024 + c, hcw, 1024 + c, 3072, hcb[1024 + c]);
        const float v = conv3(P, row, C_HXV + 2048 + c, hcw, 2048 + c, 3072, hcb[2048 + c]);
        HW[i] = x1 * v; HM[i] = x0 * siluf_((float)P[(size_t)row * NPAD + C_HZ + c]); }
#endif
}

__device__ __forceinline__ void ssd_naive(Frame& F, int l) {
    const float* U = (const float*)(F.ws + WS_SA + SA_U); const float* DT = (const float*)(F.ws + WS_SA + SA_DT);
    float* YD = WSP(float, WS_Y);
    LAS float* tile = (LAS float*)F.lds;
    for (int item = F.bid; item < 256; item += F.G) {
        const int b = item >> 6, h = (item >> 2) & 15, dir = (item >> 1) & 1, ph = item & 1, g = h >> 3;
        const float a = -expf(INP(I_SALOG, l, 32)[dir * 16 + h]);
        const int pl = F.tid >> 4, nc = F.tid & 15;
        float st[8];
#pragma unroll
        for (int j = 0; j < 8; ++j) st[j] = 0.f;
        for (int s0 = 0; s0 < CTXL + SEQ; s0 += 16) {
            __syncthreads();
            for (int e = F.tid; e < 16 * 290; e += NTHREADS) { const int k = e / 290, q = e % 290, s = s0 + k;
                int row; if (s < CTXL) row = NLAT + b * CTXL + (dir ? CTXL - 1 - s : s); else row = b * SEQ + (dir ? SEQ - 1 - (s - CTXL) : (s - CTXL));
                float v;
                if (q < 32) v = U[(size_t)row * 1536 + h * 64 + ph * 32 + q];
                else if (q < 160) v = U[(size_t)row * 1536 + 1024 + g * 128 + (q - 32)];
                else if (q < 288) v = U[(size_t)row * 1536 + 1280 + g * 128 + (q - 160)];
                else if (q == 288) v = DT[(size_t)row * 32 + dir * 16 + h];
                else v = __int_as_float(row);
                tile[k * 292 + q] = v; }
            __syncthreads();
            for (int k = 0; k < 16; ++k) {
                const LAS float* tk = tile + k * 292;
                const float dtv = tk[288], dec = expf(dtv * a), xv = tk[pl] * dtv;
                float yp = 0.f;
#pragma unroll
                for (int j = 0; j < 8; ++j) { st[j] = dec * st[j] + xv * tk[32 + nc * 8 + j]; yp += st[j] * tk[160 + nc * 8 + j]; }
                yp += __shfl_xor(yp, 1); yp += __shfl_xor(yp, 2); yp += __shfl_xor(yp, 4); yp += __shfl_xor(yp, 8);
                if (nc == 0) { const int row = __float_as_int(tk[289]); YD[((size_t)dir * MROWS + row) * 1024 + h * 64 + ph * 32 + pl] = yp; }
            }
        }
        __syncthreads();
    }
}
__device__ __forceinline__ void ssd_gate_naive(Frame& F, int l) {
    const f16* P = WSP(f16, WS_P); const float* U = (const float*)(F.ws + WS_SA + SA_U); const float* YD = WSP(float, WS_Y);
    f16* GT = WSP(f16, WS_GATED);
    const int nrows = l == 0 ? MROWS : NLAT;
    for (int row = F.gw; row < nrows; row += F.NGW) {
        float gv[16]; float ss = 0.f;
#pragma unroll
        for (int j = 0; j < 16; ++j) { const int c = F.lane * 16 + j;
            const float y = YD[(size_t)row * 1024 + c] + YD[((size_t)MROWS + row) * 1024 + c] + U[(size_t)row * 1536 + c] * INP(I_SD, l, 16)[c >> 6];
            const float g = y * siluf_((float)P[(size_t)row * NPAD + C_SZ + c]); gv[j] = g; ss += g * g; }
#pragma unroll
        for (int o = 1; o < 32; o <<= 1) ss += __shfl_xor(ss, o);
        const float r = 1.0f / sqrtf(ss * (1.f / 512.f) + LN_EPS);
#pragma unroll
        for (int j = 0; j < 16; ++j) GT[(size_t)row * 1024 + F.lane * 16 + j] = (f16)(gv[j] * r);
    }
}
__device__ __forceinline__ void gqa_naive(Frame& F, int l) {
    const f16* P = WSP(f16, WS_P);
    const float* cosT = WSP(float, WS_ROPE); const float* sinT = cosT + 2048 * 32;
    f16* GT = WSP(f16, WS_GATED) + (size_t)2 * MROWS * 1024;
    const int nrows = l == 0 ? MROWS : NLAT;
    const int d = F.lane, f = d & 31;
    for (int it = F.gw; it < nrows * 16; it += F.NGW) {
        const int row = it >> 4, hq = it & 15, kv = hq >> 3;
        const bool lat = row < NLAT; const int b = lat ? row / SEQ : (row - NLAT) / CTXL, p = row & (SEQ - 1);
        const float t1 = (float)P[(size_t)row * NPAD + C_GQ + hq * 64 + f], t2 = (float)P[(size_t)row * NPAD + C_GQ + hq * 64 + 32 + f];
        float q;
        if (lat) { const float c = cosT[p * 32 + f], s = sinT[p * 32 + f]; q = d < 32 ? t1 * c - t2 * s : t1 * s + t2 * c; } else q = d < 32 ? t1 : t2;
        q *= 0.125f;
        float m = INP(I_GSINK, l, 16)[hq], lsum = 1.0f, acc = 0.f;
        const int nkeys = CTXL + (lat ? (min(p + 128, SEQ - 1) - max(p - 128, 0) + 1) : 0);
        for (int j = 0; j < nkeys; ++j) {
            const int krow = j < CTXL ? NLAT + b * CTXL + j : b * SEQ + max(p - 128, 0) + (j - CTXL);
            const float s = wave_sum(q * (float)P[(size_t)krow * NPAD + C_GK + kv * 64 + d]);
            const float v = (float)P[(size_t)krow * NPAD + C_GV + kv * 64 + d];
            const float mn = fmaxf(m, s), corr = fast_exp(m - mn), pe = fast_exp(s - mn);
            lsum = lsum * corr + pe; acc = acc * corr + pe * v; m = mn;
        }
        const float y = acc / lsum;
        GT[(size_t)row * 1024 + hq * 64 + d] = (f16)(y * siluf_((float)P[(size_t)row * NPAD + C_GZ + hq * 64 + d]));
    }
}
__device__ __forceinline__ void mla_naive(Frame& F, int l) {
    const f16* P = WSP(f16, WS_P); const f16* QM = WSP(f16, WS_QM); const f16* KVM = WSP(f16, WS_KVM);
    const float* cosT = WSP(float, WS_ROPE); const float* sinT = cosT + 2048 * 32;
    f16* GT = WSP(f16, WS_GATED) + (size_t)1 * MROWS * 1024;
    const int nrows = l == 0 ? MROWS : NLAT;
    const int d = F.lane, f = d & 31;
    const float scale = 0.07216878364870322f;
    for (int it = F.gw; it < nrows * 8; it += F.NGW) {
        const int row = it >> 3, h = it & 7;
        const bool lat = row < NLAT; const int b = lat ? row / SEQ : (row - NLAT) / CTXL, p = row & (SEQ - 1);
        const f16* qr = QM + (size_t)row * 1536 + h * 192;
        const float q0 = (float)qr[d] * scale, q1 = (float)qr[64 + d] * scale;
        const float t1 = (float)qr[128 + f], t2 = (float)qr[128 + 32 + f];
        float qp;
        if (lat) { const float c = cosT[p * 32 + f], s = sinT[p * 32 + f]; qp = d < 32 ? t1 * c - t2 * s : t1 * s + t2 * c; } else qp = d < 32 ? t1 : t2;
        qp *= scale;
        float m = -1e30f, lsum = 0.f, a0 = 0.f, a1 = 0.f;
        const int nkeys = CTXL + (lat ? SEQ : 0);
        for (int j = 0; j < nkeys; ++j) {
            const int krow = j < CTXL ? NLAT + b * CTXL + j : b * SEQ + (j - CTXL);
            const f16* kr = KVM + (size_t)krow * 2048 + h * 256;
            const float s = wave_sum(q0 * (float)kr[d] + q1 * (float)kr[64 + d] + qp * (float)P[(size_t)krow * NPAD + C_KPE + d]);
            const float v0 = (float)kr[128 + d], v1 = (float)kr[192 + d];
            const float mn = fmaxf(m, s), corr = fast_exp(m - mn), pe = fast_exp(s - mn);
            lsum = lsum * corr + pe; a0 = a0 * corr + pe * v0; a1 = a1 * corr + pe * v1; m = mn;
        }
        const float inv = 1.0f / lsum;
        const f16* zr = P + (size_t)row * NPAD + C_MZ + h * 128;
        GT[(size_t)row * 1024 + h * 128 + d] = (f16)(a0 * inv * siluf_((float)zr[d]));
        GT[(size_t)row * 1024 + h * 128 + 64 + d] = (f16)(a1 * inv * siluf_((float)zr[64 + d]));
    }
}
__device__ __forceinline__ void hyena_naive(Frame& F, int l) {
    const float* HW = (const float*)(F.ws + WS_SB); const float* HM = HW + (size_t)MROWS * 1024;
    f16* GT = WSP(f16, WS_GATED) + (size_t)3 * MROWS * 1024;
    const int nlat_items = NB * (SEQ / 8) * 16, nctx_items = (l == 0) ? NB * (CTXL / 8) * 16 : 0;
    for (int it = F.bid; it < nlat_items + nctx_items; it += F.G) {
        const bool isctx = it >= nlat_items; const int q = isctx ? it - nlat_items : it;
        const int n = isctx ? CTXL : SEQ, cg = q & 15, pb = (q >> 4) % (n / 8), b = (q >> 4) / (n / 8);
        const int i = pb * 8 + F.wave, c = cg * 64 + F.lane;
        const int row0 = isctx ? NLAT + b * CTXL : b * SEQ;
        const f16* hf = (const f16*)(F.ws + WS_HF + (size_t)l * HF_LAYER + (isctx ? HF_LAT : 0));
        float acc = 0.f;
#pragma unroll 4
        for (int j = 0; j < n; ++j) acc += (float)hf[(size_t)(n - (i - j)) * 1024 + c] * HW[(size_t)(row0 + j) * 1024 + c];
        const size_t o = (size_t)(row0 + i) * 1024 + c;
        GT[o] = (f16)(HM[o] * (acc + HW[o] * INP(I_HD, l, 1024)[c]));
    }
}

namespace att {
typedef short s16x4 __attribute__((ext_vector_type(4)));
__device__ __forceinline__ int crow(int r, int hi) { return (r & 3) + 8 * (r >> 2) + 4 * hi; }
#define ATT_SBAR() __builtin_amdgcn_sched_barrier(0)
__device__ __forceinline__ int v_rd_base(int lane) { return ((lane & 3) << 3) | (((lane >> 2) & 3) << 6) | (((lane >> 4) & 1) << 5) | (((lane >> 5) & 1) << 8); }
template <int OFF> __device__ __forceinline__ s16x4 tr_read(int vb) { s16x4 r; asm volatile("ds_read_b64_tr_b16 %0, %1 offset:%2" : "=&v"(r) : "v"(vb), "i"(OFF) : "memory"); return r; }

template <bool MLA> struct Cfg {
    static constexpr int DQK = MLA ? 192 : 64, DV = MLA ? 128 : 64, NCB = DV / 32, ND0 = DQK / 16;
    static constexpr int KROWB = DQK * 2 + 16, SHM_K = 64 * KROWB, SHM_V = 64 * DV * 2;
    static constexpr int OFF_V = 0, OFF_K = 2 * SHM_V, OFF_WS = 2 * SHM_V + 2 * SHM_K, OFF_Q = OFF_WS + 8 * 64 * 4, LDS_TOTAL = OFF_Q + (MLA ? 8 * 32 * 144 : 0);
    static constexpr int NREG = MLA ? 8 : 4;
};
template <int NCB> __device__ __forceinline__ int v_st(int k, int c) { const int kk = (k & ~0xC) | ((k & 4) << 1) | ((k & 8) >> 1); return ((kk >> 3) * NCB + (c >> 5)) * 512 + ((kk & 7) * 32 + (c & 31)) * 2; }

__device__ __forceinline__ void partialSM(f32x16& p0, f32x16& p1, float& m_reg, float& alpha, const float C, const float thr_raw) {
    float pmax = p0[0];
#pragma unroll
    for (int r = 1; r < 16; ++r) pmax = fmaxf(pmax, p0[r]);
#pragma unroll
    for (int r = 0; r < 16; ++r) pmax = fmaxf(pmax, p1[r]);
    { auto rr = __builtin_amdgcn_permlane32_swap(__float_as_uint(pmax), __float_as_uint(pmax), false, false); pmax = fmaxf(__uint_as_float(rr[0]), __uint_as_float(rr[1])); }
    float mn;
    if (__builtin_expect(__all(pmax - m_reg <= thr_raw), 1)) { mn = m_reg; alpha = 1.f; }
    else { mn = fmaxf(m_reg, pmax); alpha = __builtin_amdgcn_exp2f((m_reg - mn) * C); m_reg = mn; }
    const float mnC = -mn * C;
#pragma unroll
    for (int r = 0; r < 16; ++r) p0[r] = fmaf(p0[r], C, mnC);
#pragma unroll
    for (int r = 0; r < 16; ++r) p1[r] = fmaf(p1[r], C, mnC);
#pragma unroll
    for (int r = 0; r < 16; ++r) p0[r] = __builtin_amdgcn_exp2f(p0[r]);
}
__device__ __forceinline__ void finishSM(f32x16& p0, f32x16& p1, float alpha, float& l_reg, f16x8& pa0, f16x8& pa1, f16x8& pa2, f16x8& pa3) {
#pragma unroll
    for (int r = 0; r < 16; ++r) p1[r] = __builtin_amdgcn_exp2f(p1[r]);
    float ps = 0;
#pragma unroll
    for (int r = 0; r < 16; ++r) ps += p0[r];
#pragma unroll
    for (int r = 0; r < 16; ++r) ps += p1[r];
    { auto rr = __builtin_amdgcn_permlane32_swap(__float_as_uint(ps), __float_as_uint(ps), false, false); ps = __uint_as_float(rr[0]) + __uint_as_float(rr[1]); }
    l_reg = l_reg * alpha + ps;
#define ATT_PK4(P, BASE, OUT) do { unsigned a0 = pkh(P[BASE + 0], P[BASE + 1]), a1 = pkh(P[BASE + 2], P[BASE + 3]); \
    unsigned b0 = pkh(P[BASE + 4], P[BASE + 5]), b1 = pkh(P[BASE + 6], P[BASE + 7]); \
    auto r0 = __builtin_amdgcn_permlane32_swap(a0, b0, false, false); auto r1 = __builtin_amdgcn_permlane32_swap(a1, b1, false, false); \
    u32x4 w = {r0[0], r1[0], r0[1], r1[1]}; OUT = __builtin_bit_cast(f16x8, w); } while (0)
    ATT_PK4(p0, 0, pa0); ATT_PK4(p0, 8, pa1); ATT_PK4(p1, 0, pa2); ATT_PK4(p1, 8, pa3);
#undef ATT_PK4
}
template <int ND0, int NREG, int KROWB> __device__ __forceinline__ void qkt(f32x16& p0, f32x16& p1, const LAS char* Ks, const f16x8* qr, const LAS char* ql, int r32, int hi) {
    p0 = f32x16{}; p1 = f32x16{};
#pragma unroll
    for (int d0 = 0; d0 < ND0; ++d0) { const int cb = (d0 * 16 + hi * 8) * 2;
        const f16x8 b0 = *(const LAS f16x8*)(Ks + r32 * KROWB + cb);
        const f16x8 b1 = *(const LAS f16x8*)(Ks + (32 + r32) * KROWB + cb);
        f16x8 qf; if (d0 < NREG) qf = qr[d0 < NREG ? d0 : 0]; else qf = *(const LAS f16x8*)(ql + (d0 - NREG) * 32);
        p0 = __builtin_amdgcn_mfma_f32_32x32x16_f16(b0, qf, p0, 0, 0, 0);
        p1 = __builtin_amdgcn_mfma_f32_32x32x16_f16(b1, qf, p1, 0, 0, 0); }
}
template <int NCB, int D0> __device__ __forceinline__ void pv_one(f32x16& od, int vb, f16x8 pa0, f16x8 pa1, f16x8 pa2, f16x8 pa3) {
    constexpr int KS = 2 * NCB * 512, HF = NCB * 512, B0 = D0 * 512;
    const s16x4 l0 = tr_read<B0 + 0 * KS>(vb), h0 = tr_read<B0 + 0 * KS + HF>(vb), l1 = tr_read<B0 + 1 * KS>(vb), h1 = tr_read<B0 + 1 * KS + HF>(vb);
    const s16x4 l2 = tr_read<B0 + 2 * KS>(vb), h2 = tr_read<B0 + 2 * KS + HF>(vb), l3 = tr_read<B0 + 3 * KS>(vb), h3 = tr_read<B0 + 3 * KS + HF>(vb);
    asm volatile("s_waitcnt lgkmcnt(0)" ::: "memory"); ATT_SBAR();
#define ATT_PK(L, H) __builtin_bit_cast(f16x8, (short __attribute__((ext_vector_type(8)))){L[0], L[1], L[2], L[3], H[0], H[1], H[2], H[3]})
    od = __builtin_amdgcn_mfma_f32_32x32x16_f16(pa0, ATT_PK(l0, h0), od, 0, 0, 0);
    od = __builtin_amdgcn_mfma_f32_32x32x16_f16(pa1, ATT_PK(l1, h1), od, 0, 0, 0);
    od = __builtin_amdgcn_mfma_f32_32x32x16_f16(pa2, ATT_PK(l2, h2), od, 0, 0, 0);
    od = __builtin_amdgcn_mfma_f32_32x32x16_f16(pa3, ATT_PK(l3, h3), od, 0, 0, 0);
#undef ATT_PK
}
template <int NCB> __device__ __forceinline__ void pv_all(f32x16* o, int vb, f16x8 pa0, f16x8 pa1, f16x8 pa2, f16x8 pa3) {
    pv_one<NCB, 0>(o[0], vb, pa0, pa1, pa2, pa3); pv_one<NCB, 1>(o[1], vb, pa0, pa1, pa2, pa3);
    if constexpr (NCB == 4) { pv_one<NCB, 2>(o[2], vb, pa0, pa1, pa2, pa3); pv_one<NCB, 3>(o[3], vb, pa0, pa1, pa2, pa3); }
}

struct UnitDesc { int b, h, qb, isctx, hp; };
template <bool MLA>
__device__ __forceinline__ void attn_unit(Frame& F, const UnitDesc u, int l, LAS char* lds) {
    typedef Cfg<MLA> C_;
    constexpr int DQK = C_::DQK, DV = C_::DV, NCB = C_::NCB, ND0 = C_::ND0, KROWB = C_::KROWB, NREG = C_::NREG;
    const int tid = F.tid, wid = F.wave, lane = F.lane, r32 = lane & 31, hi = lane >> 5;
    LAS char* V_lds = lds + C_::OFF_V; LAS char* K_lds = lds + C_::OFF_K;
    LAS float* ws = (LAS float*)(lds + C_::OFF_WS) + wid * 64; LAS float* li_l = ws; LAS float* al_l = ws + 32;
    const f16* P = WSP(f16, WS_P); const f16* KVM = WSP(f16, WS_KVM);
    const float scale = MLA ? 0.07216878364870322f : 0.125f, Cc = scale * 1.4426950408889634f, thr_raw = 8.0f / scale;
    int qrow0, qpos0, hq;
    if constexpr (MLA) { hq = u.h; qpos0 = u.qb * 256 + wid * 32; qrow0 = (u.isctx ? NLAT + u.b * CTXL : u.b * SEQ) + qpos0; }
    else { hq = u.h * 8 + u.hp * 2 + (wid >> 2); qpos0 = u.qb * 128 + (wid & 3) * 32; qrow0 = (u.isctx ? NLAT + u.b * CTXL : u.b * SEQ) + qpos0; }
    f16x8 qr[ND0];
    { const f16* Qw = MLA ? WSP(f16, WS_QM) + (size_t)(qrow0 + r32) * 1536 + hq * 192 + hi * 8 : P + (size_t)(qrow0 + r32) * NPAD + C_GQ + hq * 64 + hi * 8;
#pragma unroll
      for (int d0 = 0; d0 < ND0; ++d0) qr[d0] = *reinterpret_cast<const f16x8*>(Qw + d0 * 16);
      if (!u.isctx) {
          constexpr int R0 = ND0 - 4;
          const float* cosT = WSP(float, WS_ROPE) + (size_t)(qpos0 + r32) * 32; const float* sinT = cosT + 2048 * 32;
#pragma unroll
          for (int i = 0; i < 2; ++i) {
              const f32x4 c0 = *(const f32x4*)(cosT + 16 * i + 8 * hi), c1 = *(const f32x4*)(cosT + 16 * i + 8 * hi + 4);
              const f32x4 s0 = *(const f32x4*)(sinT + 16 * i + 8 * hi), s1 = *(const f32x4*)(sinT + 16 * i + 8 * hi + 4);
              f16x8 a = qr[R0 + i], b2 = qr[R0 + i + 2], oa, ob;
#pragma unroll
              for (int j = 0; j < 8; ++j) { const float cc = j < 4 ? c0[j] : c1[j - 4], ss = j < 4 ? s0[j] : s1[j - 4]; const float t1 = (float)a[j], t2 = (float)b2[j];
                  oa[j] = (f16)(t1 * cc - t2 * ss); ob[j] = (f16)(t1 * ss + t2 * cc); }
              qr[R0 + i] = oa; qr[R0 + i + 2] = ob; }
      } }
    const LAS char* ql = lds + C_::OFF_Q + wid * (32 * 144) + r32 * 144 + hi * 16;
    f16x8 qreg[NREG];
#pragma unroll
    for (int d0 = 0; d0 < NREG; ++d0) qreg[d0] = qr[d0];
    if constexpr (ND0 > NREG) { __syncthreads();
#pragma unroll
        for (int d0 = NREG; d0 < ND0; ++d0) *(LAS f16x8*)(lds + C_::OFF_Q + wid * (32 * 144) + r32 * 144 + hi * 16 + (d0 - NREG) * 32) = qr[d0]; }
    const int kstart = MLA ? 0 : max(0, 128 * (u.qb - 1));
    const int nlat_tiles = u.isctx ? 0 : (MLA ? 32 : ((u.qb == 0 || u.qb == 15) ? 4 : 6));
    const int NT = 4 + nlat_tiles;
    const int sk = tid >> 3, sj = tid & 7;
    const int ctxrow0 = NLAT + u.b * CTXL, latrow0 = u.b * SEQ + kstart;
#define ATT_KROW(t) ((t) < 4 ? ctxrow0 + 64 * (t) : latrow0 + 64 * ((t) - 4))
    u32x4 sK0, sK1, sK2, sV0, sV1;
#define ATT_KLOAD(t) do { const int kr_ = ATT_KROW(t) + sk; \
      if constexpr (MLA) { const f16* kp_ = KVM + (size_t)kr_ * 2048 + u.h * 256 + sj * 8; \
          sK0 = *(const u32x4*)kp_; sK1 = *(const u32x4*)(kp_ + 64); sK2 = *(const u32x4*)(P + (size_t)kr_ * NPAD + C_KPE + sj * 8); } \
      else { sK0 = *(const u32x4*)(P + (size_t)kr_ * NPAD + C_GK + u.h * 64 + sj * 8); } } while (0)
#define ATT_VLOAD(t) do { const int kr_ = ATT_KROW(t) + sk; \
      if constexpr (MLA) { const f16* kp_ = KVM + (size_t)kr_ * 2048 + u.h * 256 + 128 + sj * 8; sV0 = *(const u32x4*)kp_; sV1 = *(const u32x4*)(kp_ + 64); } \
      else { sV0 = *(const u32x4*)(P + (size_t)kr_ * NPAD + C_GV + u.h * 64 + sj * 8); } } while (0)
#define ATT_KWRITE(bf) do { LAS char* kb_ = K_lds + (bf) * C_::SHM_K + sk * KROWB + sj * 16; *(LAS u32x4*)kb_ = sK0; \
      if constexpr (MLA) { *(LAS u32x4*)(kb_ + 128) = sK1; *(LAS u32x4*)(kb_ + 256) = sK2; } } while (0)
#define ATT_VWRITE(bf) do { LAS char* vb_ = V_lds + (bf) * C_::SHM_V; *(LAS u32x4*)(vb_ + v_st<NCB>(sk, sj * 8)) = sV0; \
      if constexpr (MLA) { *(LAS u32x4*)(vb_ + v_st<NCB>(sk, 64 + sj * 8)) = sV1; } } while (0)
#define ATT_RESC(a) do { if (__any((a) < 1.f)) { if (hi == 0) al_l[r32] = (a); asm volatile("s_waitcnt lgkmcnt(0)" ::: "memory"); \
      _Pragma("unroll") for (int d = 0; d < NCB; ++d) _Pragma("unroll") for (int r = 0; r < 16; ++r) o[d][r] *= al_l[crow(r, hi)]; } } while (0)
#define ATT_MASK(p0, p1, t) do { if constexpr (!MLA) { if ((t) >= 4) { const int kb_ = kstart + 64 * ((t) - 4) + 4 * hi - (qpos0 + r32); \
      if (kb_ < -128 || kb_ + 63 > 128) { _Pragma("unroll") for (int r = 0; r < 16; ++r) { const int dk = kb_ + (r & 3) + 8 * (r >> 2); \
          if (dk < -128 || dk > 128) p0[r] = -1e30f; if (dk + 32 < -128 || dk + 32 > 128) p1[r] = -1e30f; } } } } } while (0)
    const int vb0 = (int)(unsigned)(uintptr_t)V_lds + v_rd_base(lane);
    float m_reg = -1e30f, l_reg = 0.f, alA; f32x16 o[NCB];
#pragma unroll
    for (int d = 0; d < NCB; ++d) o[d] = f32x16{};
    f32x16 pA0, pA1; f16x8 pa0, pa1, pa2, pa3;
    __syncthreads();
    ATT_KLOAD(0); ATT_VLOAD(0); ATT_KWRITE(0); ATT_VWRITE(0); __syncthreads();
#pragma unroll 1
    for (int t = 0; t < NT; ++t) {
        const int bf = t & 1; const bool more = t + 1 < NT;
        if (more) ATT_KLOAD(t + 1);
        qkt<ND0, NREG, KROWB>(pA0, pA1, K_lds + bf * C_::SHM_K, qreg, ql, r32, hi); ATT_MASK(pA0, pA1, t);
        partialSM(pA0, pA1, m_reg, alA, Cc, thr_raw);
        ATT_RESC(alA);
        finishSM(pA0, pA1, alA, l_reg, pa0, pa1, pa2, pa3); ATT_SBAR();
        if (more) { ATT_KWRITE(bf ^ 1); ATT_VLOAD(t + 1); } ATT_SBAR();
        pv_all<NCB>(o, vb0 + bf * C_::SHM_V, pa0, pa1, pa2, pa3);
        if (more) ATT_VWRITE(bf ^ 1);
        __syncthreads();
    }
    if constexpr (!MLA) l_reg += __builtin_amdgcn_exp2f(INP(I_GSINK, l, 16)[hq] * 1.4426950408889634f - m_reg * Cc);
    if (hi == 0) li_l[r32] = l_reg; asm volatile("s_waitcnt lgkmcnt(0)" ::: "memory");
    f16* GT = WSP(f16, WS_GATED) + (size_t)(MLA ? 1 : 2) * MROWS * 1024;
    const int zc = MLA ? C_MZ + hq * 128 : C_GZ + hq * 64, oc = MLA ? hq * 128 : hq * 64;
#pragma unroll
    for (int r = 0; r < 16; ++r) { const int row = qrow0 + crow(r, hi); const float rl = __builtin_amdgcn_rcpf(li_l[crow(r, hi)]);
#pragma unroll
        for (int d0 = 0; d0 < NCB; ++d0) { const float z = (float)P[(size_t)row * NPAD + zc + d0 * 32 + r32];
            GT[(size_t)row * 1024 + oc + d0 * 32 + r32] = (f16)(o[d0][r] * rl * siluf_(z)); } }
#undef ATT_KROW
#undef ATT_KLOAD
#undef ATT_VLOAD
#undef ATT_KWRITE
#undef ATT_VWRITE
#undef ATT_RESC
#undef ATT_MASK
}
#undef ATT_SBAR
}

__device__ __forceinline__ void mla_phase(Frame& F, int l) {
    const int nunits = 256 + (l == 0 ? 32 : 0);
    for (int it = F.bid; it < nunits; it += F.G) {
        att::UnitDesc u;
        if (it < 256) { u.b = it >> 6; u.h = (it >> 3) & 7; u.qb = it & 7; u.isctx = 0; } else { const int q = it - 256; u.b = q >> 3; u.h = q & 7; u.qb = 0; u.isctx = 1; }
        u.hp = 0;
        att::attn_unit<true>(F, u, l, (LAS char*)F.lds);
    }
}
__device__ __forceinline__ void gqa_phase(Frame& F, int l) {
    const int nunits = 512 + (l == 0 ? 64 : 0);
    for (int it = F.bid; it < nunits; it += F.G) {
        att::UnitDesc u;
        if (it < 512) { u.b = it >> 7; u.h = (it >> 6) & 1; u.qb = (it >> 2) & 15; u.hp = it & 3; u.isctx = 0; }
        else { const int q = it - 512; u.b = q >> 4; u.h = (q >> 3) & 1; u.qb = (q >> 2) & 1; u.hp = q & 3; u.isctx = 1; }
        att::attn_unit<false>(F, u, l, (LAS char*)F.lds);
    }
}

namespace hy {
constexpr int FREG = 8448;
constexpr int WBLK = 80;
constexpr int WREG = 65 * WBLK;
constexpr int OFF_F = 0, OFF_W = 8 * FREG, OFF_CW = OFF_W + 8 * WREG, LDS_TOTAL = OFF_CW + 512;
static_assert(LDS_TOTAL <= RING_BYTES, "hyena LDS");

__device__ __forceinline__ void load8(const f16* p, float (&o)[8]) { const f16x8 v = *(const f16x8*)p;
#pragma unroll
    for (int j = 0; j < 8; ++j) o[j] = (float)v[j]; }

__device__ __forceinline__ void conv8(const f16* P, int row0, int i, int n, int col, const LAS float* cw, int t, float (&o)[8]) {
    float a[8], b[8], c[8];
    load8(P + (size_t)(row0 + i) * NPAD + col, b);
    if (i > 0) load8(P + (size_t)(row0 + i - 1) * NPAD + col, a); else {
#pragma unroll
        for (int j = 0; j < 8; ++j) a[j] = 0.f; }
    if (i < n - 1) load8(P + (size_t)(row0 + i + 1) * NPAD + col, c); else {
#pragma unroll
        for (int j = 0; j < 8; ++j) c[j] = 0.f; }
#pragma unroll
    for (int j = 0; j < 8; ++j) o[j] = cw[(t * 4 + 0) * 8 + j] * a[j] + cw[(t * 4 + 1) * 8 + j] * b[j] + cw[(t * 4 + 2) * 8 + j] * c[j] + cw[(t * 4 + 3) * 8 + j];
}

__device__ __forceinline__ void hyena_unit(Frame& F, int l, int b, int isctx, int cg) {
    const int tid = F.tid, lane = F.lane, wid = F.wave;
    const int n = isctx ? CTXL : SEQ, nblk = n / 32, c0 = cg * 8;
    const int row0 = isctx ? NLAT + b * CTXL : b * SEQ;
    const f16* P = WSP(f16, WS_P);
    LAS char* lds = (LAS char*)F.lds;
    LAS float* cw = (LAS float*)(lds + OFF_CW);
    __syncthreads();
    if (tid < 96) { const int t = tid / 32, q = (tid % 32) / 8, j = tid & 7; const int ch = t * 1024 + c0 + j;
        cw[(t * 4 + q) * 8 + j] = q < 3 ? INP(I_HCW, l, 3 * 3072)[q * 3072 + ch] : INP(I_HCB, l, 3072)[ch]; }
    { const f16* hf = (const f16*)(F.ws + WS_HF + (size_t)l * HF_LAYER + (isctx ? HF_LAT : 0)) + c0;
      for (int y = tid; y < 2 * n; y += NTHREADS) { const f16x8 v = *(const f16x8*)(hf + (size_t)y * 1024);
#pragma unroll
          for (int j = 0; j < 8; ++j) *(LAS f16*)(lds + OFF_F + j * FREG + y * 2) = v[j]; } }
    if (tid < 8 * 5) { const int j = tid / 5, q = tid % 5; *(LAS u32x4*)(lds + OFF_W + j * WREG + nblk * WBLK + q * 16) = (u32x4){0u, 0u, 0u, 0u}; }
    __syncthreads();
    for (int i = tid; i < n; i += NTHREADS) {
        float x1[8], vv[8];
        conv8(P, row0, i, n, C_HXV + 1024 + c0, cw, 1, x1); conv8(P, row0, i, n, C_HXV + 2048 + c0, cw, 2, vv);
#pragma unroll
        for (int j = 0; j < 8; ++j) *(LAS f16*)(lds + OFF_W + j * WREG + (i >> 5) * WBLK + (i & 31) * 2) = (f16)(x1[j] * vv[j]);
    }
    __syncthreads();
    f32x16 acc0 = f32x16{}, acc1 = f32x16{};
    {
        const int r = lane & 31, half = lane >> 5;
        const LAS char* fb = lds + OFF_F + wid * FREG; const LAS char* wb = lds + OFF_W + wid * WREG;
        const int ntile = nblk > 32 ? 2 : 1;
#pragma unroll 1
        for (int dd = -(nblk - 1); dd <= nblk - 1; ++dd) {
            const int y0 = n - 32 * dd - r + 8 * half;
            const unsigned sh = (unsigned)(y0 & 1) << 4;
            const LAS unsigned* fp = (const LAS unsigned*)(fb + ((y0 >> 1) << 2));
            unsigned d[13];
#pragma unroll
            for (int q = 0; q < 5; ++q) d[q] = fp[q];
#pragma unroll
            for (int q = 0; q < 5; ++q) d[8 + q] = fp[8 + q];
            u32x4 a0w, a1w;
#pragma unroll
            for (int q = 0; q < 4; ++q) { a0w[q] = __builtin_amdgcn_alignbit(d[q + 1], d[q], sh); a1w[q] = __builtin_amdgcn_alignbit(d[8 + q + 1], d[8 + q], sh); }
            const f16x8 A0 = __builtin_bit_cast(f16x8, a0w), A1 = __builtin_bit_cast(f16x8, a1w);
            if (dd <= 31) {
                int blk = r - dd; blk = (blk >= 0 && blk < nblk) ? blk : nblk;
                const LAS char* bp = wb + blk * WBLK + 16 * half;
                const f16x8 B0 = *(const LAS f16x8*)bp, B1 = *(const LAS f16x8*)(bp + 32);
                acc0 = __builtin_amdgcn_mfma_f32_32x32x16_f16(A0, B0, acc0, 0, 0, 0);
                acc0 = __builtin_amdgcn_mfma_f32_32x32x16_f16(A1, B1, acc0, 0, 0, 0);
            }
            if (ntile == 2 && dd >= -31) {
                int blk = 32 + r - dd; blk = (blk >= 0 && blk < nblk) ? blk : nblk;
                const LAS char* bp = wb + blk * WBLK + 16 * half;
                const f16x8 B0 = *(const LAS f16x8*)bp, B1 = *(const LAS f16x8*)(bp + 32);
                acc1 = __builtin_amdgcn_mfma_f32_32x32x16_f16(A0, B0, acc1, 0, 0, 0);
                acc1 = __builtin_amdgcn_mfma_f32_32x32x16_f16(A1, B1, acc1, 0, 0, 0);
            }
        }
        asm volatile("s_waitcnt lgkmcnt(0)" ::: "memory");
        LAS float* yo = (LAS float*)(lds + OFF_F + wid * FREG);
#pragma unroll
        for (int q = 0; q < 16; ++q) { const int rr = (q & 3) + 8 * (q >> 2) + 4 * half;
            if (r < nblk) yo[(32 * r + rr) + r] = acc0[q];
            if (ntile == 2) yo[(32 * (32 + r) + rr) + (32 + r)] = acc1[q]; }
    }
    __syncthreads();
    {
        f16* GT = WSP(f16, WS_GATED) + (size_t)3 * MROWS * 1024;
        const float* dsk = INP(I_HD, l, 1024) + c0;
        for (int i = tid; i < n; i += NTHREADS) {
            float x0[8], z[8]; conv8(P, row0, i, n, C_HXV + c0, cw, 0, x0); load8(P + (size_t)(row0 + i) * NPAD + C_HZ + c0, z);
            f32x4 o0, o1;
#pragma unroll
            for (int j = 0; j < 8; ++j) {
                const float y = *(const LAS float*)(lds + OFF_F + j * FREG + (i + (i >> 5)) * 4);
                const float w = (float)*(const LAS f16*)(lds + OFF_W + j * WREG + (i >> 5) * WBLK + (i & 31) * 2);
                const float o = x0[j] * siluf_(z[j]) * (y + w * dsk[j]);
                if (j < 4) o0[j] = o; else o1[j - 4] = o; }
            *(u32x4*)(GT + (size_t)(row0 + i) * 1024 + c0) = pkh8(o0, o1);
        }
    }
}
}
__device__ __forceinline__ void hyena_phase(Frame& F, int l) {
    const int nunits = 512 + (l == 0 ? 512 : 0);
    for (int it = F.bid; it < nunits; it += F.G) {
        const int isctx = it >= 512, q = it & 511;
        hy::hyena_unit(F, l, q >> 7, isctx, q & 127);
    }
}

namespace ssd {
using att::s16x4; using att::tr_read; using att::v_st; using att::v_rd_base; using att::crow;
constexpr size_t L_ELEMS = (size_t)64 * 128;
__device__ __forceinline__ size_t state_index(int b, int sc, int h, int dir) { return ((((size_t)b * 18 + sc) * 16 + h) * 2 + dir) * L_ELEMS; }
constexpr int TAB_OFF = 0;
constexpr int CW_OFF = 16384;
constexpr int END_OFF = CW_OFF + 12288;
constexpr int SSQ_OFF = END_OFF + 64;
constexpr int BM_OFF = 29824;
constexpr int XS_OFF = BM_OFF + 34816;
constexpr int LDS_TOTAL = XS_OFF + 65536;
static_assert(LDS_TOTAL <= RING_BYTES, "ssd LDS");
constexpr int KROWB = 272;

struct Unit { int b, sc, g, row0, n, i0; };
__device__ __forceinline__ Unit make_unit(int b, int sc, int g) { Unit u; u.b = b; u.sc = sc; u.g = g;
    if (sc < 2) { u.row0 = NLAT + b * CTXL; u.n = CTXL; u.i0 = sc * 128; } else { u.row0 = b * SEQ; u.n = SEQ; u.i0 = (sc - 2) * 128; } return u; }

__device__ __forceinline__ void stage_common(Frame& F, const Unit& u, int l, LAS char* lds) {
    const f16* P = WSP(f16, WS_P);
    LAS float* cw = (LAS float*)(lds + CW_OFF);
    for (int i = F.tid; i < 4 * 768; i += NTHREADS) { const int q = i / 768, c = i % 768;
        const int ch = c < 512 ? u.g * 512 + c : (c < 640 ? 1024 + u.g * 128 + (c - 512) : 1280 + u.g * 128 + (c - 640));
        cw[i] = q < 3 ? INP(I_SCW, l, 3 * 1536)[q * 1536 + ch] : INP(I_SCB, l, 1536)[ch]; }
    { const int h = u.g * 8 + F.wave, lane = F.lane;
      const float af = -expf(INP(I_SALOG, l, 32)[h]), ab = -expf(INP(I_SALOG, l, 32)[16 + h]);
      const float bf = INP(I_SDTB, l, 32)[h], bb = INP(I_SDTB, l, 32)[16 + h];
      const f16* pr = P + (size_t)(u.row0 + u.i0 + 2 * lane) * NPAD + C_DT;
      const float dtf0 = softplusf_((float)pr[h] + bf), dtf1 = softplusf_((float)pr[NPAD + h] + bf);
      const float dtb0 = softplusf_((float)pr[16 + h] + bb), dtb1 = softplusf_((float)pr[NPAD + 16 + h] + bb);
      const float laf0 = dtf0 * af, laf1 = dtf1 * af, lab0 = dtb0 * ab, lab1 = dtb1 * ab;
      float sf = laf0 + laf1, sb = lab0 + lab1;
#pragma unroll
      for (int o = 1; o < 64; o <<= 1) { const float tf = __shfl_up(sf, o), tb = __shfl_up(sb, o); if (lane >= o) { sf += tf; sb += tb; } }
      const float totb = __shfl(sb, 63), totf = __shfl(sf, 63);
      const float exf = sf - (laf0 + laf1), exb = sb - (lab0 + lab1);
      LAS f32x4* tab = (LAS f32x4*)(lds + TAB_OFF) + F.wave * 128;
      tab[2 * lane] = (f32x4){exf + laf0, totb - exb, dtf0, dtb0};
      tab[2 * lane + 1] = (f32x4){sf, totb - sb + lab1, dtf1, dtb1};
      if (lane == 0) { LAS float* en = (LAS float*)(lds + END_OFF) + F.wave * 2; en[0] = totf; en[1] = totb; } }
}
__device__ __forceinline__ void conv_silu8(const f16* P, const Unit& u, int i, int cl, const LAS float* cw, float (&o)[8]) {
    const int col = C_XBC + (cl < 512 ? u.g * 512 + cl : (cl < 640 ? 1024 + u.g * 128 + (cl - 512) : 1280 + u.g * 128 + (cl - 640)));
    const int tok = u.i0 + i;
    float a[8], b[8], c[8];
    hy::load8(P + (size_t)(u.row0 + tok) * NPAD + col, b);
    if (tok > 0) hy::load8(P + (size_t)(u.row0 + tok - 1) * NPAD + col, a); else {
#pragma unroll
        for (int j = 0; j < 8; ++j) a[j] = 0.f; }
    if (tok < u.n - 1) hy::load8(P + (size_t)(u.row0 + tok + 1) * NPAD + col, c); else {
#pragma unroll
        for (int j = 0; j < 8; ++j) c[j] = 0.f; }
#pragma unroll
    for (int j = 0; j < 8; ++j) o[j] = siluf_(cw[cl + j] * a[j] + cw[768 + cl + j] * b[j] + cw[1536 + cl + j] * c[j] + cw[2304 + cl + j]);
}
__device__ __forceinline__ u32x4 pack8(const float (&o)[8]) { u32x4 w; w.x = pkh(o[0], o[1]); w.y = pkh(o[2], o[3]); w.z = pkh(o[4], o[5]); w.w = pkh(o[6], o[7]); return w; }
__device__ __forceinline__ void stage_x(Frame& F, const Unit& u, int hq, LAS char* lds) {
    const f16* P = WSP(f16, WS_P); const LAS float* cw = (const LAS float*)(lds + CW_OFF);
    for (int e = F.tid; e < 128 * 32; e += NTHREADS) { const int i = e >> 5, q = e & 31, hh = q >> 3, ck = q & 7;
        float o[8]; conv_silu8(P, u, i, (hq * 4 + hh) * 64 + ck * 8, cw, o);
        *(LAS u32x4*)(lds + XS_OFF + hh * 16384 + v_st<2>(i, ck * 8)) = pack8(o); }
}
#define SSD_FRAG(L, H) __builtin_bit_cast(f16x8, (short __attribute__((ext_vector_type(8)))){L[0], L[1], L[2], L[3], H[0], H[1], H[2], H[3]})

__device__ __forceinline__ void s1_unit(Frame& F, const Unit u, int l) {
    LAS char* lds = (LAS char*)F.lds; const f16* P = WSP(f16, WS_P);
    const int lane = F.lane, wid = F.wave, r32 = lane & 31, hi = lane >> 5;
    __syncthreads();
    stage_common(F, u, l, lds);
    __syncthreads();
    { const LAS float* cw = (const LAS float*)(lds + CW_OFF);
      for (int e = F.tid; e < 128 * 16; e += NTHREADS) { const int i = e >> 4, ck = e & 15;
          float o[8]; conv_silu8(P, u, i, 512 + ck * 8, cw, o);
          *(LAS u32x4*)(lds + BM_OFF + v_st<4>(i, ck * 8)) = pack8(o); } }
    if (F.tid < 16) { const int hh = F.tid >> 1, dir = F.tid & 1; const LAS float* en = (const LAS float*)(lds + END_OFF) + hh * 2;
        WSP(float, WS_SB)[(((size_t)u.b * 18 + u.sc) * 16 + u.g * 8 + hh) * 2 + dir] = expf(en[dir]); }
#pragma unroll 1
    for (int hq = 0; hq < 2; ++hq) {
        __syncthreads();
        stage_x(F, u, hq, lds);
        __syncthreads();
        const int hh = hq * 4 + (wid >> 1), dir = wid & 1;
        const LAS f32x4* tab = (const LAS f32x4*)(lds + TAB_OFF) + hh * 128;
        const float cend = ((const LAS float*)(lds + END_OFF))[hh * 2 + dir];
        const int xb = (int)(unsigned)(uintptr_t)(lds + XS_OFF + (wid >> 1) * 16384) + v_rd_base(lane);
        const int bb = (int)(unsigned)(uintptr_t)(lds + BM_OFF) + v_rd_base(lane);
        f32x16 acc[2][4];
#pragma unroll
        for (int a = 0; a < 2; ++a)
#pragma unroll
            for (int c = 0; c < 4; ++c) acc[a][c] = f32x16{};
#define SSD_S1_STEP(KS) do { \
            f16x8 wv; { _Pragma("unroll") for (int j = 0; j < 8; ++j) { const f32x4 t = tab[(KS) * 16 + 8 * hi + j]; wv[j] = (f16)(fast_exp(cend - (dir ? t[1] : t[0])) * (dir ? t[3] : t[2])); } } \
            const s16x4 xl0 = tr_read<0 * 512 + (KS) * 2048>(xb), xh0 = tr_read<0 * 512 + (KS) * 2048 + 1024>(xb), xl1 = tr_read<1 * 512 + (KS) * 2048>(xb), xh1 = tr_read<1 * 512 + (KS) * 2048 + 1024>(xb); \
            const s16x4 bl0 = tr_read<0 * 512 + (KS) * 4096>(bb), bh0 = tr_read<0 * 512 + (KS) * 4096 + 2048>(bb), bl1 = tr_read<1 * 512 + (KS) * 4096>(bb), bh1 = tr_read<1 * 512 + (KS) * 4096 + 2048>(bb); \
            const s16x4 bl2 = tr_read<2 * 512 + (KS) * 4096>(bb), bh2 = tr_read<2 * 512 + (KS) * 4096 + 2048>(bb), bl3 = tr_read<3 * 512 + (KS) * 4096>(bb), bh3 = tr_read<3 * 512 + (KS) * 4096 + 2048>(bb); \
            asm volatile("s_waitcnt lgkmcnt(0)" ::: "memory"); __builtin_amdgcn_sched_barrier(0); \
            const f16x8 A0 = SSD_FRAG(xl0, xh0) * wv, A1 = SSD_FRAG(xl1, xh1) * wv; \
            const f16x8 B0 = SSD_FRAG(bl0, bh0), B1 = SSD_FRAG(bl1, bh1), B2 = SSD_FRAG(bl2, bh2), B3 = SSD_FRAG(bl3, bh3); \
            acc[0][0] = __builtin_amdgcn_mfma_f32_32x32x16_f16(A0, B0, acc[0][0], 0, 0, 0); acc[0][1] = __builtin_amdgcn_mfma_f32_32x32x16_f16(A0, B1, acc[0][1], 0, 0, 0); \
            acc[0][2] = __builtin_amdgcn_mfma_f32_32x32x16_f16(A0, B2, acc[0][2], 0, 0, 0); acc[0][3] = __builtin_amdgcn_mfma_f32_32x32x16_f16(A0, B3, acc[0][3], 0, 0, 0); \
            acc[1][0] = __builtin_amdgcn_mfma_f32_32x32x16_f16(A1, B0, acc[1][0], 0, 0, 0); acc[1][1] = __builtin_amdgcn_mfma_f32_32x32x16_f16(A1, B1, acc[1][1], 0, 0, 0); \
            acc[1][2] = __builtin_amdgcn_mfma_f32_32x32x16_f16(A1, B2, acc[1][2], 0, 0, 0); acc[1][3] = __builtin_amdgcn_mfma_f32_32x32x16_f16(A1, B3, acc[1][3], 0, 0, 0); } while (0)
        SSD_S1_STEP(0); SSD_S1_STEP(1); SSD_S1_STEP(2); SSD_S1_STEP(3); SSD_S1_STEP(4); SSD_S1_STEP(5); SSD_S1_STEP(6); SSD_S1_STEP(7);
#undef SSD_S1_STEP
        float* Lo = (float*)(F.ws + WS_SA) + state_index(u.b, u.sc, u.g * 8 + hh, dir);
#pragma unroll
        for (int a = 0; a < 2; ++a)
#pragma unroll
            for (int r = 0; r < 16; ++r) { const int p = 32 * a + crow(r, hi);
#pragma unroll
                for (int c = 0; c < 4; ++c) Lo[(size_t)p * 128 + 32 * c + r32] = acc[a][c][r]; }
    }
}
__device__ __forceinline__ void s1_phase(Frame& F, int l) {
    for (int it = F.bid; it < 4 * 18 * 2; it += F.G) { const int b = it / 36, q = it % 36; s1_unit(F, make_unit(b, q >> 1, q & 1), l); }
}
__device__ __forceinline__ void s2_phase(Frame& F) {
    const float* Lb = (const float*)(F.ws + WS_SA); f16* Sp = (f16*)(F.ws + WS_SC); const float* DEC = WSP(float, WS_SB);
    for (int e = F.gw * 64 + F.lane; e < 4 * 16 * 2 * 1024; e += F.NGW * 64) {
        const int q8 = e & 1023, dir = (e >> 10) & 1, h = (e >> 11) & 15, b = e >> 15;
        f32x4 s0 = {0.f, 0.f, 0.f, 0.f}, s1 = {0.f, 0.f, 0.f, 0.f};
#pragma unroll 2
        for (int k = 0; k < 18; ++k) {
            const int sc = dir == 0 ? k : (k < 2 ? 1 - k : 19 - k);
            const size_t off = state_index(b, sc, h, dir) + (size_t)q8 * 8;
            *(u32x4*)(Sp + off) = pkh8(s0, s1);
            const float d = DEC[(((size_t)b * 18 + sc) * 16 + h) * 2 + dir];
            s0 = s0 * d + *(const f32x4*)(Lb + off); s1 = s1 * d + *(const f32x4*)(Lb + off + 4);
        }
    }
}
__device__ __forceinline__ void s3_unit(Frame& F, const Unit u, int l) {
    LAS char* lds = (LAS char*)F.lds; const f16* P = WSP(f16, WS_P);
    const int lane = F.lane, wid = F.wave, r32 = lane & 31, hi = lane >> 5, li = wid & 3;
    __syncthreads();
    stage_common(F, u, l, lds);
    __syncthreads();
    { const LAS float* cw = (const LAS float*)(lds + CW_OFF);
      for (int e = F.tid; e < 128 * 32; e += NTHREADS) { const int i = e >> 5, q = e & 31, isc = q >> 4, ck = q & 15;
          float o[8]; conv_silu8(P, u, i, 512 + isc * 128 + ck * 8, cw, o);
          *(LAS u32x4*)(lds + (isc ? XS_OFF : BM_OFF) + i * KROWB + ck * 16) = pack8(o); } }
    if (F.tid < 256) ((LAS float*)(lds + SSQ_OFF))[F.tid] = 0.f;
    __syncthreads();
    f16x8 qr[8];
#pragma unroll
    for (int d0 = 0; d0 < 8; ++d0) qr[d0] = *(const LAS f16x8*)(lds + XS_OFF + (li * 32 + r32) * KROWB + (d0 * 16 + hi * 8) * 2);
    f32x16 gt[4];
#pragma unroll
    for (int st = 0; st < 4; ++st) { gt[st] = f32x16{};
#pragma unroll
        for (int d0 = 0; d0 < 8; ++d0) { const f16x8 bf = *(const LAS f16x8*)(lds + BM_OFF + (st * 32 + r32) * KROWB + (d0 * 16 + hi * 8) * 2);
            gt[st] = __builtin_amdgcn_mfma_f32_32x32x16_f16(bf, qr[d0], gt[st], 0, 0, 0); } }
    const int lrow = li * 32 + r32;
    float ssacc[16];
#pragma unroll
    for (int r = 0; r < 16; ++r) ssacc[r] = 0.f;
    f16* GT = WSP(f16, WS_GATED);
    const f16* Sp = (const f16*)(F.ws + WS_SC);
#pragma unroll 1
    for (int hq = 0; hq < 2; ++hq) {
        __syncthreads();
        stage_x(F, u, hq, lds);
        __syncthreads();
#pragma unroll 1
        for (int e2 = 0; e2 < 2; ++e2) {
            const int hx = (wid >> 2) * 2 + e2, hh = hq * 4 + hx, h = u.g * 8 + hh;
            const LAS f32x4* tab = (const LAS f32x4*)(lds + TAB_OFF) + hh * 128;
            const int lane = lane_id_opaque(), r32 = lane & 31, hi = lane >> 5; const int lrow_ = li * 32 + r32;
            const f32x4 tl = tab[lrow_];
            f16x8 pa[8];
#define SSD_W(ST, R) ({ const int s_ = 32 * (ST) + (R & 3) + 8 * (R >> 2) + 4 * hi; const f32x4 ts_ = tab[s_]; \
                const float arg_ = s_ < lrow_ ? tl[0] - ts_[0] : (s_ > lrow_ ? tl[1] - ts_[1] : 0.f); \
                const float mul_ = s_ < lrow_ ? ts_[2] : (s_ > lrow_ ? ts_[3] : ts_[2] + ts_[3]); \
                gt[ST][R] * fast_exp(arg_) * mul_; })
#define SSD_PK4(ST, BASE, OUT) do { const unsigned a0 = pkh(SSD_W(ST, BASE + 0), SSD_W(ST, BASE + 1)), a1 = pkh(SSD_W(ST, BASE + 2), SSD_W(ST, BASE + 3)); \
                const unsigned b0 = pkh(SSD_W(ST, BASE + 4), SSD_W(ST, BASE + 5)), b1 = pkh(SSD_W(ST, BASE + 6), SSD_W(ST, BASE + 7)); \
                auto r0 = __builtin_amdgcn_permlane32_swap(a0, b0, false, false); auto r1 = __builtin_amdgcn_permlane32_swap(a1, b1, false, false); \
                u32x4 w = {r0[0], r1[0], r0[1], r1[1]}; OUT = __builtin_bit_cast(f16x8, w); } while (0)
#define SB_ __builtin_amdgcn_sched_barrier(0)
            SB_; SSD_PK4(0, 0, pa[0]); SB_; SSD_PK4(0, 8, pa[1]); SB_; SSD_PK4(1, 0, pa[2]); SB_; SSD_PK4(1, 8, pa[3]); SB_;
            SSD_PK4(2, 0, pa[4]); SB_; SSD_PK4(2, 8, pa[5]); SB_; SSD_PK4(3, 0, pa[6]); SB_; SSD_PK4(3, 8, pa[7]); SB_;
#undef SB_
#undef SSD_PK4
#undef SSD_W
            f32x16 o[2] = {f32x16{}, f32x16{}};
            const int xb = (int)(unsigned)(uintptr_t)(lds + XS_OFF + hx * 16384) + v_rd_base(lane);
#define SSD_PV(KS) do { const s16x4 l0 = tr_read<(KS) * 2048>(xb), h0 = tr_read<(KS) * 2048 + 1024>(xb), l1 = tr_read<512 + (KS) * 2048>(xb), h1 = tr_read<512 + (KS) * 2048 + 1024>(xb); \
                asm volatile("s_waitcnt lgkmcnt(0)" ::: "memory"); __builtin_amdgcn_sched_barrier(0); \
                o[0] = __builtin_amdgcn_mfma_f32_32x32x16_f16(pa[KS], SSD_FRAG(l0, h0), o[0], 0, 0, 0); o[1] = __builtin_amdgcn_mfma_f32_32x32x16_f16(pa[KS], SSD_FRAG(l1, h1), o[1], 0, 0, 0); } while (0)
            SSD_PV(0); SSD_PV(1); SSD_PV(2); SSD_PV(3); SSD_PV(4); SSD_PV(5); SSD_PV(6); SSD_PV(7);
#undef SSD_PV
            { const f16 ef = (f16)fast_exp(tl[0]), eb = (f16)fast_exp(tl[1]);
              const f16* sf = Sp + state_index(u.b, u.sc, h, 0) + (size_t)r32 * 128 + hi * 8; const f16* sb = sf + L_ELEMS;
#define SSD_ST(D0) do { const f16x8 af = qr[D0] * ef, ab = qr[D0] * eb; \
                  const f16x8 f0 = *(const f16x8*)(sf + (D0) * 16), f1 = *(const f16x8*)(sf + 32 * 128 + (D0) * 16); \
                  const f16x8 b0 = *(const f16x8*)(sb + (D0) * 16), b1 = *(const f16x8*)(sb + 32 * 128 + (D0) * 16); \
                  o[0] = __builtin_amdgcn_mfma_f32_32x32x16_f16(af, f0, o[0], 0, 0, 0); o[1] = __builtin_amdgcn_mfma_f32_32x32x16_f16(af, f1, o[1], 0, 0, 0); \
                  o[0] = __builtin_amdgcn_mfma_f32_32x32x16_f16(ab, b0, o[0], 0, 0, 0); o[1] = __builtin_amdgcn_mfma_f32_32x32x16_f16(ab, b1, o[1], 0, 0, 0); } while (0)
              __builtin_amdgcn_sched_barrier(0);
              SSD_ST(0); SSD_ST(1); SSD_ST(2); SSD_ST(3); __builtin_amdgcn_sched_barrier(0);
              SSD_ST(4); SSD_ST(5); SSD_ST(6); SSD_ST(7); __builtin_amdgcn_sched_barrier(0);
#undef SSD_ST
            }
            const float dsk = INP(I_SD, l, 16)[h];
#pragma unroll
            for (int r = 0; r < 16; ++r) { const int lr = li * 32 + crow(r, hi), row = u.row0 + u.i0 + lr;
#pragma unroll
                for (int pt = 0; pt < 2; ++pt) { const int p = 32 * pt + r32;
                    const float x = (float)*(const LAS f16*)(lds + XS_OFF + hx * 16384 + v_st<2>(lr, p & ~7) + (p & 7) * 2);
                    const float z = (float)P[(size_t)row * NPAD + C_SZ + h * 64 + p];
                    const float gv = (o[pt][r] + x * dsk) * siluf_(z);
                    GT[(size_t)row * 1024 + h * 64 + p] = (f16)gv; ssacc[r] += gv * gv; }
                __builtin_amdgcn_sched_barrier(0); }
        }
    }
#pragma unroll
    for (int r = 0; r < 16; ++r) { float v = ssacc[r];
#pragma unroll
        for (int o = 1; o < 32; o <<= 1) v += __shfl_xor(v, o);
        if (r32 == 0) ((LAS float*)(lds + SSQ_OFF))[(wid >> 2) * 128 + li * 32 + crow(r, hi)] = v; }
    asm volatile("s_waitcnt vmcnt(0)" ::: "memory");
    __syncthreads();
    { const LAS float* sq = (const LAS float*)(lds + SSQ_OFF);
      for (int e = F.tid; e < 128 * 64; e += NTHREADS) { const int i = e >> 6, ck = e & 63;
          const float rs = 1.0f / sqrtf((sq[i] + sq[128 + i]) * (1.f / 512.f) + LN_EPS);
          f16* gp = GT + (size_t)(u.row0 + u.i0 + i) * 1024 + u.g * 512 + ck * 8;
          f16x8 v = *(const f16x8*)gp;
#pragma unroll
          for (int j = 0; j < 8; ++j) v[j] = (f16)((float)v[j] * rs);
          *(f16x8*)gp = v; } }
}
__device__ __forceinline__ void s3_phase(Frame& F, int l) {
    const int nsc = l == 0 ? 18 : 16, sc0 = l == 0 ? 0 : 2;
    for (int it = F.bid; it < 4 * nsc * 2; it += F.G) { const int b = it / (nsc * 2), q = it % (nsc * 2); s3_unit(F, make_unit(b, sc0 + (q >> 1), q & 1), l); }
}
#undef SSD_FRAG
}

#ifndef USE_MFMA_GQA
#define USE_MFMA_GQA 1
#endif
#ifndef USE_MFMA_MLA
#define USE_MFMA_MLA 1
#endif
#ifndef USE_MFMA_HY
#define USE_MFMA_HY 1
#endif
#ifndef DUP
#define DUP 0
#endif
#define REP(k) for (int rep_ = 0; rep_ < ((DUP == (k)) ? 2 : 1); ++rep_)
#ifndef MK_ONE_LAUNCH
#define MK_ONE_LAUNCH 1
#endif
constexpr int PH_PER_LAYER = 7, N_PHASES = 2 + PH_PER_LAYER * DEPTH;
constexpr int CW_BAR = 4096;

__device__ __forceinline__ int opaque_zero() { int v = 0; asm volatile("" : "+v"(v)); return __builtin_amdgcn_readfirstlane(v); }
__device__ __forceinline__ unsigned long long opaque_u64(unsigned long long x) { unsigned lo = (unsigned)x, hi = (unsigned)(x >> 32); asm volatile("" : "+v"(lo), "+v"(hi));
    lo = __builtin_amdgcn_readfirstlane(lo); hi = __builtin_amdgcn_readfirstlane(hi); return ((unsigned long long)hi << 32) | lo; }
__global__ void __launch_bounds__(NTHREADS, 2) fwd_kernel(Args args) {
    extern __shared__ __attribute__((aligned(16))) unsigned char lds_raw[];
    Frame F;
    F.lds = (LAS unsigned char*)lds_raw; F.ws = args.ws; F.in = args.in; F.out = args.out;
    F.wave = __builtin_amdgcn_readfirstlane((int)threadIdx.x >> 6); F.lane = lane_id_opaque(); F.tid = F.wave * 64 + F.lane;
    F.G = gridDim.x; F.bid = blockIdx.x; F.gw = F.bid * NWAVES + F.wave; F.NGW = F.G * NWAVES; F.zin = 0;
    volatile LAS unsigned* MISC = (volatile LAS unsigned*)(F.lds + MISC_OFF);
    for (int u = F.tid; u < (LDS_BYTES - LDSCTL_OFF) / 4; u += NTHREADS) ((LAS unsigned*)(F.lds + LDSCTL_OFF))[u] = 0u;
    __syncthreads();
    XcdBarrier bar; bar.bar = (unsigned*)(F.ws + WS_CTL) + CW_BAR; bar.x = 0; bar.st = nullptr;
    if (MK_ONE_LAUNCH) bar = xcd_barrier_post((unsigned*)(F.ws + WS_CTL) + CW_BAR, MISC + 8);
    const int lo = args.ph_lo, hi = args.ph_hi;
#define IN_PH(k) (lo <= (k) && (k) < hi)
#define FENCE() do { const int z_ = opaque_zero(); F.lane = lane_id_opaque(); F.tid = F.wave * 64 + F.lane; F.ws += z_; F.zin = z_; } while (0)
#define SEAM(k) do { if (IN_PH(k) && IN_PH((k) + 1)) xcd_barrier(bar); } while (0)

    if (IN_PH(0)) { FENCE(); prologue_a(F); __syncthreads(); if (DUP == 1) { FENCE(); prologue_a(F); __syncthreads(); } } SEAM(0);
    if (IN_PH(1)) { FENCE(); prologue_b(F); } SEAM(1);
    { constexpr int l = 0;
        const int base = 2 + PH_PER_LAYER * l;
        const int mrows = (l == DEPTH - 1) ? NLAT : MROWS;
        if (IN_PH(base + 0)) { FENCE();
            typedef pg8::Shape<NTOT, DM, DM, DM, 1, 0, 0> SH;
            pg8::Gemm g{WSP(f16, WS_H), WSP(f16, WS_WTIN) + (size_t)l * NTOT * DM};
            pg8::StaticOrder<NTOT / 256, 1> S; S.init(MROWS, F.G, F.bid);
            EpiInProj E{WSP(f16, WS_P), WSP(f16, WS_G)};
            REP(2) { pg8::gemm_phase<SH, EpiInProj>(F.lds, g, S, E, F.wave); __syncthreads(); }
        }
        SEAM(base + 0);
        if (IN_PH(base + 1)) { FENCE(); prep_naive(F, l);
#if USE_MFMA_SSD
            FENCE(); ssd::s1_phase(F, l);
#endif
        }
        SEAM(base + 1);
        if (IN_PH(base + 2)) { FENCE();
            { typedef pg8::Shape<1536, 512, NPAD, 512, 1, 0, 0> SH;
              pg8::Gemm g{WSP(f16, WS_P) + C_CQ, WSP(f16, WS_WTUQ) + (size_t)l * 1536 * 512};
              pg8::StaticOrder<6, 1> S; S.init(MROWS, F.G, F.bid);
              EpiRowScale E{WSP(f16, WS_QM), 1536, WSP(float, WS_RS)};
              pg8::gemm_phase<SH, EpiRowScale>(F.lds, g, S, E, F.wave); }
            FENCE();
            { typedef pg8::Shape<2048, 256, NPAD, 256, 1, 0, 0> SH;
              pg8::Gemm g{WSP(f16, WS_P) + C_CKV, WSP(f16, WS_WTUKV) + (size_t)l * 2048 * 256};
              pg8::StaticOrder<8, 1> S; S.init(MROWS, F.G, (int)((F.bid + 128) % F.G));
              EpiRowScale E{WSP(f16, WS_KVM), 2048, WSP(float, WS_RS) + MROWS};
              pg8::gemm_phase<SH, EpiRowScale>(F.lds, g, S, E, F.wave); }
            __syncthreads();
#if USE_MFMA_SSD
            FENCE(); ssd::s2_phase(F);
#else
            REP(3) { FENCE(); ssd_naive(F, l); }
#endif
#if USE_MFMA_GQA
            REP(4) { FENCE(); gqa_phase(F, l); }
#else
            FENCE(); gqa_naive(F, l);
#endif
#if USE_MFMA_HY
            REP(5) { FENCE(); hyena_phase(F, l); }
#else
            FENCE(); hyena_naive(F, l);
#endif
        }
        SEAM(base + 2);
        if (IN_PH(base + 3)) {
#if USE_MFMA_MLA
            REP(6) { FENCE(); mla_phase(F, l); }
#else
            FENCE(); mla_naive(F, l);
#endif
#if USE_MFMA_SSD
            FENCE(); ssd::s3_phase(F, l); }
#else
            FENCE(); ssd_gate_naive(F, l); }
#endif
        SEAM(base + 3);
        if (IN_PH(base + 4)) { FENCE();
            typedef pg8::Shape<DM, 1024, 1024, 1024, 4, (long)MROWS * 1024, (long)DM * 1024> SH;
            pg8::Gemm g{WSP(f16, WS_GATED), WSP(f16, WS_WTBR) + (size_t)l * 4 * DM * 1024};
            pg8::StaticOrder<8, 4> S; S.init(mrows, F.G, F.bid);
            EpiMerge E{WSP(f16, WS_G), WSP(float, WS_Y), WSP(f16, WS_MIX)};
            REP(7) { pg8::gemm_phase<SH, EpiMerge>(F.lds, g, S, E, F.wave); __syncthreads(); }
        }
        SEAM(base + 4);
        if (IN_PH(base + 5)) { FENCE();
            typedef pg8::Shape<DM, DM, DM, DM, 1, 0, 0> SH;
            pg8::Gemm g{WSP(f16, WS_MIX), WSP(f16, WS_WTOUT) + (size_t)l * DM * DM};
            pg8::StaticOrder<8, 1> S; S.init(mrows, F.G, F.bid);
            EpiOut E{l == 0 ? F.in[F.zin + I_X] : WSP(float, WS_X1), l == 0 ? F.in[F.zin + I_CTX] : WSP(float, WS_X1) + (size_t)NLAT * DM, WSP(float, WS_MOD) + (size_t)l * 5 * 6144, WSP(float, WS_Y)};
            REP(8) { pg8::gemm_phase<SH, EpiOut>(F.lds, g, S, E, F.wave); __syncthreads(); }
        }
        SEAM(base + 5);
        if (IN_PH(base + 6)) { REP(9) { FENCE(); ln_phase(F, l); } }
        SEAM(base + 6);
        }
    { constexpr int l = 1;
        const int base = 2 + PH_PER_LAYER * l;
        const int mrows = (l == DEPTH - 1) ? NLAT : MROWS;
        if (IN_PH(base + 0)) { FENCE();
            typedef pg8::Shape<NTOT, DM, DM, DM, 1, 0, 0> SH;
            pg8::Gemm g{WSP(f16, WS_H), WSP(f16, WS_WTIN) + (size_t)l * NTOT * DM};
            pg8::StaticOrder<NTOT / 256, 1> S; S.init(MROWS, F.G, F.bid);
            EpiInProj E{WSP(f16, WS_P), WSP(f16, WS_G)};
            REP(2) { pg8::gemm_phase<SH, EpiInProj>(F.lds, g, S, E, F.wave); __syncthreads(); }
        }
        SEAM(base + 0);
        if (IN_PH(base + 1)) { FENCE(); prep_naive(F, l);
#if USE_MFMA_SSD
            FENCE(); ssd::s1_phase(F, l);
#endif
        }
        SEAM(base + 1);
        if (IN_PH(base + 2)) { FENCE();
            { typedef pg8::Shape<1536, 512, NPAD, 512, 1, 0, 0> SH;
              pg8::Gemm g{WSP(f16, WS_P) + C_CQ, WSP(f16, WS_WTUQ) + (size_t)l * 1536 * 512};
              pg8::StaticOrder<6, 1> S; S.init(MROWS, F.G, F.bid);
              EpiRowScale E{WSP(f16, WS_QM), 1536, WSP(float, WS_RS)};
              pg8::gemm_phase<SH, EpiRowScale>(F.lds, g, S, E, F.wave); }
            FENCE();
            { typedef pg8::Shape<2048, 256, NPAD, 256, 1, 0, 0> SH;
              pg8::Gemm g{WSP(f16, WS_P) + C_CKV, WSP(f16, WS_WTUKV) + (size_t)l * 2048 * 256};
              pg8::StaticOrder<8, 1> S; S.init(MROWS, F.G, (int)((F.bid + 128) % F.G));
              EpiRowScale E{WSP(f16, WS_KVM), 2048, WSP(float, WS_RS) + MROWS};
              pg8::gemm_phase<SH, EpiRowScale>(F.lds, g, S, E, F.wave); }
            __syncthreads();
#if USE_MFMA_SSD
            FENCE(); ssd::s2_phase(F);
#else
            REP(3) { FENCE(); ssd_naive(F, l); }
#endif
#if USE_MFMA_GQA
            REP(4) { FENCE(); gqa_phase(F, l); }
#else
            FENCE(); gqa_naive(F, l);
#endif
#if USE_MFMA_HY
            REP(5) { FENCE(); hyena_phase(F, l); }
#else
            FENCE(); hyena_naive(F, l);
#endif
        }
        SEAM(base + 2);
        if (IN_PH(base + 3)) {
#if USE_MFMA_MLA
            REP(6) { FENCE(); mla_phase(F, l); }
#else
            FENCE(); mla_naive(F, l);
#endif
#if USE_MFMA_SSD
            FENCE(); ssd::s3_phase(F, l); }
#else
            FENCE(); ssd_gate_naive(F, l); }
#endif
        SEAM(base + 3);
        if (IN_PH(base + 4)) { FENCE();
            typedef pg8::Shape<DM, 1024, 1024, 1024, 4, (long)MROWS * 1024, (long)DM * 1024> SH;
            pg8::Gemm g{WSP(f16, WS_GATED), WSP(f16, WS_WTBR) + (size_t)l * 4 * DM * 1024};
            pg8::StaticOrder<8, 4> S; S.init(mrows, F.G, F.bid);
            EpiMerge E{WSP(f16, WS_G), WSP(float, WS_Y), WSP(f16, WS_MIX)};
            REP(7) { pg8::gemm_phase<SH, EpiMerge>(F.lds, g, S, E, F.wave); __syncthreads(); }
        }
        SEAM(base + 4);
        if (IN_PH(base + 5)) { FENCE();
            typedef pg8::Shape<DM, DM, DM, DM, 1, 0, 0> SH;
            pg8::Gemm g{WSP(f16, WS_MIX), WSP(f16, WS_WTOUT) + (size_t)l * DM * DM};
            pg8::StaticOrder<8, 1> S; S.init(mrows, F.G, F.bid);
            EpiOut E{l == 0 ? F.in[F.zin + I_X] : WSP(float, WS_X1), l == 0 ? F.in[F.zin + I_CTX] : WSP(float, WS_X1) + (size_t)NLAT * DM, WSP(float, WS_MOD) + (size_t)l * 5 * 6144, WSP(float, WS_Y)};
            REP(8) { pg8::gemm_phase<SH, EpiOut>(F.lds, g, S, E, F.wave); __syncthreads(); }
        }
        SEAM(base + 5);
        if (IN_PH(base + 6)) { REP(9) { FENCE(); ln_phase(F, l); } }
        SEAM(base + 6);
        }
#undef IN_PH
#undef SEAM
}

extern "C" void kernel_launch(void* const* d_in, const int* in_sizes, int n_in, void* d_out, int out_size, void* d_ws, size_t ws_size, hipStream_t stream) {
    static int grid = 0;
    if (grid == 0) {
        if (n_in != N_IN || out_size != NLAT * DM || ws_size < WS_END) { fprintf(stderr, "kernel_launch: unexpected shapes: n_in %d out %d ws %zu (need %zu)\n", n_in, out_size, ws_size, (size_t)WS_END); grid = -1; return; }
        int dev = 0, cus = 0, per_cu = 0;
        if (hipGetDevice(&dev) != hipSuccess || hipDeviceGetAttribute(&cus, hipDeviceAttributeMultiprocessorCount, dev) != hipSuccess) { grid = -1; return; }
        if (hipFuncSetAttribute((const void*)fwd_kernel, hipFuncAttributeMaxDynamicSharedMemorySize, LDS_BYTES) != hipSuccess) { fprintf(stderr, "kernel_launch: hipFuncSetAttribute failed\n"); grid = -1; return; }
        if (hipOccupancyMaxActiveBlocksPerMultiprocessor(&per_cu, (const void*)fwd_kernel, NTHREADS, LDS_BYTES) != hipSuccess || per_cu < 1) { fprintf(stderr, "kernel_launch: occupancy query says %d blocks per CU\n", per_cu); (void)hipGetLastError(); grid = -1; return; }
        grid = cus;
    }
    if (grid < 0) return;
    (void)hipMemsetAsync((char*)d_ws + WS_CTL, 0, CTL_BYTES, stream);
    Args a{};
    for (int i = 0; i < N_IN; ++i) a.in[i] = (const float*)d_in[i];
    a.out = (float*)d_out; a.ws = (unsigned char*)d_ws;
#if MK_ONE_LAUNCH
    a.ph_lo = 0; a.ph_hi = N_PHASES;
    hipLaunchKernelGGL(fwd_kernel, dim3(grid), dim3(NTHREADS), LDS_BYTES, stream, a);
#else
    for (int ph = 0; ph < N_PHASES; ++ph) { a.ph_lo = ph; a.ph_hi = ph + 1; hipLaunchKernelGGL(fwd_kernel, dim3(grid), dim3(NTHREADS), LDS_BYTES, stream, a); }
#endif
}
```

```cpp
#ifndef USE_MFMA_GQA
#define USE_MFMA_GQA 1
#endif
#ifndef USE_MFMA_MLA
#define USE_MFMA_MLA 1
#endif
#ifndef USE_MFMA_HY
#define USE_MFMA_HY 1
#endif
#ifndef USE_MFMA_SSD
#define USE_MFMA_SSD 1
#endif
#include <hip/hip_runtime.h>
#include <cstdio>
#include <cstdint>
#include <cmath>

constexpr int DM = 2048, NB = 4, SEQ = 2048, CTXL = 256, DEPTH = 2;
constexpr int NLAT = NB * SEQ;
constexpr int NCTX = NB * CTXL;
constexpr int MROWS = NLAT + NCTX;
constexpr int INW = 19040;
constexpr int NPAD = 11008;
constexpr int NGATE = 8192;
constexpr int NTOT = NPAD + NGATE;
constexpr int NPT = NPAD / 256;
constexpr int C_SZ = 0, C_XBC = 1024, C_DT = 2560, C_CQ = 2592, C_CKV = 3104, C_KPE = 3360, C_MZ = 3424, C_GQ = 4448,
              C_GK = 5472, C_GV = 5600, C_GZ = 5728, C_HXV = 6752, C_HZ = 9824, C_MERGE = 10848;
constexpr float LN_EPS = 1e-6f;
constexpr float DN_ALPHA = 1.4142135623730951f;

enum { I_X = 0, I_C, I_CTX, I_CCTX, I_WADA, I_BADA, I_WIN, I_SCW, I_SCB, I_SDTB, I_SALOG, I_SD, I_SNW, I_MQN, I_MWUQ, I_MKVN, I_MWUKV,
       I_GSINK, I_HCW, I_HCB, I_HW1, I_HB1, I_HW2, I_HB2, I_HW3, I_HFREQ, I_HD, I_WBR, I_WOUT, I_LNG, I_LNB, N_IN };

constexpr size_t al256(size_t x) { return (x + 255) & ~(size_t)255; }
constexpr size_t WS_CTL = 0, CTL_BYTES = 1u << 20;
constexpr size_t WS_WTIN = CTL_BYTES;
constexpr size_t WS_WTUQ = WS_WTIN + (size_t)2 * NTOT * DM * 2;
constexpr size_t WS_WTUKV = WS_WTUQ + (size_t)2 * 1536 * 512 * 2;
constexpr size_t WS_WTBR = WS_WTUKV + (size_t)2 * 2048 * 256 * 2;
constexpr size_t WS_WTOUT = WS_WTBR + (size_t)2 * 4 * 2048 * 1024 * 2;
constexpr size_t WS_MOD = WS_WTOUT + (size_t)2 * 2048 * 2048 * 2;
constexpr size_t WS_ROPE = al256(WS_MOD + (size_t)2 * 5 * 6144 * 4);
constexpr size_t WS_HF = al256(WS_ROPE + (size_t)2 * 2048 * 32 * 4);
constexpr size_t HF_LAT = (size_t)4096 * 1024 * 2, HF_CTX = (size_t)512 * 1024 * 2, HF_LAYER = HF_LAT + HF_CTX;
constexpr size_t WS_HD2 = al256(WS_HF + 2 * HF_LAYER);
constexpr size_t WS_H = al256(WS_HD2 + (size_t)2 * 2304 * 64 * 2);
constexpr size_t WS_P = WS_H + (size_t)MROWS * DM * 2;
constexpr size_t WS_G = WS_P + (size_t)MROWS * NPAD * 2;
constexpr size_t WS_RS = WS_G + (size_t)MROWS * NGATE * 2;
constexpr size_t WS_QM = al256(WS_RS + (size_t)2 * MROWS * 4);
constexpr size_t WS_KVM = WS_QM + (size_t)MROWS * 1536 * 2;
constexpr size_t WS_GATED = WS_KVM + (size_t)MROWS * 2048 * 2;
constexpr size_t WS_MIX = WS_GATED + (size_t)4 * MROWS * 1024 * 2;
constexpr size_t WS_Y = WS_MIX + (size_t)MROWS * DM * 2;
constexpr size_t WS_X1 = WS_Y + (size_t)MROWS * DM * 4;
constexpr size_t WS_SA = WS_X1 + (size_t)MROWS * DM * 4;
constexpr size_t SA_BYTES = (size_t)MROWS * 2048 * 4;
constexpr size_t WS_SB = WS_SA + SA_BYTES;
constexpr size_t WS_SC = WS_SB + SA_BYTES;
constexpr size_t SC_BYTES = (size_t)MROWS * 1024 * 4;
constexpr size_t WS_END = WS_SC + SC_BYTES;

#define GAS __attribute__((address_space(1)))
#define LAS __attribute__((address_space(3)))
typedef _Float16 f16;
typedef _Float16 f16x2 __attribute__((ext_vector_type(2)));
typedef _Float16 f16x4 __attribute__((ext_vector_type(4)));
typedef _Float16 f16x8 __attribute__((ext_vector_type(8)));
typedef float f32x2 __attribute__((ext_vector_type(2)));
typedef float f32x4 __attribute__((ext_vector_type(4)));
typedef float f32x16 __attribute__((ext_vector_type(16)));
typedef unsigned u32x2 __attribute__((ext_vector_type(2)));
typedef unsigned u32x4 __attribute__((ext_vector_type(4)));
typedef GAS unsigned gu32;
#define RLX_AGENT __ATOMIC_RELAXED, __HIP_MEMORY_SCOPE_AGENT
#define LDS_WAIT() asm volatile("s_waitcnt lgkmcnt(0)" ::: "memory")
#define VM_WAIT() asm volatile("s_waitcnt vmcnt(0)" ::: "memory")

__device__ __forceinline__ unsigned pkh(float lo, float hi) { f16x2 v = {(f16)lo, (f16)hi}; return __builtin_bit_cast(unsigned, v); }
__device__ __forceinline__ u32x4 pkh8(f32x4 a, f32x4 b) { u32x4 w; w.x = pkh(a[0], a[1]); w.y = pkh(a[2], a[3]); w.z = pkh(b[0], b[1]); w.w = pkh(b[2], b[3]); return w; }
__device__ __forceinline__ float fast_exp(float x) { return __builtin_amdgcn_exp2f(x * 1.4426950408889634f); }
__device__ __forceinline__ float sigmoidf_(float x) { return __builtin_amdgcn_rcpf(1.0f + fast_exp(-x)); }
__device__ __forceinline__ float siluf_(float x) { return x * sigmoidf_(x); }
__device__ __forceinline__ float softplusf_(float x) { return x > 20.f ? x : log1pf(expf(x)); }
__device__ __forceinline__ int lane_id_opaque() { int l; asm volatile("v_mbcnt_lo_u32_b32 %0, -1, 0\n\tv_mbcnt_hi_u32_b32 %0, -1, %0" : "=v"(l)); return l; }
__device__ __forceinline__ float wave_sum(float v) {
#pragma unroll
    for (int o = 1; o < 64; o <<= 1) v += __shfl_xor(v, o);
    return v;
}

namespace pg8 {
constexpr int BM = 256, BK = 64, HALF = 128, HTB = HALF * BK * 2, STAGE_BYTES = 8 * HTB, NXCD = 8, WGM = 8;
__host__ __device__ __forceinline__ int lds_byte(int r, int c) { const int st = (r >> 4) * 2 + (c >> 5), rr = r & 15, cc = c & 31, ob = rr * 64 + cc * 2; return st * 1024 + (ob ^ (((ob >> 9) & 1) << 5)); }
__host__ __device__ __forceinline__ void stage_rc(int b, int& R, int& C) { const int st = b / 1024, sb = b % 1024, swz = sb ^ (((sb >> 9) & 1) << 5); R = (st >> 1) * 16 + swz / 64; C = (st & 1) * 32 + (swz % 64) / 2; }
__host__ __device__ __forceinline__ int perm32(int rho) { const int n = rho >> 4, i = rho & 15; return 8 * (i >> 2) + 4 * n + (i & 3); }

struct Unit { int pm, pn, kz; };
struct Gemm { const f16* A; const f16* Bt; };
template <int N_, int K_, int LDA_, int LDB_, int NZ_, long AZS_, long BZS_> struct Shape { static constexpr int N = N_, K = K_, LDA = LDA_, LDB = LDB_, NZ = NZ_; static constexpr long AZS = AZS_, BZS = BZS_; };

template <int NN, int NZ> struct StaticOrder {
    int nM, nwg, G, c, ntail;
    __device__ __forceinline__ void init(int M, int G_, int c_, int ntail_ = 0) { nM = M / BM; nwg = nM * NN; G = G_; c = c_; ntail = ntail_; }
    __device__ __forceinline__ bool next(int i, Unit& u) const {
        const int j = i / NZ; u.kz = i - j * NZ;
        const int L = j * G + c; if (L >= nwg) { const int q = L - nwg; if (q >= ntail) return false; const int t = q % 12; u.pm = nM + q / 12; u.pn = t < 10 ? 4 + t : 11 + t; return true; }
        int wgid = L; { const int q = nwg / NXCD, r = nwg % NXCD, xcd = wgid % NXCD, off = wgid / NXCD; wgid = (xcd < r ? xcd * (q + 1) : r * (q + 1) + (xcd - r) * q) + off; }
        constexpr int nig = WGM * NN; const int gid = wgid / nig, fm = gid * WGM, gsz = (nM - fm) < WGM ? (nM - fm) : WGM;
        u.pm = fm + ((wgid % nig) % gsz); u.pn = (wgid % nig) / gsz; return true;
    }
};

struct TailOrder {
    int G, c, nq;
    __device__ __forceinline__ void init(int G_, int c_, int shift, int nq_) { G = G_; c = (c_ + G_ - shift % G_) % G_; nq = nq_; }
    __device__ __forceinline__ bool next(int i, Unit& u) const { const int q = i * G + c; if (q >= nq) return false; const int t = q >> 2; u.kz = q & 3; u.pm = 32 + (t >> 3); u.pn = t & 7; return true; }
};
template <class SH, class Epi, class Sched>
__device__ __forceinline__ void gemm_phase(LAS unsigned char* lds, const Gemm g, const Sched& S, const Epi& E, const int wid) {
    const int lane = lane_id_opaque(), tid = wid * 64 + lane,
               wr = wid >> 2, wc = wid & 3, fr = lane & 15, fq = lane >> 4;
    constexpr int K = SH::K, nt = K / BK;
    unsigned voffA[2], voffB[2];
#pragma unroll
    for (int i = 0; i < 2; ++i) { int R, C; stage_rc(tid * 16 + i * 8192, R, C); const int Rb = Epi::PERM ? ((R & ~31) + perm32(R & 31)) : R;
        voffA[i] = (unsigned)(R * SH::LDA + C) * 2u; voffB[i] = (unsigned)(Rb * SH::LDB + C) * 2u; }
    constexpr size_t kstep = (size_t)(BK * 2);
    constexpr size_t hstepA = (size_t)HALF * SH::LDA * 2, hstepB = (size_t)HALF * SH::LDB * 2;
    constexpr size_t tstepA = 2 * hstepA, tstepB = 2 * hstepB;
    const unsigned ldsw = (unsigned)wid * 1024u;
    const int aoff = lds_byte(wr * 64 + fr, fq * 8), boff = lds_byte(wc * 32 + fr, fq * 8);
#define PG8_SA(b, h) (((b) * 2 + (h)) * HTB)
#define PG8_SB(b, h) ((4 + (b) * 2 + (h)) * HTB)
#define PG8_STAGE(bufoff, gbase, voff) do { _Pragma("unroll") for (int _i = 0; _i < 2; ++_i) \
        __builtin_amdgcn_global_load_lds((const unsigned*)((const char*)(gbase) + (voff)[_i]), (LAS unsigned*)(lds + (bufoff) + ldsw + _i * 8192), 16, 0, 0); } while (0)
#define PG8_LDA(dst, b, h) do { _Pragma("unroll") for (int m = 0; m < 4; ++m) _Pragma("unroll") for (int k = 0; k < 2; ++k) dst[m][k] = *(const LAS f16x8*)(lds + PG8_SA(b, h) + aoff + m * 2048 + k * 1024); } while (0)
#define PG8_LDB(dst, b, h) do { _Pragma("unroll") for (int n = 0; n < 2; ++n) _Pragma("unroll") for (int k = 0; k < 2; ++k) dst[n][k] = *(const LAS f16x8*)(lds + PG8_SB(b, h) + boff + n * 2048 + k * 1024); } while (0)
#define PG8_MMA(ai, bj, At, Bt) do { __builtin_amdgcn_s_setprio(1); _Pragma("unroll") for (int m = 0; m < 4; ++m) _Pragma("unroll") for (int n = 0; n < 2; ++n) _Pragma("unroll") for (int k = 0; k < 2; ++k) \
        acc[ai][bj][m][n] = __builtin_amdgcn_mfma_f32_16x16x32_f16(Bt[n][k], At[m][k], acc[ai][bj][m][n], 0, 0, 0); __builtin_amdgcn_s_setprio(0); } while (0)
#define PG8_WAIT_V(n) asm volatile("s_waitcnt vmcnt(" #n ")" ::: "memory")
#define PG8_WAIT_L(n) asm volatile("s_waitcnt lgkmcnt(" #n ")" ::: "memory")
#define PG8_BAR __builtin_amdgcn_s_barrier()
#define PG8_SCHED __builtin_amdgcn_sched_barrier(0)
    Unit cur, nxt; int ui = 0;
    if (!S.next(0, cur)) return;
    f32x4 acc[2][2][4][2];
#pragma unroll
    for (int a = 0; a < 2; ++a)
#pragma unroll
        for (int b = 0; b < 2; ++b)
#pragma unroll
            for (int m = 0; m < 4; ++m)
#pragma unroll
                for (int n = 0; n < 2; ++n) acc[a][b][m][n] = (f32x4){0.f, 0.f, 0.f, 0.f};
    f16x8 At[4][2], B0[2][2], B1[2][2];
    const char* cA = (const char*)(g.A + (size_t)cur.kz * SH::AZS) + (size_t)cur.pm * tstepA;
    const char* cB = (const char*)(g.Bt + (size_t)cur.kz * SH::BZS) + (size_t)cur.pn * tstepB;
    PG8_STAGE(PG8_SB(0, 0), cB, voffB); PG8_STAGE(PG8_SB(0, 1), cB + hstepB, voffB); PG8_STAGE(PG8_SA(0, 0), cA, voffA); PG8_STAGE(PG8_SA(0, 1), cA + hstepA, voffA);
    if (wr == 1) PG8_BAR;
    PG8_WAIT_V(2); PG8_BAR;
    PG8_STAGE(PG8_SB(1, 0), cB + kstep, voffB); PG8_STAGE(PG8_SA(1, 0), cA + kstep, voffA); PG8_STAGE(PG8_SB(1, 1), cB + hstepB + kstep, voffB);
    PG8_WAIT_V(6); PG8_BAR;
    for (;;) {
        const bool has_next = S.next(ui + 1, nxt);
        const char* nA = has_next ? (const char*)(g.A + (size_t)nxt.kz * SH::AZS) + (size_t)nxt.pm * tstepA : cA;
        const char* nB = has_next ? (const char*)(g.Bt + (size_t)nxt.kz * SH::BZS) + (size_t)nxt.pn * tstepB : cB;
        for (int t = 0; t < nt; t += 2) {
            const bool last = (t == nt - 2);
            const char* a1 = cA + (size_t)(t + 1) * kstep;
            const char* a2 = last ? nA : cA + (size_t)(t + 2) * kstep; const char* b2 = last ? nB : cB + (size_t)(t + 2) * kstep;
            const char* a3 = a2 + kstep; const char* b3 = b2 + kstep;
            PG8_LDB(B0, 0, 0); PG8_LDB(B1, 0, 1); PG8_SCHED; PG8_LDA(At, 0, 0); PG8_STAGE(PG8_SA(1, 1), a1 + hstepA, voffA);
            PG8_WAIT_V(8); PG8_WAIT_L(0); PG8_BAR; PG8_MMA(0, 0, At, B0); PG8_MMA(0, 1, At, B1); PG8_BAR; PG8_SCHED;
            PG8_LDA(At, 0, 1); PG8_STAGE(PG8_SB(0, 0), b2, voffB); PG8_STAGE(PG8_SB(0, 1), b2 + hstepB, voffB); PG8_STAGE(PG8_SA(0, 0), a2, voffA);
            PG8_WAIT_V(8); PG8_WAIT_L(0); PG8_BAR; PG8_MMA(1, 0, At, B0); PG8_MMA(1, 1, At, B1); PG8_BAR; PG8_SCHED;
            PG8_LDB(B0, 1, 0); PG8_LDB(B1, 1, 1); PG8_SCHED; PG8_LDA(At, 1, 0); PG8_STAGE(PG8_SA(0, 1), a2 + hstepA, voffA);
            PG8_WAIT_V(8); PG8_WAIT_L(0); PG8_BAR; PG8_MMA(0, 0, At, B0); PG8_MMA(0, 1, At, B1); PG8_BAR; PG8_SCHED;
            PG8_LDA(At, 1, 1); PG8_STAGE(PG8_SB(1, 0), b3, voffB); PG8_STAGE(PG8_SB(1, 1), b3 + hstepB, voffB); PG8_STAGE(PG8_SA(1, 0), a3, voffA);
            PG8_WAIT_V(8); PG8_WAIT_L(0); PG8_BAR; PG8_MMA(1, 0, At, B0); PG8_MMA(1, 1, At, B1); PG8_BAR; PG8_SCHED;
        }
        if (wr == 0) PG8_BAR;
        E(acc, cur, wr, wc, fr, fq);
        if (!has_next) break;
#pragma unroll
        for (int a = 0; a < 2; ++a)
#pragma unroll
            for (int b = 0; b < 2; ++b)
#pragma unroll
                for (int m = 0; m < 4; ++m)
#pragma unroll
                    for (int n = 0; n < 2; ++n) acc[a][b][m][n] = (f32x4){0.f, 0.f, 0.f, 0.f};
        cur = nxt; cA = nA; cB = nB; ++ui;
        if (wr == 1) PG8_BAR;
    }
    PG8_WAIT_V(0);
    PG8_BAR;
#undef PG8_SA
#undef PG8_SB
#undef PG8_STAGE
#undef PG8_LDA
#undef PG8_LDB
#undef PG8_MMA
#undef PG8_WAIT_V
#undef PG8_WAIT_L
#undef PG8_BAR
#undef PG8_SCHED
}
}

constexpr int RING_BYTES = 131072;
constexpr int LDSCTL_OFF = RING_BYTES, MISC_OFF = LDSCTL_OFF + 320;
constexpr int LDS_BYTES = 147456;
constexpr int NWAVES = 8, NTHREADS = 512;

#define XB_TMO      128
#define XB_XCNT(j)  (256  + 64 * (j))
#define XB_XSUB(j)  (1280 + 64 * (j))
#define XB_XGEN(j)  (2304 + 64 * (j))
#define XB_TOP      3328
#define XB_TOPGEN   3392
#define XCD_BAR_WORDS 3456
#define XB_SPIN_CAP (1u << 24)
__device__ __forceinline__ unsigned xb_ld(unsigned* p)              { return __hip_atomic_load(p, __ATOMIC_RELAXED, __HIP_MEMORY_SCOPE_AGENT); }
__device__ __forceinline__ unsigned xb_add(unsigned* p, unsigned v) { return __hip_atomic_fetch_add(p, v, __ATOMIC_RELAXED, __HIP_MEMORY_SCOPE_AGENT); }
__device__ __forceinline__ unsigned xb_xcc_id() { return (unsigned)__builtin_amdgcn_s_getreg((3 << 11) | 20) & 0xFu; }
#define XB_SPIN(cond, bar) do { unsigned _sp = 0; while (cond) { __builtin_amdgcn_s_sleep(1); \
    if ((++_sp & 255u) == 0u) { if (xb_ld(&(bar)[XB_TMO])) break; if (_sp > XB_SPIN_CAP) { atomicAdd(&(bar)[XB_TMO], 1u); break; } } } } while (0)
struct XcdBarrier { unsigned* bar; unsigned x; volatile LAS unsigned* st; };
__device__ __forceinline__ XcdBarrier xcd_barrier_post(unsigned* bar, volatile LAS unsigned* st) {
    XcdBarrier b; b.bar = bar; b.x = xb_xcc_id(); b.st = st;
    if (threadIdx.x == 0) (void)xb_add(&bar[XB_XCNT(b.x)], 1u);
    return b;
}
__device__ __forceinline__ void xcd_barrier_complete(unsigned* bar, unsigned x, unsigned& nloc, unsigned& nx) {
    const unsigned G = gridDim.x * gridDim.y * gridDim.z;
    unsigned sum, cnt, mine, sp = 0u;
    for (;;) {
        sum = 0u; cnt = 0u; mine = 0u;
#pragma unroll
        for (unsigned j = 0; j < 16; ++j) { const unsigned c = xb_ld(&bar[XB_XCNT(j)]); sum += c; cnt += (c > 0u) ? 1u : 0u; mine = (j == x) ? c : mine; }
        if (sum == G) break;
        __builtin_amdgcn_s_sleep(1);
        if ((++sp & 255u) == 0u) { if (xb_ld(&bar[XB_TMO])) break; if (sp > XB_SPIN_CAP) { atomicAdd(&bar[XB_TMO], 1u); break; } }
    }
    nloc = mine > 0u ? mine : 1u; nx = cnt > 0u ? cnt : 1u;
}
__device__ __forceinline__ void xcd_barrier(const XcdBarrier& b) {
    asm volatile("s_waitcnt vmcnt(0)" ::: "memory");
    __syncthreads();
    if (threadIdx.x == 0) {
        unsigned* bar = b.bar;
        __builtin_amdgcn_s_waitcnt(0);
        unsigned nloc = b.st[0], nx = b.st[1];
        if (nloc == 0u) { xcd_barrier_complete(bar, b.x, nloc, nx); b.st[0] = nloc; b.st[1] = nx; }
        const unsigned old = xb_add(&bar[XB_XSUB(b.x)], 1u);
        const unsigned gen = old / nloc;
        if (old + 1u == (gen + 1u) * nloc) {
            __builtin_amdgcn_fence(__ATOMIC_RELEASE, "agent");
            asm volatile("s_waitcnt vmcnt(0)" ::: "memory");
            const unsigned og = xb_add(&bar[XB_TOP], 1u);
            const unsigned tg = og / nx;
            if (og + 1u == (tg + 1u) * nx) xb_add(&bar[XB_TOPGEN], 1u);
            else XB_SPIN(xb_ld(&bar[XB_TOPGEN]) == tg, bar);
            __builtin_amdgcn_fence(__ATOMIC_ACQUIRE, "agent");
            xb_add(&bar[XB_XGEN(b.x)], 1u);
            asm volatile("s_waitcnt vmcnt(0)" ::: "memory");
        } else {
            XB_SPIN(xb_ld(&bar[XB_XGEN(b.x)]) == gen, bar);
            __builtin_amdgcn_fence(__ATOMIC_ACQUIRE, "agent");
            asm volatile("s_waitcnt vmcnt(0)" ::: "memory");
        }
    }
    __syncthreads();
}

struct Args { const float* in[N_IN]; float* out; unsigned char* ws; int ph_lo, ph_hi; };
struct Frame {
    LAS unsigned char* lds;
    unsigned char* ws;
    const float* const* in;
    float* out;
    int tid, lane, wave, G, gw, NGW, bid, zin;
};
#define WSP(T, off) ((T*)(F.ws + (off)))
#define INP(i, l, per) (F.in[(i) + F.zin] + (size_t)(l) * (per))

struct TTile { const float* W; f16* WT; const float* kscale; int K, N, k0, n0, dfrom, dshift; };
__device__ __forceinline__ bool ttile_get(Frame& F, int it, TTile& t) {
    constexpr int T_IN = 32 * 75, T_BR = 16 * 8, T_OUT = 32 * 8, T_UQ = 8 * 6, T_UKV = 4 * 8;
    constexpr int T_LAYER = T_IN + 4 * T_BR + T_OUT + T_UQ + T_UKV;
    if (it >= 2 * T_LAYER) return false;
    const int l = it / T_LAYER; int r = it % T_LAYER;
    t.dfrom = 1 << 30; t.dshift = 0; t.kscale = nullptr;
    if (r < T_IN) { t.W = INP(I_WIN, l, (size_t)DM * INW); t.K = DM; t.N = INW; t.WT = WSP(f16, WS_WTIN) + (size_t)l * NTOT * DM; t.k0 = (r % 32) * 64; t.n0 = (r / 32) * 256; t.dfrom = C_MERGE; t.dshift = NPAD - C_MERGE; return true; }
    r -= T_IN;
    if (r < 4 * T_BR) { const int kz = r / T_BR, q = r % T_BR; t.W = INP(I_WBR, l, (size_t)4 * 1024 * DM) + (size_t)kz * 1024 * DM; t.K = 1024; t.N = DM; t.WT = WSP(f16, WS_WTBR) + ((size_t)l * 4 + kz) * DM * 1024;
        t.k0 = (q % 16) * 64; t.n0 = (q / 16) * 256; t.kscale = kz == 0 ? INP(I_SNW, l, 1024) : nullptr; return true; }
    r -= 4 * T_BR;
    if (r < T_OUT) { t.W = INP(I_WOUT, l, (size_t)DM * DM); t.K = DM; t.N = DM; t.WT = WSP(f16, WS_WTOUT) + (size_t)l * DM * DM; t.k0 = (r % 32) * 64; t.n0 = (r / 32) * 256; return true; }
    r -= T_OUT;
    if (r < T_UQ) { t.W = INP(I_MWUQ, l, (size_t)512 * 1536); t.K = 512; t.N = 1536; t.WT = WSP(f16, WS_WTUQ) + (size_t)l * 1536 * 512; t.k0 = (r % 8) * 64; t.n0 = (r / 8) * 256; t.kscale = INP(I_MQN, l, 512); return true; }
    r -= T_UQ;
    t.W = INP(I_MWUKV, l, (size_t)256 * 2048); t.K = 256; t.N = 2048; t.WT = WSP(f16, WS_WTUKV) + (size_t)l * 2048 * 256; t.k0 = (r % 4) * 64; t.n0 = (r / 4) * 256; t.kscale = INP(I_MKVN, l, 256); return true;
}
__device__ __forceinline__ void ttile_load(Frame& F, const TTile& t, float (&v)[4][4][2]) {
#pragma unroll
    for (int rp = 0; rp < 4; ++rp) { const int k = t.k0 + 2 * (F.wave * 4 + rp);
#pragma unroll
        for (int cc = 0; cc < 4; ++cc) { const int n = t.n0 + cc * 64 + F.lane;
            v[rp][cc][0] = n < t.N ? __builtin_nontemporal_load(t.W + (size_t)k * t.N + n) : 0.f; v[rp][cc][1] = n < t.N ? __builtin_nontemporal_load(t.W + (size_t)(k + 1) * t.N + n) : 0.f; } }
}
__device__ __forceinline__ void pa_weights(Frame& F) {
    LAS unsigned* img = (LAS unsigned*)F.lds;
    TTile cur, nxt; float v[4][4][2];
    int it = F.bid; bool have = ttile_get(F, it, cur);
    if (have) ttile_load(F, cur, v);
    while (have) {
        __syncthreads();
#pragma unroll
        for (int rp = 0; rp < 4; ++rp) { const int k = cur.k0 + 2 * (F.wave * 4 + rp);
            const float s0 = cur.kscale ? cur.kscale[k] : 1.f, s1 = cur.kscale ? cur.kscale[k + 1] : 1.f;
#pragma unroll
            for (int cc = 0; cc < 4; ++cc) img[(cc * 64 + F.lane) * 33 + F.wave * 4 + rp] = pkh(v[rp][cc][0] * s0, v[rp][cc][1] * s1); }
        __syncthreads();
        it += F.G; const bool more = ttile_get(F, it, nxt);
        if (more) ttile_load(F, nxt, v);
        const int q = F.tid & 7;
#pragma unroll
        for (int i = 0; i < 4; ++i) { const int c = (F.tid >> 3) + 64 * i, n = cur.n0 + c;
            if (n < cur.N) { const LAS unsigned* r = img + c * 33 + 4 * q; u32x4 o; o.x = r[0]; o.y = r[1]; o.z = r[2]; o.w = r[3];
                *(u32x4*)(cur.WT + (size_t)(n + (n >= cur.dfrom ? cur.dshift : 0)) * cur.K + cur.k0 + 8 * q) = o; } }
        cur = nxt; have = more;
    }
    __syncthreads();
    const int lane = F.lane;
    for (int i = F.gw * 64 + lane; i < 2 * 40960; i += F.NGW * 64) { const int l = i / 40960, q = i % 40960;
        *(u32x4*)(WSP(f16, WS_WTIN) + ((size_t)l * NTOT + C_MERGE) * DM + (size_t)q * 8) = (u32x4){0u, 0u, 0u, 0u}; }
}
__device__ __forceinline__ void pa_mod(Frame& F) {
    const int lane = F.lane;
    {
        LAS float* sl = (LAS float*)F.lds;
        LAS float* part = (LAS float*)(F.lds + 5 * 2048 * 4);
        if (F.bid < 2 * 96) {
            __syncthreads();
            for (int i = F.tid; i < 5 * DM; i += NTHREADS) { const int j = i / DM, k = i % DM; sl[i] = siluf_(j < 4 ? F.in[F.zin + I_C][j * DM + k] : F.in[F.zin + I_CCTX][k]); }
            __syncthreads();
        }
        for (int it = F.bid; it < 2 * 96; it += F.G) {
            const int l = it / 96, n = (it % 96) * 64 + lane;
            const float* wa = INP(I_WADA, l, (size_t)DM * 6144) + n + (size_t)(F.wave * 256) * 6144;
            const LAS float* s0 = sl + F.wave * 256;
            float a0 = 0.f, a1 = 0.f, a2 = 0.f, a3 = 0.f, a4 = 0.f;
#pragma unroll 16
            for (int k = 0; k < 256; ++k) { const float w = wa[(size_t)k * 6144];
                a0 += s0[k] * w; a1 += s0[DM + k] * w; a2 += s0[2 * DM + k] * w; a3 += s0[3 * DM + k] * w; a4 += s0[4 * DM + k] * w; }
            LAS float* pw = part + F.wave * 320 + lane;
            pw[0] = a0; pw[64] = a1; pw[128] = a2; pw[192] = a3; pw[256] = a4;
            __syncthreads();
            if (F.tid < 320) { float t = 0.f;
#pragma unroll
                for (int w = 0; w < 8; ++w) t += part[w * 320 + F.tid];
                const int j = F.tid >> 6, nn = (it % 96) * 64 + (F.tid & 63);
                WSP(float, WS_MOD)[((size_t)l * 5 + j) * 6144 + nn] = t + INP(I_BADA, l, 6144)[nn]; }
            __syncthreads();
        }
        __syncthreads();
    }
}
__device__ __forceinline__ void pa_rope(Frame& F) {
    const int lane = F.lane;
    for (int i = F.gw * 64 + lane; i < 2048 * 32; i += F.NGW * 64) {
        const int p = i >> 5, f = i & 31;
        const float invf = powf(10000.0f, -(float)(f & 15) / 16.0f);
        const float ang = (float)(f < 16 ? (p >> 6) : (p & 63)) * invf;
        WSP(float, WS_ROPE)[i] = cosf(ang); WSP(float, WS_ROPE)[2048 * 32 + i] = sinf(ang);
    }
}
__device__ __forceinline__ void pa_filters(Frame& F) {
    const int lane = F.lane;
    for (int it = F.gw; it < 2 * 2304; it += F.NGW) {
        const int l = it / 2304, q = it % 2304, isctx = q >= 2048, m = isctx ? q - 2048 : q, n = isctx ? 256 : 2048;
        const float* w1 = INP(I_HW1, l, 33 * 64); const float* w2 = INP(I_HW2, l, 64 * 64);
        const float t = (float)m / (float)(n - 1), wang = (6.283185307179586f / (float)n) * (float)m;
        float pre = INP(I_HB1, l, 64)[lane] + t * w1[lane];
#pragma unroll
        for (int i = 0; i < 16; ++i) { const float band = 1e-4f + (float)i * ((15.0f - 1e-4f) / 15.0f); const float a = band * wang;
            pre += cosf(a) * w1[(1 + i) * 64 + lane] - sinf(a) * w1[(17 + i) * 64 + lane]; }
        const float hd1 = sinf(INP(I_HFREQ, l, 128)[lane] * pre);
        float pre2 = INP(I_HB2, l, 64)[lane];
#pragma unroll 8
        for (int k = 0; k < 64; ++k) pre2 += __shfl(hd1, k) * w2[k * 64 + lane];
        WSP(f16, WS_HD2)[((size_t)l * 2304 + q) * 64 + lane] = (f16)sinf(INP(I_HFREQ, l, 128)[64 + lane] * pre2);
    }
}
__device__ __forceinline__ void filter_gemm(Frame& F) {
    for (int it = F.gw; it < 2 * 72 * 8; it += F.NGW) {
        const int lane = lane_id_opaque(), r32 = lane & 31, hi = lane >> 5;
        const int l = it / 576, q = it % 576, pt = q >> 3, cc = q & 7, isctx = pt >= 64, n = isctx ? 256 : 2048;
        const int m0 = isctx ? (pt - 64) * 32 : pt * 32, posbase = isctx ? 2048 + m0 : m0, c0 = cc * 256;
        const f16* hd = WSP(f16, WS_HD2) + ((size_t)l * 2304 + posbase + r32) * 64 + hi * 8;
        f16x8 A[4];
#pragma unroll
        for (int ks = 0; ks < 4; ++ks) A[ks] = *(const f16x8*)(hd + ks * 16);
        const float* w3u = INP(I_HW3, l, 64 * 2048);
        const unsigned loff = (unsigned)(8 * hi * 2048 + c0 + r32);
        f16* hf = (f16*)(F.ws + WS_HF + (size_t)l * HF_LAYER + (isctx ? HF_LAT : 0));
#pragma unroll 1
        for (int half4 = 0; half4 < 2; ++half4) {
            f32x16 acc[4];
#pragma unroll
            for (int ct = 0; ct < 4; ++ct) { acc[ct] = f32x16{};
#pragma unroll
                for (int ks = 0; ks < 4; ++ks) { float wv[8];
#pragma unroll
                    for (int j = 0; j < 8; ++j) wv[j] = (w3u + (size_t)(16 * ks + j) * 2048 + (half4 * 4 + ct) * 32)[loff];
                    f32x4 w0 = {wv[0], wv[1], wv[2], wv[3]}, w1 = {wv[4], wv[5], wv[6], wv[7]};
                    acc[ct] = __builtin_amdgcn_mfma_f32_32x32x16_f16(A[ks], __builtin_bit_cast(f16x8, pkh8(w0, w1)), acc[ct], 0, 0, 0); } }
#pragma unroll
            for (int ct = 0; ct < 4; ++ct) { const int c = c0 + (half4 * 4 + ct) * 32 + r32, ch = c & 1023;
                const float delta = fabsf(-15.350567286626973f + (float)ch * ((-3.0701134573253945f + 15.350567286626973f) / 1023.0f));
#pragma unroll
                for (int r = 0; r < 16; ++r) { const int m = m0 + (r & 3) + 8 * (r >> 2) + 4 * hi;
                    const float o = acc[ct][r] * expf(-((float)m / (float)(n - 1)) * delta);
                    if (c < 1024) hf[(size_t)(n - m) * 1024 + ch] = (f16)o;
                    else if (m >= 1) hf[(size_t)(n + m) * 1024 + ch] = (f16)o;
                    if (m == 0 && c < 1024) hf[ch] = (f16)0.f; } }
        }
    }
}

__device__ __forceinline__ void row_stats(const f32x4 (&v)[8], float& mean, float& rstd) {
    float s = 0.f;
#pragma unroll
    for (int j = 0; j < 8; ++j) s += (v[j][0] + v[j][1]) + (v[j][2] + v[j][3]);
    mean = wave_sum(s) * (1.f / DM); float s2 = 0.f;
#pragma unroll
    for (int j = 0; j < 8; ++j) { const f32x4 d = v[j] - mean; s2 += (d[0] * d[0] + d[1] * d[1]) + (d[2] * d[2] + d[3] * d[3]); }
    rstd = 1.0f / sqrtf(wave_sum(s2) * (1.f / DM) + LN_EPS);
}
__device__ __forceinline__ void write_h_row(Frame& F, const f32x4 (&v)[8], int row, int l) {
    float mean, rstd; row_stats(v, mean, rstd);
    const int bidx = row < NLAT ? row / SEQ : 4;
    const float* mo = WSP(float, WS_MOD) + ((size_t)l * 5 + bidx) * 6144;
    f16* hr = WSP(f16, WS_H) + (size_t)row * DM;
#pragma unroll
    for (int j = 0; j < 8; ++j) { const int col = 4 * F.lane + 256 * j;
        const f32x4 sh = *(const f32x4*)(mo + col), sc = *(const f32x4*)(mo + 2048 + col);
        const f32x4 h = (v[j] - mean) * rstd * (sc + 1.0f) + sh;
        u32x2 w; w.x = pkh(h[0], h[1]); w.y = pkh(h[2], h[3]); *(u32x2*)(hr + col) = w; }
}
__device__ __forceinline__ void prologue_b(Frame& F) {
    for (int row = F.gw; row < MROWS; row += F.NGW) {
        const float* xr = row < NLAT ? F.in[F.zin + I_X] + (size_t)row * DM : F.in[F.zin + I_CTX] + (size_t)(row - NLAT) * DM;
        f32x4 v[8];
#pragma unroll
        for (int j = 0; j < 8; ++j) v[j] = *(const f32x4*)(xr + 4 * F.lane + 256 * j);
        write_h_row(F, v, row, 0);
    }
}
__device__ __forceinline__ void ln_phase(Frame& F, int l) {
    const int nrows = (l == DEPTH - 1) ? NLAT : MROWS;
    const float* lg = INP(I_LNG, l, DM); const float* lb = INP(I_LNB, l, DM);
    for (int row = F.gw; row < nrows; row += F.NGW) {
        const float* yr = WSP(float, WS_Y) + (size_t)row * DM;
        f32x4 v[8];
        if (l == 0 && row >= NLAT) {
            const float* rr = F.in[F.zin + I_CTX] + (size_t)(row - NLAT) * DM; const float* sl = (const float*)(F.ws + WS_SA) + (size_t)4 * NCTX * DM + (size_t)(row - NLAT) * DM;
#pragma unroll
            for (int j = 0; j < 8; ++j) { const int col = 4 * F.lane + 256 * j; f32x4 a = *(const f32x4*)(rr + col) * DN_ALPHA;
#pragma unroll
                for (int k = 0; k < 4; ++k) a += *(const f32x4*)(sl + (size_t)k * NCTX * DM + col);
                v[j] = a; }
        } else {
#pragma unroll
        for (int j = 0; j < 8; ++j) v[j] = *(const f32x4*)(yr + 4 * F.lane + 256 * j); }
        float mean, rstd; row_stats(v, mean, rstd);
        float* xo = (l == DEPTH - 1) ? F.out + (size_t)row * DM : WSP(float, WS_X1) + (size_t)row * DM;
#pragma unroll
        for (int j = 0; j < 8; ++j) { const int col = 4 * F.lane + 256 * j;
            v[j] = (v[j] - mean) * rstd * *(const f32x4*)(lg + col) + *(const f32x4*)(lb + col);
            *(f32x4*)(xo + col) = v[j]; }
        if (l < DEPTH - 1) write_h_row(F, v, row, l + 1);
    }
}

struct EpiInProj {
    static constexpr bool PERM = true;
    f16* P; f16* G;
    __device__ __forceinline__ void operator()(const f32x4 (&acc)[2][2][4][2], const pg8::Unit& u, int wr, int wc, int fr, int fq) const {
        const int row0 = u.pm * 256 + wr * 64 + fr;
        const bool sig = u.pn >= NPT;
        f16* base = sig ? G : P; const int ld = sig ? NGATE : NPAD;
        const int col0 = (sig ? u.pn - NPT : u.pn) * 256 + wc * 32 + 8 * fq;
#pragma unroll
        for (int ai = 0; ai < 2; ++ai)
#pragma unroll
            for (int m = 0; m < 4; ++m) { f16* rowp = base + (size_t)(row0 + ai * 128 + m * 16) * ld + col0;
#pragma unroll
                for (int bj = 0; bj < 2; ++bj) { f32x4 v0 = acc[ai][bj][m][0], v1 = acc[ai][bj][m][1];
                    if (sig) {
#pragma unroll
                        for (int e = 0; e < 4; ++e) { v0[e] = sigmoidf_(v0[e]); v1[e] = sigmoidf_(v1[e]); } }
                    *(u32x4*)(rowp + bj * 128) = pkh8(v0, v1); } }
    }
};
struct EpiRowScale {
    static constexpr bool PERM = true;
    f16* O; int ldc; const float* rs;
    __device__ __forceinline__ void operator()(const f32x4 (&acc)[2][2][4][2], const pg8::Unit& u, int wr, int wc, int fr, int fq) const {
        const int row0 = u.pm * 256 + wr * 64 + fr, col0 = u.pn * 256 + wc * 32 + 8 * fq;
#pragma unroll
        for (int ai = 0; ai < 2; ++ai)
#pragma unroll
            for (int m = 0; m < 4; ++m) { const int row = row0 + ai * 128 + m * 16; const float s = rs[row]; f16* rowp = O + (size_t)row * ldc + col0;
#pragma unroll
                for (int bj = 0; bj < 2; ++bj) *(u32x4*)(rowp + bj * 128) = pkh8(acc[ai][bj][m][0] * s, acc[ai][bj][m][1] * s); }
    }
};
struct EpiMerge {
    static constexpr bool PERM = true;
    const f16* G; float* part; f16* MIX;
    __device__ __forceinline__ void operator()(const f32x4 (&acc)[2][2][4][2], const pg8::Unit& u, int wr, int wc, int fr, int fq) const {
        const int row0 = u.pm * 256 + wr * 64 + fr, col0 = u.pn * 256 + wc * 32 + 8 * fq;
#pragma unroll
        for (int ai = 0; ai < 2; ++ai)
#pragma unroll
            for (int m = 0; m < 4; ++m) { const int row = row0 + ai * 128 + m * 16;
#pragma unroll
                for (int bj = 0; bj < 2; ++bj) { const int col = col0 + bj * 128;
                    const f16x8 gt = *(const f16x8*)(G + (size_t)row * NGATE + u.kz * 2048 + col);
                    f32x4 v0 = acc[ai][bj][m][0], v1 = acc[ai][bj][m][1];
#pragma unroll
                    for (int e = 0; e < 4; ++e) { v0[e] *= (float)gt[e]; v1[e] *= (float)gt[4 + e]; }
                    float* pp = part + (size_t)row * DM + col;
                    if (u.kz > 0) { v0 += *(const f32x4*)pp; v1 += *(const f32x4*)(pp + 4); }
                    if (u.kz < 3) { *(f32x4*)pp = v0; *(f32x4*)(pp + 4) = v1; }
                    else *(u32x4*)(MIX + (size_t)row * DM + col) = pkh8(v0, v1); } }
    }
};
struct EpiOut {
    static constexpr bool PERM = false;
    const float* res_lat; const float* res_ctx; const float* mod; float* Y;
    __device__ __forceinline__ void operator()(const f32x4 (&acc)[2][2][4][2], const pg8::Unit& u, int wr, int wc, int fr, int fq) const {
        const int row0 = u.pm * 256 + wr * 64 + fr, col0 = u.pn * 256 + wc * 32 + 4 * fq;
        const bool lat = u.pm < NLAT / 256;
        const float* res = lat ? res_lat : res_ctx - (size_t)NLAT * DM;
        const float* gv = mod + (size_t)(lat ? u.pm / 8 : 4) * 6144 + 4096;
        f32x4 g4[2][2];
#pragma unroll
        for (int bj = 0; bj < 2; ++bj)
#pragma unroll
            for (int n = 0; n < 2; ++n) g4[bj][n] = *(const f32x4*)(gv + col0 + bj * 128 + n * 16);
#pragma unroll
        for (int ai = 0; ai < 2; ++ai)
#pragma unroll
            for (int m = 0; m < 4; ++m) { const size_t off = (size_t)(row0 + ai * 128 + m * 16) * DM + col0;
#pragma unroll
                for (int bj = 0; bj < 2; ++bj)
#pragma unroll
                    for (int n = 0; n < 2; ++n) { const f32x4 r = *(const f32x4*)(res + off + bj * 128 + n * 16);
                        *(f32x4*)(Y + off + bj * 128 + n * 16) = r * DN_ALPHA + g4[bj][n] * acc[ai][bj][m][n]; } }
    }
};

struct EpiMergeSlab {
    static constexpr bool PERM = true;
    const f16* G; float* slab;
    __device__ __forceinline__ void operator()(const f32x4 (&acc)[2][2][4][2], const pg8::Unit& u, int wr, int wc, int fr, int fq) const {
        const int row0 = u.pm * 256 + wr * 64 + fr, col0 = u.pn * 256 + wc * 32 + 8 * fq;
#pragma unroll
        for (int ai = 0; ai < 2; ++ai)
#pragma unroll
            for (int m = 0; m < 4; ++m) { const int row = row0 + ai * 128 + m * 16;
#pragma unroll
                for (int bj = 0; bj < 2; ++bj) { const int col = col0 + bj * 128;
                    const f16x8 gt = *(const f16x8*)(G + (size_t)row * NGATE + u.kz * 2048 + col);
                    f32x4 v0 = acc[ai][bj][m][0], v1 = acc[ai][bj][m][1];
#pragma unroll
                    for (int e = 0; e < 4; ++e) { v0[e] *= (float)gt[e]; v1[e] *= (float)gt[4 + e]; }
                    float* pp = slab + ((size_t)u.kz * NCTX + (row - NLAT)) * DM + col;
                    *(f32x4*)pp = v0; *(f32x4*)(pp + 4) = v1; } }
    }
};
__device__ __forceinline__ void merge_tail_reduce(Frame& F, int q, const float* slab, f16* MIX, unsigned* cnt) {
    LAS unsigned* flag = (LAS unsigned*)(F.lds + MISC_OFF + 96);
    const int t = q >> 2, pm = 32 + (t >> 3), pn = t & 7;
    asm volatile("s_waitcnt vmcnt(0)" ::: "memory");
    __syncthreads();
    if (F.tid == 0) { __builtin_amdgcn_fence(__ATOMIC_RELEASE, "agent"); asm volatile("s_waitcnt vmcnt(0)" ::: "memory");
        const unsigned old = __hip_atomic_fetch_add(cnt + 64 * t, 1u, __ATOMIC_RELAXED, __HIP_MEMORY_SCOPE_AGENT);
        if (old == 3u) { __builtin_amdgcn_fence(__ATOMIC_ACQUIRE, "agent"); asm volatile("s_waitcnt vmcnt(0)" ::: "memory"); }
        *flag = old; }
    __syncthreads();
    if (*flag != 3u) return;
    const int r = F.tid >> 1, cb = pn * 256 + (F.tid & 1) * 128;
    const float* s0 = slab + (size_t)((pm - 32) * 256 + r) * DM + cb; f16* mo = MIX + (size_t)(pm * 256 + r) * DM + cb;
#pragma unroll 4
    for (int c = 0; c < 128; c += 8) {
        f32x4 a0 = *(const f32x4*)(s0 + c), a1 = *(const f32x4*)(s0 + c + 4);
#pragma unroll
        for (int k = 1; k < 4; ++k) { a0 += *(const f32x4*)(s0 + (size_t)k * NCTX * DM + c); a1 += *(const f32x4*)(s0 + (size_t)k * NCTX * DM + c + 4); }
        *(u32x4*)(mo + c) = pkh8(a0, a1); }
}
struct EpiOutSlab {
    static constexpr bool PERM = false;
    const float* mod; float* slab;
    __device__ __forceinline__ void operator()(const f32x4 (&acc)[2][2][4][2], const pg8::Unit& u, int wr, int wc, int fr, int fq) const {
        const int row0 = u.pm * 256 + wr * 64 + fr, col0 = u.pn * 256 + wc * 32 + 4 * fq;
        const float* gv = mod + (size_t)4 * 6144 + 4096;
#pragma unroll
        for (int bj = 0; bj < 2; ++bj)
#pragma unroll
            for (int n = 0; n < 2; ++n) { const f32x4 g4 = *(const f32x4*)(gv + col0 + bj * 128 + n * 16);
#pragma unroll
                for (int ai = 0; ai < 2; ++ai)
#pragma unroll
                    for (int m = 0; m < 4; ++m) *(f32x4*)(slab + ((size_t)u.kz * NCTX + (row0 + ai * 128 + m * 16 - NLAT)) * DM + col0 + bj * 128 + n * 16) = g4 * acc[ai][bj][m][n]; }
    }
};

constexpr size_t SA_U = 0, SA_DT = (size_t)MROWS * 1536 * 4, SA_KPE = SA_DT + (size_t)MROWS * 32 * 4, SA_GK = SA_KPE + (size_t)MROWS * 64 * 4;
static_assert(SA_GK + (size_t)MROWS * 128 * 4 <= SA_BYTES, "scratch A");

__device__ __forceinline__ bool has_prev(int row) { return row < NLAT ? (row & (SEQ - 1)) != 0 : ((row - NLAT) & (CTXL - 1)) != 0; }
__device__ __forceinline__ bool has_next(int row) { return row < NLAT ? (row & (SEQ - 1)) != SEQ - 1 : ((row - NLAT) & (CTXL - 1)) != CTXL - 1; }
__device__ __forceinline__ float conv3(const f16* P, int row, int col, const float* w, int wc, int nch, float bias) {
    float a = w[nch + wc] * (float)P[(size_t)row * NPAD + col] + bias;
    if (has_prev(row)) a += w[wc] * (float)P[(size_t)(row - 1) * NPAD + col];
    if (has_next(row)) a += w[2 * nch + wc] * (float)P[(size_t)(row + 1) * NPAD + col];
    return a;
}
__device__ __forceinline__ void prep_naive(Frame& F, int l) {
    const f16* P = WSP(f16, WS_P); f16* Pw = WSP(f16, WS_P);
    const int gt = F.gw * 64 + F.lane, NT = F.NGW * 64;
    float* U = (float*)(F.ws + WS_SA + SA_U); float* DT = (float*)(F.ws + WS_SA + SA_DT);
    float* HW = (float*)(F.ws + WS_SB); float* HM = HW + (size_t)MROWS * 1024;
    const float* scw = INP(I_SCW, l, 3 * 1536); const float* scb = INP(I_SCB, l, 1536);
    const float* hcw = INP(I_HCW, l, 3 * 3072); const float* hcb = INP(I_HCB, l, 3072);
    const float* cosT = WSP(float, WS_ROPE); const float* sinT = cosT + 2048 * 32;
#if !USE_MFMA_SSD
    for (int i = gt; i < MROWS * 1536; i += NT) { const int row = i / 1536, c = i % 1536;
        U[i] = siluf_(conv3(P, row, C_XBC + c, scw, c, 1536, scb[c])); }
    for (int i = gt; i < MROWS * 32; i += NT) { const int row = i >> 5, j = i & 31;
        DT[i] = softplusf_((float)P[(size_t)row * NPAD + C_DT + j] + INP(I_SDTB, l, 32)[j]); }
#endif
    for (int row = F.gw; row < MROWS; row += F.NGW) {
        float sq = 0.f, sk = 0.f;
#pragma unroll
        for (int j = 0; j < 8; ++j) { const float v = (float)P[(size_t)row * NPAD + C_CQ + j * 64 + F.lane]; sq += v * v; }
#pragma unroll
        for (int j = 0; j < 4; ++j) { const float v = (float)P[(size_t)row * NPAD + C_CKV + j * 64 + F.lane]; sk += v * v; }
        sq = wave_sum(sq); sk = wave_sum(sk);
        if (F.lane == 0) { WSP(float, WS_RS)[row] = 1.0f / sqrtf(sq * (1.f / 512.f) + LN_EPS); WSP(float, WS_RS)[MROWS + row] = 1.0f / sqrtf(sk * (1.f / 256.f) + LN_EPS); }
    }
    for (int i = gt; i < NLAT * 32; i += NT) { const int row = i >> 5, f = i & 31, p = row & (SEQ - 1);
        f16* a = Pw + (size_t)row * NPAD + C_KPE; const float c = cosT[p * 32 + f], s = sinT[p * 32 + f], t1 = (float)a[f], t2 = (float)a[32 + f];
        a[f] = (f16)(t1 * c - t2 * s); a[32 + f] = (f16)(t1 * s + t2 * c); }
    for (int i = gt; i < NLAT * 64; i += NT) { const int row = i >> 6, kv = (i >> 5) & 1, f = i & 31, p = row & (SEQ - 1);
        f16* a = Pw + (size_t)row * NPAD + C_GK + kv * 64; const float c = cosT[p * 32 + f], s = sinT[p * 32 + f], t1 = (float)a[f], t2 = (float)a[32 + f];
        a[f] = (f16)(t1 * c - t2 * s); a[32 + f] = (f16)(t1 * s + t2 * c); }
#if !USE_MFMA_HY
    for (int i = gt; i < MROWS * 1024; i += NT) { const int row = i >> 10, c = i & 1023;
        const float x0 = conv3(P, row, C_HXV + c, hcw, c, 3072, hcb[c]);
        const float x1 = conv3(P, row, C_HXV + 1024 + c, hcw, 1024 + c, 3072, hcb[1024 + c]);
        const float v = conv3(P, row, C_HXV + 2048 + c, hcw, 2048 + c, 3072, hcb[2048 + c]);
        HW[i] = x1 * v; HM[i] = x0 * siluf_((float)P[(size_t)row * NPAD + C_HZ + c]); }
#endif
}

__device__ __forceinline__ void ssd_naive(Frame& F, int l) {
    const float* U = (const float*)(F.ws + WS_SA + SA_U); const float* DT = (const float*)(F.ws + WS_SA + SA_DT);
    float* YD = WSP(float, WS_Y);
    LAS float* tile = (LAS float*)F.lds;
    for (int item = F.bid; item < 256; item += F.G) {
        const int b = item >> 6, h = (item >> 2) & 15, dir = (item >> 1) & 1, ph = item & 1, g = h >> 3;
        const float a = -expf(INP(I_SALOG, l, 32)[dir * 16 + h]);
        const int pl = F.tid >> 4, nc = F.tid & 15;
        float st[8];
#pragma unroll
        for (int j = 0; j < 8; ++j) st[j] = 0.f;
        for (int s0 = 0; s0 < CTXL + SEQ; s0 += 16) {
            __syncthreads();
            for (int e = F.tid; e < 16 * 290; e += NTHREADS) { const int k = e / 290, q = e % 290, s = s0 + k;
                int row; if (s < CTXL) row = NLAT + b * CTXL + (dir ? CTXL - 1 - s : s); else row = b * SEQ + (dir ? SEQ - 1 - (s - CTXL) : (s - CTXL));
                float v;
                if (q < 32) v = U[(size_t)row * 1536 + h * 64 + ph * 32 + q];
                else if (q < 160) v = U[(size_t)row * 1536 + 1024 + g * 128 + (q - 32)];
                else if (q < 288) v = U[(size_t)row * 1536 + 1280 + g * 128 + (q - 160)];
                else if (q == 288) v = DT[(size_t)row * 32 + dir * 16 + h];
                else v = __int_as_float(row);
                tile[k * 292 + q] = v; }
            __syncthreads();
            for (int k = 0; k < 16; ++k) {
                const LAS float* tk = tile + k * 292;
                const float dtv = tk[288], dec = expf(dtv * a), xv = tk[pl] * dtv;
                float yp = 0.f;
#pragma unroll
                for (int j = 0; j < 8; ++j) { st[j] = dec * st[j] + xv * tk[32 + nc * 8 + j]; yp += st[j] * tk[160 + nc * 8 + j]; }
                yp += __shfl_xor(yp, 1); yp += __shfl_xor(yp, 2); yp += __shfl_xor(yp, 4); yp += __shfl_xor(yp, 8);
                if (nc == 0) { const int row = __float_as_int(tk[289]); YD[((size_t)dir * MROWS + row) * 1024 + h * 64 + ph * 32 + pl] = yp; }
            }
        }
        __syncthreads();
    }
}
__device__ __forceinline__ void ssd_gate_naive(Frame& F, int l) {
    const f16* P = WSP(f16, WS_P); const float* U = (const float*)(F.ws + WS_SA + SA_U); const float* YD = WSP(float, WS_Y);
    f16* GT = WSP(f16, WS_GATED);
    const int nrows = l == 0 ? MROWS : NLAT;
    for (int row = F.gw; row < nrows; row += F.NGW) {
        float gv[16]; float ss = 0.f;
#pragma unroll
        for (int j = 0; j < 16; ++j) { const int c = F.lane * 16 + j;
            const float y = YD[(size_t)row * 1024 + c] + YD[((size_t)MROWS + row) * 1024 + c] + U[(size_t)row * 1536 + c] * INP(I_SD, l, 16)[c >> 6];
            const float g = y * siluf_((float)P[(size_t)row * NPAD + C_SZ + c]); gv[j] = g; ss += g * g; }
#pragma unroll
        for (int o = 1; o < 32; o <<= 1) ss += __shfl_xor(ss, o);
        const float r = 1.0f / sqrtf(ss * (1.f / 512.f) + LN_EPS);
#pragma unroll
        for (int j = 0; j < 16; ++j) GT[(size_t)row * 1024 + F.lane * 16 + j] = (f16)(gv[j] * r);
    }
}
__device__ __forceinline__ void gqa_naive(Frame& F, int l) {
    const f16* P = WSP(f16, WS_P);
    const float* cosT = WSP(float, WS_ROPE); const float* sinT = cosT + 2048 * 32;
    f16* GT = WSP(f16, WS_GATED) + (size_t)2 * MROWS * 1024;
    const int nrows = l == 0 ? MROWS : NLAT;
    const int d = F.lane, f = d & 31;
    for (int it = F.gw; it < nrows * 16; it += F.NGW) {
        const int row = it >> 4, hq = it & 15, kv = hq >> 3;
        const bool lat = row < NLAT; const int b = lat ? row / SEQ : (row - NLAT) / CTXL, p = row & (SEQ - 1);
        const float t1 = (float)P[(size_t)row * NPAD + C_GQ + hq * 64 + f], t2 = (float)P[(size_t)row * NPAD + C_GQ + hq * 64 + 32 + f];
        float q;
        if (lat) { const float c = cosT[p * 32 + f], s = sinT[p * 32 + f]; q = d < 32 ? t1 * c - t2 * s : t1 * s + t2 * c; } else q = d < 32 ? t1 : t2;
        q *= 0.125f;
        float m = INP(I_GSINK, l, 16)[hq], lsum = 1.0f, acc = 0.f;
        const int nkeys = CTXL + (lat ? (min(p + 128, SEQ - 1) - max(p - 128, 0) + 1) : 0);
        for (int j = 0; j < nkeys; ++j) {
            const int krow = j < CTXL ? NLAT + b * CTXL + j : b * SEQ + max(p - 128, 0) + (j - CTXL);
            const float s = wave_sum(q * (float)P[(size_t)krow * NPAD + C_GK + kv * 64 + d]);
            const float v = (float)P[(size_t)krow * NPAD + C_GV + kv * 64 + d];
            const float mn = fmaxf(m, s), corr = fast_exp(m - mn), pe = fast_exp(s - mn);
            lsum = lsum * corr + pe; acc = acc * corr + pe * v; m = mn;
        }
        const float y = acc / lsum;
        GT[(size_t)row * 1024 + hq * 64 + d] = (f16)(y * siluf_((float)P[(size_t)row * NPAD + C_GZ + hq * 64 + d]));
    }
}
__device__ __forceinline__ void mla_naive(Frame& F, int l) {
    const f16* P = WSP(f16, WS_P); const f16* QM = WSP(f16, WS_QM); const f16* KVM = WSP(f16, WS_KVM);
    const float* cosT = WSP(float, WS_ROPE); const float* sinT = cosT + 2048 * 32;
    f16* GT = WSP(f16, WS_GATED) + (size_t)1 * MROWS * 1024;
    const int nrows = l == 0 ? MROWS : NLAT;
    const int d = F.lane, f = d & 31;
    const float scale = 0.07216878364870322f;
    for (int it = F.gw; it < nrows * 8; it += F.NGW) {
        const int row = it >> 3, h = it & 7;
        const bool lat = row < NLAT; const int b = lat ? row / SEQ : (row - NLAT) / CTXL, p = row & (SEQ - 1);
        const f16* qr = QM + (size_t)row * 1536 + h * 192;
        const float q0 = (float)qr[d] * scale, q1 = (float)qr[64 + d] * scale;
        const float t1 = (float)qr[128 + f], t2 = (float)qr[128 + 32 + f];
        float qp;
        if (lat) { const float c = cosT[p * 32 + f], s = sinT[p * 32 + f]; qp = d < 32 ? t1 * c - t2 * s : t1 * s + t2 * c; } else qp = d < 32 ? t1 : t2;
        qp *= scale;
        float m = -1e30f, lsum = 0.f, a0 = 0.f, a1 = 0.f;
        const int nkeys = CTXL + (lat ? SEQ : 0);
        for (int j = 0; j < nkeys; ++j) {
            const int krow = j < CTXL ? NLAT + b * CTXL + j : b * SEQ + (j - CTXL);
            const f16* kr = KVM + (size_t)krow * 2048 + h * 256;
            const float s = wave_sum(q0 * (float)kr[d] + q1 * (float)kr[64 + d] + qp * (float)P[(size_t)krow * NPAD + C_KPE + d]);
            const float v0 = (float)kr[128 + d], v1 = (float)kr[192 + d];
            const float mn = fmaxf(m, s), corr = fast_exp(m - mn), pe = fast_exp(s - mn);
            lsum = lsum * corr + pe; a0 = a0 * corr + pe * v0; a1 = a1 * corr + pe * v1; m = mn;
        }
        const float inv = 1.0f / lsum;
        const f16* zr = P + (size_t)row * NPAD + C_MZ + h * 128;
        GT[(size_t)row * 1024 + h * 128 + d] = (f16)(a0 * inv * siluf_((float)zr[d]));
        GT[(size_t)row * 1024 + h * 128 + 64 + d] = (f16)(a1 * inv * siluf_((float)zr[64 + d]));
    }
}
__device__ __forceinline__ void hyena_naive(Frame& F, int l) {
    const float* HW = (const float*)(F.ws + WS_SB); const float* HM = HW + (size_t)MROWS * 1024;
    f16* GT = WSP(f16, WS_GATED) + (size_t)3 * MROWS * 1024;
    const int nlat_items = NB * (SEQ / 8) * 16, nctx_items = (l == 0) ? NB * (CTXL / 8) * 16 : 0;
    for (int it = F.bid; it < nlat_items + nctx_items; it += F.G) {
        const bool isctx = it >= nlat_items; const int q = isctx ? it - nlat_items : it;
        const int n = isctx ? CTXL : SEQ, cg = q & 15, pb = (q >> 4) % (n / 8), b = (q >> 4) / (n / 8);
        const int i = pb * 8 + F.wave, c = cg * 64 + F.lane;
        const int row0 = isctx ? NLAT + b * CTXL : b * SEQ;
        const f16* hf = (const f16*)(F.ws + WS_HF + (size_t)l * HF_LAYER + (isctx ? HF_LAT : 0));
        float acc = 0.f;
#pragma unroll 4
        for (int j = 0; j < n; ++j) acc += (float)hf[(size_t)(n - (i - j)) * 1024 + c] * HW[(size_t)(row0 + j) * 1024 + c];
        const size_t o = (size_t)(row0 + i) * 1024 + c;
        GT[o] = (f16)(HM[o] * (acc + HW[o] * INP(I_HD, l, 1024)[c]));
    }
}

namespace att {
typedef short s16x4 __attribute__((ext_vector_type(4)));
__device__ __forceinline__ int crow(int r, int hi) { return (r & 3) + 8 * (r >> 2) + 4 * hi; }
#define ATT_SBAR() __builtin_amdgcn_sched_barrier(0)
__device__ __forceinline__ int v_rd_base(int lane) { return ((lane & 3) << 3) | (((lane >> 2) & 3) << 6) | (((lane >> 4) & 1) << 5) | (((lane >> 5) & 1) << 8); }
template <int OFF> __device__ __forceinline__ s16x4 tr_read(int vb) { s16x4 r; asm volatile("ds_read_b64_tr_b16 %0, %1 offset:%2" : "=&v"(r) : "v"(vb), "i"(OFF) : "memory"); return r; }

template <bool MLA> struct Cfg {
    static constexpr int DQK = MLA ? 192 : 64, DV = MLA ? 128 : 64, NCB = DV / 32, ND0 = DQK / 16;
    static constexpr int KROWB = DQK * 2 + 16, SHM_K = 64 * KROWB, SHM_V = 64 * DV * 2;
    static constexpr int OFF_V = 0, OFF_K = 2 * SHM_V, OFF_WS = 2 * SHM_V + 2 * SHM_K, OFF_Q = OFF_WS + 8 * 64 * 4, LDS_TOTAL = OFF_Q + (MLA ? 8 * 32 * 144 : 0);
    static constexpr int NREG = MLA ? 8 : 4;
};
template <int NCB> __device__ __forceinline__ int v_st(int k, int c) { const int kk = (k & ~0xC) | ((k & 4) << 1) | ((k & 8) >> 1); return ((kk >> 3) * NCB + (c >> 5)) * 512 + ((kk & 7) * 32 + (c & 31)) * 2; }

__device__ __forceinline__ void partialSM(f32x16& p0, f32x16& p1, float& m_reg, float& alpha, const float C, const float thr_raw) {
    float pmax = p0[0];
#pragma unroll
    for (int r = 1; r < 16; ++r) pmax = fmaxf(pmax, p0[r]);
#pragma unroll
    for (int r = 0; r < 16; ++r) pmax = fmaxf(pmax, p1[r]);
    { auto rr = __builtin_amdgcn_permlane32_swap(__float_as_uint(pmax), __float_as_uint(pmax), false, false); pmax = fmaxf(__uint_as_float(rr[0]), __uint_as_float(rr[1])); }
    float mn;
    if (__builtin_expect(__all(pmax - m_reg <= thr_raw), 1)) { mn = m_reg; alpha = 1.f; }
    else { mn = fmaxf(m_reg, pmax); alpha = __builtin_amdgcn_exp2f((m_reg - mn) * C); m_reg = mn; }
    const float mnC = -mn * C;
#pragma unroll
    for (int r = 0; r < 16; ++r) p0[r] = fmaf(p0[r], C, mnC);
#pragma unroll
    for (int r = 0; r < 16; ++r) p1[r] = fmaf(p1[r], C, mnC);
#pragma unroll
    for (int r = 0; r < 16; ++r) p0[r] = __builtin_amdgcn_exp2f(p0[r]);
}
__device__ __forceinline__ void finishSM(f32x16& p0, f32x16& p1, float alpha, float& l_reg, f16x8& pa0, f16x8& pa1, f16x8& pa2, f16x8& pa3) {
#pragma unroll
    for (int r = 0; r < 16; ++r) p1[r] = __builtin_amdgcn_exp2f(p1[r]);
    float ps = 0;
#pragma unroll
    for (int r = 0; r < 16; ++r) ps += p0[r];
#pragma unroll
    for (int r = 0; r < 16; ++r) ps += p1[r];
    { auto rr = __builtin_amdgcn_permlane32_swap(__float_as_uint(ps), __float_as_uint(ps), false, false); ps = __uint_as_float(rr[0]) + __uint_as_float(rr[1]); }
    l_reg = l_reg * alpha + ps;
#define ATT_PK4(P, BASE, OUT) do { unsigned a0 = pkh(P[BASE + 0], P[BASE + 1]), a1 = pkh(P[BASE + 2], P[BASE + 3]); \
    unsigned b0 = pkh(P[BASE + 4], P[BASE + 5]), b1 = pkh(P[BASE + 6], P[BASE + 7]); \
    auto r0 = __builtin_amdgcn_permlane32_swap(a0, b0, false, false); auto r1 = __builtin_amdgcn_permlane32_swap(a1, b1, false, false); \
    u32x4 w = {r0[0], r1[0], r0[1], r1[1]}; OUT = __builtin_bit_cast(f16x8, w); } while (0)
    ATT_PK4(p0, 0, pa0); ATT_PK4(p0, 8, pa1); ATT_PK4(p1, 0, pa2); ATT_PK4(p1, 8, pa3);
#undef ATT_PK4
}
template <int ND0, int NREG, int KROWB> __device__ __forceinline__ void qkt(f32x16& p0, f32x16& p1, const LAS char* Ks, const f16x8* qr, const LAS char* ql, int r32, int hi) {
    p0 = f32x16{}; p1 = f32x16{};
#pragma unroll
    for (int d0 = 0; d0 < ND0; ++d0) { const int cb = (d0 * 16 + hi * 8) * 2;
        const f16x8 b0 = *(const LAS f16x8*)(Ks + r32 * KROWB + cb);
        const f16x8 b1 = *(const LAS f16x8*)(Ks + (32 + r32) * KROWB + cb);
        f16x8 qf; if (d0 < NREG) qf = qr[d0 < NREG ? d0 : 0]; else qf = *(const LAS f16x8*)(ql + (d0 - NREG) * 32);
        p0 = __builtin_amdgcn_mfma_f32_32x32x16_f16(b0, qf, p0, 0, 0, 0);
        p1 = __builtin_amdgcn_mfma_f32_32x32x16_f16(b1, qf, p1, 0, 0, 0); }
}
template <int NCB, int D0> __device__ __forceinline__ void pv_one(f32x16& od, int vb, f16x8 pa0, f16x8 pa1, f16x8 pa2, f16x8 pa3) {
    constexpr int KS = 2 * NCB * 512, HF = NCB * 512, B0 = D0 * 512;
    const s16x4 l0 = tr_read<B0 + 0 * KS>(vb), h0 = tr_read<B0 + 0 * KS + HF>(vb), l1 = tr_read<B0 + 1 * KS>(vb), h1 = tr_read<B0 + 1 * KS + HF>(vb);
    const s16x4 l2 = tr_read<B0 + 2 * KS>(vb), h2 = tr_read<B0 + 2 * KS + HF>(vb), l3 = tr_read<B0 + 3 * KS>(vb), h3 = tr_read<B0 + 3 * KS + HF>(vb);
    asm volatile("s_waitcnt lgkmcnt(0)" ::: "memory"); ATT_SBAR();
#define ATT_PK(L, H) __builtin_bit_cast(f16x8, (short __attribute__((ext_vector_type(8)))){L[0], L[1], L[2], L[3], H[0], H[1], H[2], H[3]})
    od = __builtin_amdgcn_mfma_f32_32x32x16_f16(pa0, ATT_PK(l0, h0), od, 0, 0, 0);
    od = __builtin_amdgcn_mfma_f32_32x32x16_f16(pa1, ATT_PK(l1, h1), od, 0, 0, 0);
    od = __builtin_amdgcn_mfma_f32_32x32x16_f16(pa2, ATT_PK(l2, h2), od, 0, 0, 0);
    od = __builtin_amdgcn_mfma_f32_32x32x16_f16(pa3, ATT_PK(l3, h3), od, 0, 0, 0);
#undef ATT_PK
}
template <int NCB> __device__ __forceinline__ void pv_all(f32x16* o, int vb, f16x8 pa0, f16x8 pa1, f16x8 pa2, f16x8 pa3) {
    pv_one<NCB, 0>(o[0], vb, pa0, pa1, pa2, pa3); pv_one<NCB, 1>(o[1], vb, pa0, pa1, pa2, pa3);
    if constexpr (NCB == 4) { pv_one<NCB, 2>(o[2], vb, pa0, pa1, pa2, pa3); pv_one<NCB, 3>(o[3], vb, pa0, pa1, pa2, pa3); }
}

struct UnitDesc { int b, h, qb, isctx, hp; };
template <bool MLA>
__device__ __forceinline__ void attn_unit(Frame& F, const UnitDesc u, int l, LAS char* lds) {
    typedef Cfg<MLA> C_;
    constexpr int DQK = C_::DQK, DV = C_::DV, NCB = C_::NCB, ND0 = C_::ND0, KROWB = C_::KROWB, NREG = C_::NREG;
    const int tid = F.tid, wid = F.wave, lane = F.lane, r32 = lane & 31, hi = lane >> 5;
    LAS char* V_lds = lds + C_::OFF_V; LAS char* K_lds = lds + C_::OFF_K;
    LAS float* ws = (LAS float*)(lds + C_::OFF_WS) + wid * 64; LAS float* li_l = ws; LAS float* al_l = ws + 32;
    const f16* P = WSP(f16, WS_P); const f16* KVM = WSP(f16, WS_KVM);
    const float scale = MLA ? 0.07216878364870322f : 0.125f, Cc = scale * 1.4426950408889634f, thr_raw = 8.0f / scale;
    int qrow0, qpos0, hq;
    if constexpr (MLA) { hq = u.h; qpos0 = u.qb * 256 + wid * 32; qrow0 = (u.isctx ? NLAT + u.b * CTXL : u.b * SEQ) + qpos0; }
    else { hq = u.h * 8 + u.hp * 2 + (wid >> 2); qpos0 = u.qb * 128 + (wid & 3) * 32; qrow0 = (u.isctx ? NLAT + u.b * CTXL : u.b * SEQ) + qpos0; }
    f16x8 qr[ND0];
    { const f16* Qw = MLA ? WSP(f16, WS_QM) + (size_t)(qrow0 + r32) * 1536 + hq * 192 + hi * 8 : P + (size_t)(qrow0 + r32) * NPAD + C_GQ + hq * 64 + hi * 8;
#pragma unroll
      for (int d0 = 0; d0 < ND0; ++d0) qr[d0] = *reinterpret_cast<const f16x8*>(Qw + d0 * 16);
      if (!u.isctx) {
          constexpr int R0 = ND0 - 4;
          const float* cosT = WSP(float, WS_ROPE) + (size_t)(qpos0 + r32) * 32; const float* sinT = cosT + 2048 * 32;
#pragma unroll
          for (int i = 0; i < 2; ++i) {
              const f32x4 c0 = *(const f32x4*)(cosT + 16 * i + 8 * hi), c1 = *(const f32x4*)(cosT + 16 * i + 8 * hi + 4);
              const f32x4 s0 = *(const f32x4*)(sinT + 16 * i + 8 * hi), s1 = *(const f32x4*)(sinT + 16 * i + 8 * hi + 4);
              f16x8 a = qr[R0 + i], b2 = qr[R0 + i + 2], oa, ob;
#pragma unroll
              for (int j = 0; j < 8; ++j) { const float cc = j < 4 ? c0[j] : c1[j - 4], ss = j < 4 ? s0[j] : s1[j - 4]; const float t1 = (float)a[j], t2 = (float)b2[j];
                  oa[j] = (f16)(t1 * cc - t2 * ss); ob[j] = (f16)(t1 * ss + t2 * cc); }
              qr[R0 + i] = oa; qr[R0 + i + 2] = ob; }
      } }
    const LAS char* ql = lds + C_::OFF_Q + wid * (32 * 144) + r32 * 144 + hi * 16;
    f16x8 qreg[NREG];
#pragma unroll
    for (int d0 = 0; d0 < NREG; ++d0) qreg[d0] = qr[d0];
    if constexpr (ND0 > NREG) { __syncthreads();
#pragma unroll
        for (int d0 = NREG; d0 < ND0; ++d0) *(LAS f16x8*)(lds + C_::OFF_Q + wid * (32 * 144) + r32 * 144 + hi * 16 + (d0 - NREG) * 32) = qr[d0]; }
    const int kstart = MLA ? 0 : max(0, 128 * (u.qb - 1));
    const int nlat_tiles = u.isctx ? 0 : (MLA ? 32 : ((u.qb == 0 || u.qb == 15) ? 4 : 6));
    const int NT = 4 + nlat_tiles;
    const int sk = tid >> 3, sj = tid & 7;
    const int ctxrow0 = NLAT + u.b * CTXL, latrow0 = u.b * SEQ + kstart;
#define ATT_KROW(t) ((t) < 4 ? ctxrow0 + 64 * (t) : latrow0 + 64 * ((t) - 4))
    u32x4 sK0, sK1, sK2, sV0, sV1;
#define ATT_KLOAD(t) do { const int kr_ = ATT_KROW(t) + sk; \
      if constexpr (MLA) { const f16* kp_ = KVM + (size_t)kr_ * 2048 + u.h * 256 + sj * 8; \
          sK0 = *(const u32x4*)kp_; sK1 = *(const u32x4*)(kp_ + 64); sK2 = *(const u32x4*)(P + (size_t)kr_ * NPAD + C_KPE + sj * 8); } \
      else { sK0 = *(const u32x4*)(P + (size_t)kr_ * NPAD + C_GK + u.h * 64 + sj * 8); } } while (0)
#define ATT_VLOAD(t) do { const int kr_ = ATT_KROW(t) + sk; \
      if constexpr (MLA) { const f16* kp_ = KVM + (size_t)kr_ * 2048 + u.h * 256 + 128 + sj * 8; sV0 = *(const u32x4*)kp_; sV1 = *(const u32x4*)(kp_ + 64); } \
      else { sV0 = *(const u32x4*)(P + (size_t)kr_ * NPAD + C_GV + u.h * 64 + sj * 8); } } while (0)
#define ATT_KWRITE(bf) do { LAS char* kb_ = K_lds + (bf) * C_::SHM_K + sk * KROWB + sj * 16; *(LAS u32x4*)kb_ = sK0; \
      if constexpr (MLA) { *(LAS u32x4*)(kb_ + 128) = sK1; *(LAS u32x4*)(kb_ + 256) = sK2; } } while (0)
#define ATT_VWRITE(bf) do { LAS char* vb_ = V_lds + (bf) * C_::SHM_V; *(LAS u32x4*)(vb_ + v_st<NCB>(sk, sj * 8)) = sV0; \
      if constexpr (MLA) { *(LAS u32x4*)(vb_ + v_st<NCB>(sk, 64 + sj * 8)) = sV1; } } while (0)
#define ATT_RESC(a) do { if (__any((a) < 1.f)) { if (hi == 0) al_l[r32] = (a); asm volatile("s_waitcnt lgkmcnt(0)" ::: "memory"); \
      _Pragma("unroll") for (int d = 0; d < NCB; ++d) _Pragma("unroll") for (int r = 0; r < 16; ++r) o[d][r] *= al_l[crow(r, hi)]; } } while (0)
#define ATT_MASK(p0, p1, t) do { if constexpr (!MLA) { if ((t) >= 4) { const int kb_ = kstart + 64 * ((t) - 4) + 4 * hi - (qpos0 + r32); \
      if (kb_ < -128 || kb_ + 63 > 128) { _Pragma("unroll") for (int r = 0; r < 16; ++r) { const int dk = kb_ + (r & 3) + 8 * (r >> 2); \
          if (dk < -128 || dk > 128) p0[r] = -1e30f; if (dk + 32 < -128 || dk + 32 > 128) p1[r] = -1e30f; } } } } } while (0)
    const int vb0 = (int)(unsigned)(uintptr_t)V_lds + v_rd_base(lane);
    float m_reg = -1e30f, l_reg = 0.f, alA; f32x16 o[NCB];
#pragma unroll
    for (int d = 0; d < NCB; ++d) o[d] = f32x16{};
    f32x16 pA0, pA1; f16x8 pa0, pa1, pa2, pa3;
    __syncthreads();
    ATT_KLOAD(0); ATT_VLOAD(0); ATT_KWRITE(0); ATT_VWRITE(0); __syncthreads();
#pragma unroll 1
    for (int t = 0; t < NT; ++t) {
        const int bf = t & 1; const bool more = t + 1 < NT;
        if (more) ATT_KLOAD(t + 1);
        qkt<ND0, NREG, KROWB>(pA0, pA1, K_lds + bf * C_::SHM_K, qreg, ql, r32, hi); ATT_MASK(pA0, pA1, t);
        partialSM(pA0, pA1, m_reg, alA, Cc, thr_raw);
        ATT_RESC(alA);
        finishSM(pA0, pA1, alA, l_reg, pa0, pa1, pa2, pa3); ATT_SBAR();
        if (more) { ATT_KWRITE(bf ^ 1); ATT_VLOAD(t + 1); } ATT_SBAR();
        pv_all<NCB>(o, vb0 + bf * C_::SHM_V, pa0, pa1, pa2, pa3);
        if (more) ATT_VWRITE(bf ^ 1);
        __syncthreads();
    }
    if constexpr (!MLA) l_reg += __builtin_amdgcn_exp2f(INP(I_GSINK, l, 16)[hq] * 1.4426950408889634f - m_reg * Cc);
    if (hi == 0) li_l[r32] = l_reg; asm volatile("s_waitcnt lgkmcnt(0)" ::: "memory");
    f16* GT = WSP(f16, WS_GATED) + (size_t)(MLA ? 1 : 2) * MROWS * 1024;
    const int zc = MLA ? C_MZ + hq * 128 : C_GZ + hq * 64, oc = MLA ? hq * 128 : hq * 64;
#pragma unroll
    for (int r = 0; r < 16; ++r) { const int row = qrow0 + crow(r, hi); const float rl = __builtin_amdgcn_rcpf(li_l[crow(r, hi)]);
#pragma unroll
        for (int d0 = 0; d0 < NCB; ++d0) { const float z = (float)P[(size_t)row * NPAD + zc + d0 * 32 + r32];
            GT[(size_t)row * 1024 + oc + d0 * 32 + r32] = (f16)(o[d0][r] * rl * siluf_(z)); } }
#undef ATT_KROW
#undef ATT_KLOAD
#undef ATT_VLOAD
#undef ATT_KWRITE
#undef ATT_VWRITE
#undef ATT_RESC
#undef ATT_MASK
}
#undef ATT_SBAR
}

__device__ __forceinline__ void mla_phase(Frame& F, int l) {
    const int nunits = 256 + (l == 0 ? 32 : 0);
    for (int it = F.bid; it < nunits; it += F.G) {
        att::UnitDesc u;
        if (it < 256) { u.b = it >> 6; u.h = (it >> 3) & 7; u.qb = it & 7; u.isctx = 0; } else { const int q = it - 256; u.b = q >> 3; u.h = q & 7; u.qb = 0; u.isctx = 1; }
        u.hp = 0;
        att::attn_unit<true>(F, u, l, (LAS char*)F.lds);
    }
}
__device__ __forceinline__ void gqa_phase(Frame& F, int l) {
    const int nunits = 512 + (l == 0 ? 64 : 0);
    for (int it = F.bid; it < nunits; it += F.G) {
        att::UnitDesc u;
        if (it < 512) { u.b = it >> 7; u.h = (it >> 6) & 1; u.qb = (it >> 2) & 15; u.hp = it & 3; u.isctx = 0; }
        else { const int q = it - 512; u.b = q >> 4; u.h = (q >> 3) & 1; u.qb = (q >> 2) & 1; u.hp = q & 3; u.isctx = 1; }
        att::attn_unit<false>(F, u, l, (LAS char*)F.lds);
    }
}

#ifndef HY_PROBE
#define HY_PROBE 0
#endif
namespace hy {
constexpr int FREG = 8448;
constexpr int WBLK = 80;
constexpr int WREG = 65 * WBLK;
constexpr int OFF_F = 0, OFF_W = 8 * FREG, OFF_CW = OFF_W + 8 * WREG, LDS_TOTAL = OFF_CW + 512;
static_assert(LDS_TOTAL <= RING_BYTES, "hyena LDS");

__device__ __forceinline__ void load8(const f16* p, float (&o)[8]) { const f16x8 v = *(const f16x8*)p;
#pragma unroll
    for (int j = 0; j < 8; ++j) o[j] = (float)v[j]; }

__device__ __forceinline__ void conv8(const f16* P, int row0, int i, int n, int col, const LAS float* cw, int t, float (&o)[8]) {
    float a[8], b[8], c[8];
    load8(P + (size_t)(row0 + i) * NPAD + col, b);
    if (i > 0) load8(P + (size_t)(row0 + i - 1) * NPAD + col, a); else {
#pragma unroll
        for (int j = 0; j < 8; ++j) a[j] = 0.f; }
    if (i < n - 1) load8(P + (size_t)(row0 + i + 1) * NPAD + col, c); else {
#pragma unroll
        for (int j = 0; j < 8; ++j) c[j] = 0.f; }
#pragma unroll
    for (int j = 0; j < 8; ++j) o[j] = cw[(t * 4 + 0) * 8 + j] * a[j] + cw[(t * 4 + 1) * 8 + j] * b[j] + cw[(t * 4 + 2) * 8 + j] * c[j] + cw[(t * 4 + 3) * 8 + j];
}

__device__ __forceinline__ void hyena_unit(Frame& F, int l, int b, int isctx, int cg) {
    const int tid = F.tid, lane = F.lane, wid = F.wave;
    const int n = isctx ? CTXL : SEQ, nblk = n / 32, c0 = cg * 8;
    const int row0 = isctx ? NLAT + b * CTXL : b * SEQ;
    const f16* P = WSP(f16, WS_P);
    LAS char* lds = (LAS char*)F.lds;
    LAS float* cw = (LAS float*)(lds + OFF_CW);
    for (int rp_ = 0; rp_ < (HY_PROBE == 1 ? 2 : 1); ++rp_) {
    __syncthreads();
    if (tid < 96) { const int t = tid / 32, q = (tid % 32) / 8, j = tid & 7; const int ch = t * 1024 + c0 + j;
        cw[(t * 4 + q) * 8 + j] = q < 3 ? INP(I_HCW, l, 3 * 3072)[q * 3072 + ch] : INP(I_HCB, l, 3072)[ch]; }
    { const f16* hf = (const f16*)(F.ws + WS_HF + (size_t)l * HF_LAYER + (isctx ? HF_LAT : 0)) + c0;
      if (!isctx) { f16x8 v[8];
#pragma unroll
          for (int q = 0; q < 8; ++q) v[q] = *(const f16x8*)(hf + (size_t)(tid + q * NTHREADS) * 1024);
#pragma unroll
          for (int q = 0; q < 8; ++q)
#pragma unroll
              for (int j = 0; j < 8; ++j) *(LAS f16*)(lds + OFF_F + j * FREG + (tid + q * NTHREADS) * 2) = v[q][j]; }
      else { const f16x8 v = *(const f16x8*)(hf + (size_t)tid * 1024);
#pragma unroll
          for (int j = 0; j < 8; ++j) *(LAS f16*)(lds + OFF_F + j * FREG + tid * 2) = v[j]; } }
    if (tid < 8 * 5) { const int j = tid / 5, q = tid % 5; *(LAS u32x4*)(lds + OFF_W + j * WREG + nblk * WBLK + q * 16) = (u32x4){0u, 0u, 0u, 0u}; }
    __syncthreads();
    for (int i = tid; i < n; i += NTHREADS) {
        float x1[8], vv[8];
        conv8(P, row0, i, n, C_HXV + 1024 + c0, cw, 1, x1); conv8(P, row0, i, n, C_HXV + 2048 + c0, cw, 2, vv);
#pragma unroll
        for (int j = 0; j < 8; ++j) *(LAS f16*)(lds + OFF_W + j * WREG + (i >> 5) * WBLK + (i & 31) * 2) = (f16)(x1[j] * vv[j]);
    }
    __syncthreads();
    }
    f32x16 acc0 = f32x16{}, acc1 = f32x16{};
    for (int rp_ = 0; rp_ < (HY_PROBE == 2 ? 2 : 1); ++rp_) {
        if (rp_) { acc0 = f32x16{}; acc1 = f32x16{}; asm volatile("" : "+v"(acc0), "+v"(acc1)); }
        const int r = lane & 31, half = lane >> 5;
        const LAS char* fb = lds + OFF_F + wid * FREG; const LAS char* wb = lds + OFF_W + wid * WREG;
        const int ntile = nblk > 32 ? 2 : 1;
#pragma unroll 1
        for (int dd = -(nblk - 1); dd <= nblk - 1; ++dd) {
            const int y0 = n - 32 * dd - r + 8 * half;
            const unsigned sh = (unsigned)(y0 & 1) << 4;
            const LAS unsigned* fp = (const LAS unsigned*)(fb + ((y0 >> 1) << 2));
            unsigned d[13];
#pragma unroll
            for (int q = 0; q < 5; ++q) d[q] = fp[q];
#pragma unroll
            for (int q = 0; q < 5; ++q) d[8 + q] = fp[8 + q];
            u32x4 a0w, a1w;
#pragma unroll
            for (int q = 0; q < 4; ++q) { a0w[q] = __builtin_amdgcn_alignbit(d[q + 1], d[q], sh); a1w[q] = __builtin_amdgcn_alignbit(d[8 + q + 1], d[8 + q], sh); }
            const f16x8 A0 = __builtin_bit_cast(f16x8, a0w), A1 = __builtin_bit_cast(f16x8, a1w);
            if (dd <= 31) {
                int blk = r - dd; blk = (blk >= 0 && blk < nblk) ? blk : nblk;
                const LAS char* bp = wb + blk * WBLK + 16 * half;
                const f16x8 B0 = *(const LAS f16x8*)bp, B1 = *(const LAS f16x8*)(bp + 32);
                acc0 = __builtin_amdgcn_mfma_f32_32x32x16_f16(A0, B0, acc0, 0, 0, 0);
                acc0 = __builtin_amdgcn_mfma_f32_32x32x16_f16(A1, B1, acc0, 0, 0, 0);
            }
            if (ntile == 2 && dd >= -31) {
                int blk = 32 + r - dd; blk = (blk >= 0 && blk < nblk) ? blk : nblk;
                const LAS char* bp = wb + blk * WBLK + 16 * half;
                const f16x8 B0 = *(const LAS f16x8*)bp, B1 = *(const LAS f16x8*)(bp + 32);
                acc1 = __builtin_amdgcn_mfma_f32_32x32x16_f16(A0, B0, acc1, 0, 0, 0);
                acc1 = __builtin_amdgcn_mfma_f32_32x32x16_f16(A1, B1, acc1, 0, 0, 0);
            }
        }
        if (HY_PROBE == 2 && rp_ == 0) { asm volatile("" :: "v"(acc0), "v"(acc1)); continue; }
        asm volatile("s_waitcnt lgkmcnt(0)" ::: "memory");
        LAS float* yo = (LAS float*)(lds + OFF_F + wid * FREG);
#pragma unroll
        for (int q = 0; q < 16; ++q) { const int rr = (q & 3) + 8 * (q >> 2) + 4 * half;
            if (r < nblk) yo[(32 * r + rr) + r] = acc0[q];
            if (ntile == 2) yo[(32 * (32 + r) + rr) + (32 + r)] = acc1[q]; }
    }
    __syncthreads();
    for (int rp_ = 0; rp_ < (HY_PROBE == 3 ? 2 : 1); ++rp_) {
        f16* GT = WSP(f16, WS_GATED) + (size_t)3 * MROWS * 1024;
        const float* dsk = INP(I_HD, l, 1024) + c0;
        for (int i = tid; i < n; i += NTHREADS) {
            float x0[8], z[8]; conv8(P, row0, i, n, C_HXV + c0, cw, 0, x0); load8(P + (size_t)(row0 + i) * NPAD + C_HZ + c0, z);
            f32x4 o0, o1;
#pragma unroll
            for (int j = 0; j < 8; ++j) {
                const float y = *(const LAS float*)(lds + OFF_F + j * FREG + (i + (i >> 5)) * 4);
                const float w = (float)*(const LAS f16*)(lds + OFF_W + j * WREG + (i >> 5) * WBLK + (i & 31) * 2);
                const float o = x0[j] * siluf_(z[j]) * (y + w * dsk[j]);
                if (j < 4) o0[j] = o; else o1[j - 4] = o; }
            *(u32x4*)(GT + (size_t)(row0 + i) * 1024 + c0) = pkh8(o0, o1);
        }
    }
}
}
__device__ __forceinline__ void hyena_phase(Frame& F, int l) {
    const int nunits = 512 + (l == 0 ? 512 : 0);
    for (int it = F.bid; it < nunits; it += F.G) {
        const int isctx = it >= 512, q = it & 511;
        hy::hyena_unit(F, l, q >> 7, isctx, q & 127);
    }
}

namespace ssd {
using att::s16x4; using att::tr_read; using att::v_st; using att::v_rd_base; using att::crow;
constexpr size_t L_ELEMS = (size_t)64 * 128;
__device__ __forceinline__ size_t state_index(int b, int sc, int h, int dir) { return ((((size_t)b * 18 + sc) * 16 + h) * 2 + dir) * L_ELEMS; }
constexpr int TAB_OFF = 0;
constexpr int CW_OFF = 16384;
constexpr int END_OFF = CW_OFF + 12288;
constexpr int SSQ_OFF = END_OFF + 64;
constexpr int BM_OFF = 29824;
constexpr int XS_OFF = BM_OFF + 34816;
constexpr int LDS_TOTAL = XS_OFF + 65536;
static_assert(LDS_TOTAL <= RING_BYTES, "ssd LDS");
constexpr int KROWB = 272;

struct Unit { int b, sc, g, row0, n, i0; };
__device__ __forceinline__ Unit make_unit(int b, int sc, int g) { Unit u; u.b = b; u.sc = sc; u.g = g;
    if (sc < 2) { u.row0 = NLAT + b * CTXL; u.n = CTXL; u.i0 = sc * 128; } else { u.row0 = b * SEQ; u.n = SEQ; u.i0 = (sc - 2) * 128; } return u; }

__device__ __forceinline__ void stage_common(Frame& F, const Unit& u, int l, LAS char* lds) {
    const f16* P = WSP(f16, WS_P);
    LAS float* cw = (LAS float*)(lds + CW_OFF);
    for (int i = F.tid; i < 4 * 768; i += NTHREADS) { const int q = i / 768, c = i % 768;
        const int ch = c < 512 ? u.g * 512 + c : (c < 640 ? 1024 + u.g * 128 + (c - 512) : 1280 + u.g * 128 + (c - 640));
        cw[i] = q < 3 ? INP(I_SCW, l, 3 * 1536)[q * 1536 + ch] : INP(I_SCB, l, 1536)[ch]; }
    { const int h = u.g * 8 + F.wave, lane = F.lane;
      const float af = -expf(INP(I_SALOG, l, 32)[h]), ab = -expf(INP(I_SALOG, l, 32)[16 + h]);
      const float bf = INP(I_SDTB, l, 32)[h], bb = INP(I_SDTB, l, 32)[16 + h];
      const f16* pr = P + (size_t)(u.row0 + u.i0 + 2 * lane) * NPAD + C_DT;
      const float dtf0 = softplusf_((float)pr[h] + bf), dtf1 = softplusf_((float)pr[NPAD + h] + bf);
      const float dtb0 = softplusf_((float)pr[16 + h] + bb), dtb1 = softplusf_((float)pr[NPAD + 16 + h] + bb);
      const float laf0 = dtf0 * af, laf1 = dtf1 * af, lab0 = dtb0 * ab, lab1 = dtb1 * ab;
      float sf = laf0 + laf1, sb = lab0 + lab1;
#pragma unroll
      for (int o = 1; o < 64; o <<= 1) { const float tf = __shfl_up(sf, o), tb = __shfl_up(sb, o); if (lane >= o) { sf += tf; sb += tb; } }
      const float totb = __shfl(sb, 63), totf = __shfl(sf, 63);
      const float exf = sf - (laf0 + laf1), exb = sb - (lab0 + lab1);
      LAS f32x4* tab = (LAS f32x4*)(lds + TAB_OFF) + F.wave * 128;
      tab[2 * lane] = (f32x4){exf + laf0, totb - exb, dtf0, dtb0};
      tab[2 * lane + 1] = (f32x4){sf, totb - sb + lab1, dtf1, dtb1};
      if (lane == 0) { LAS float* en = (LAS float*)(lds + END_OFF) + F.wave * 2; en[0] = totf; en[1] = totb; } }
}
__device__ __forceinline__ void conv_silu8(const f16* P, const Unit& u, int i, int cl, const LAS float* cw, float (&o)[8]) {
    const int col = C_XBC + (cl < 512 ? u.g * 512 + cl : (cl < 640 ? 1024 + u.g * 128 + (cl - 512) : 1280 + u.g * 128 + (cl - 640)));
    const int tok = u.i0 + i;
    float a[8], b[8], c[8];
    hy::load8(P + (size_t)(u.row0 + tok) * NPAD + col, b);
    if (tok > 0) hy::load8(P + (size_t)(u.row0 + tok - 1) * NPAD + col, a); else {
#pragma unroll
        for (int j = 0; j < 8; ++j) a[j] = 0.f; }
    if (tok < u.n - 1) hy::load8(P + (size_t)(u.row0 + tok + 1) * NPAD + col, c); else {
#pragma unroll
        for (int j = 0; j < 8; ++j) c[j] = 0.f; }
#pragma unroll
    for (int j = 0; j < 8; ++j) o[j] = siluf_(cw[cl + j] * a[j] + cw[768 + cl + j] * b[j] + cw[1536 + cl + j] * c[j] + cw[2304 + cl + j]);
}
__device__ __forceinline__ u32x4 pack8(const float (&o)[8]) { u32x4 w; w.x = pkh(o[0], o[1]); w.y = pkh(o[2], o[3]); w.z = pkh(o[4], o[5]); w.w = pkh(o[6], o[7]); return w; }
__device__ __forceinline__ void stage_x(Frame& F, const Unit& u, int hq, LAS char* lds) {
    const f16* P = WSP(f16, WS_P); const LAS float* cw = (const LAS float*)(lds + CW_OFF);
    for (int e = F.tid; e < 128 * 32; e += NTHREADS) { const int i = e >> 5, q = e & 31, hh = q >> 3, ck = q & 7;
        float o[8]; conv_silu8(P, u, i, (hq * 4 + hh) * 64 + ck * 8, cw, o);
        *(LAS u32x4*)(lds + XS_OFF + hh * 16384 + v_st<2>(i, ck * 8)) = pack8(o); }
}
#define SSD_FRAG(L, H) __builtin_bit_cast(f16x8, (short __attribute__((ext_vector_type(8)))){L[0], L[1], L[2], L[3], H[0], H[1], H[2], H[3]})

__device__ __forceinline__ void s1_unit(Frame& F, const Unit u, int l) {
    LAS char* lds = (LAS char*)F.lds; const f16* P = WSP(f16, WS_P);
    const int lane = F.lane, wid = F.wave, r32 = lane & 31, hi = lane >> 5;
    __syncthreads();
    stage_common(F, u, l, lds);
    __syncthreads();
    { const LAS float* cw = (const LAS float*)(lds + CW_OFF);
      for (int e = F.tid; e < 128 * 16; e += NTHREADS) { const int i = e >> 4, ck = e & 15;
          float o[8]; conv_silu8(P, u, i, 512 + ck * 8, cw, o);
          *(LAS u32x4*)(lds + BM_OFF + v_st<4>(i, ck * 8)) = pack8(o); } }
    if (F.tid < 16) { const int hh = F.tid >> 1, dir = F.tid & 1; const LAS float* en = (const LAS float*)(lds + END_OFF) + hh * 2;
        WSP(float, WS_SB)[(((size_t)u.b * 18 + u.sc) * 16 + u.g * 8 + hh) * 2 + dir] = expf(en[dir]); }
#pragma unroll 1
    for (int hq = 0; hq < 2; ++hq) {
        __syncthreads();
        stage_x(F, u, hq, lds);
        __syncthreads();
        const int hh = hq * 4 + (wid >> 1), dir = wid & 1;
        const LAS f32x4* tab = (const LAS f32x4*)(lds + TAB_OFF) + hh * 128;
        const float cend = ((const LAS float*)(lds + END_OFF))[hh * 2 + dir];
        const int xb = (int)(unsigned)(uintptr_t)(lds + XS_OFF + (wid >> 1) * 16384) + v_rd_base(lane);
        const int bb = (int)(unsigned)(uintptr_t)(lds + BM_OFF) + v_rd_base(lane);
        f32x16 acc[2][4];
#pragma unroll
        for (int a = 0; a < 2; ++a)
#pragma unroll
            for (int c = 0; c < 4; ++c) acc[a][c] = f32x16{};
#define SSD_S1_STEP(KS) do { \
            f16x8 wv; { _Pragma("unroll") for (int j = 0; j < 8; ++j) { const f32x4 t = tab[(KS) * 16 + 8 * hi + j]; wv[j] = (f16)(fast_exp(cend - (dir ? t[1] : t[0])) * (dir ? t[3] : t[2])); } } \
            const s16x4 xl0 = tr_read<0 * 512 + (KS) * 2048>(xb), xh0 = tr_read<0 * 512 + (KS) * 2048 + 1024>(xb), xl1 = tr_read<1 * 512 + (KS) * 2048>(xb), xh1 = tr_read<1 * 512 + (KS) * 2048 + 1024>(xb); \
            const s16x4 bl0 = tr_read<0 * 512 + (KS) * 4096>(bb), bh0 = tr_read<0 * 512 + (KS) * 4096 + 2048>(bb), bl1 = tr_read<1 * 512 + (KS) * 4096>(bb), bh1 = tr_read<1 * 512 + (KS) * 4096 + 2048>(bb); \
            const s16x4 bl2 = tr_read<2 * 512 + (KS) * 4096>(bb), bh2 = tr_read<2 * 512 + (KS) * 4096 + 2048>(bb), bl3 = tr_read<3 * 512 + (KS) * 4096>(bb), bh3 = tr_read<3 * 512 + (KS) * 4096 + 2048>(bb); \
            asm volatile("s_waitcnt lgkmcnt(0)" ::: "memory"); __builtin_amdgcn_sched_barrier(0); \
            const f16x8 A0 = SSD_FRAG(xl0, xh0) * wv, A1 = SSD_FRAG(xl1, xh1) * wv; \
            const f16x8 B0 = SSD_FRAG(bl0, bh0), B1 = SSD_FRAG(bl1, bh1), B2 = SSD_FRAG(bl2, bh2), B3 = SSD_FRAG(bl3, bh3); \
            acc[0][0] = __builtin_amdgcn_mfma_f32_32x32x16_f16(A0, B0, acc[0][0], 0, 0, 0); acc[0][1] = __builtin_amdgcn_mfma_f32_32x32x16_f16(A0, B1, acc[0][1], 0, 0, 0); \
            acc[0][2] = __builtin_amdgcn_mfma_f32_32x32x16_f16(A0, B2, acc[0][2], 0, 0, 0); acc[0][3] = __builtin_amdgcn_mfma_f32_32x32x16_f16(A0, B3, acc[0][3], 0, 0, 0); \
            acc[1][0] = __builtin_amdgcn_mfma_f32_32x32x16_f16(A1, B0, acc[1][0], 0, 0, 0); acc[1][1] = __builtin_amdgcn_mfma_f32_32x32x16_f16(A1, B1, acc[1][1], 0, 0, 0); \
            acc[1][2] = __builtin_amdgcn_mfma_f32_32x32x16_f16(A1, B2, acc[1][2], 0, 0, 0); acc[1][3] = __builtin_amdgcn_mfma_f32_32x32x16_f16(A1, B3, acc[1][3], 0, 0, 0); } while (0)
        SSD_S1_STEP(0); SSD_S1_STEP(1); SSD_S1_STEP(2); SSD_S1_STEP(3); SSD_S1_STEP(4); SSD_S1_STEP(5); SSD_S1_STEP(6); SSD_S1_STEP(7);
#undef SSD_S1_STEP
        float* Lo = (float*)(F.ws + WS_SA) + state_index(u.b, u.sc, u.g * 8 + hh, dir);
#pragma unroll
        for (int a = 0; a < 2; ++a)
#pragma unroll
            for (int r = 0; r < 16; ++r) { const int p = 32 * a + crow(r, hi);
#pragma unroll
                for (int c = 0; c < 4; ++c) Lo[(size_t)p * 128 + 32 * c + r32] = acc[a][c][r]; }
    }
}
__device__ __forceinline__ void s1_phase(Frame& F, int l) {
    for (int it = F.bid; it < 4 * 18 * 2; it += F.G) { const int b = it / 36, q = it % 36; s1_unit(F, make_unit(b, q >> 1, q & 1), l); }
}
__device__ __forceinline__ void s2_piece(Frame& F, int piece) {
    const float* Lb = (const float*)(F.ws + WS_SA); f16* Sp = (f16*)(F.ws + WS_SC); const float* DEC = WSP(float, WS_SB);
    { const int e = piece * NTHREADS + F.tid;
        const int q8 = e & 1023, dir = (e >> 10) & 1, h = (e >> 11) & 15, b = e >> 15;
        f32x4 s0 = {0.f, 0.f, 0.f, 0.f}, s1 = {0.f, 0.f, 0.f, 0.f};
#pragma unroll 2
        for (int k = 0; k < 18; ++k) {
            const int sc = dir == 0 ? k : (k < 2 ? 1 - k : 19 - k);
            const size_t off = state_index(b, sc, h, dir) + (size_t)q8 * 8;
            *(u32x4*)(Sp + off) = pkh8(s0, s1);
            const float d = DEC[(((size_t)b * 18 + sc) * 16 + h) * 2 + dir];
            s0 = s0 * d + *(const f32x4*)(Lb + off); s1 = s1 * d + *(const f32x4*)(Lb + off + 4);
        }
    }
}
__device__ __forceinline__ void s3_unit(Frame& F, const Unit u, int l) {
    LAS char* lds = (LAS char*)F.lds; const f16* P = WSP(f16, WS_P);
    const int lane = F.lane, wid = F.wave, r32 = lane & 31, hi = lane >> 5, li = wid & 3;
    __syncthreads();
    stage_common(F, u, l, lds);
    __syncthreads();
    { const LAS float* cw = (const LAS float*)(lds + CW_OFF);
      for (int e = F.tid; e < 128 * 32; e += NTHREADS) { const int i = e >> 5, q = e & 31, isc = q >> 4, ck = q & 15;
          float o[8]; conv_silu8(P, u, i, 512 + isc * 128 + ck * 8, cw, o);
          *(LAS u32x4*)(lds + (isc ? XS_OFF : BM_OFF) + i * KROWB + ck * 16) = pack8(o); } }
    if (F.tid < 256) ((LAS float*)(lds + SSQ_OFF))[F.tid] = 0.f;
    __syncthreads();
    f16x8 qr[8];
#pragma unroll
    for (int d0 = 0; d0 < 8; ++d0) qr[d0] = *(const LAS f16x8*)(lds + XS_OFF + (li * 32 + r32) * KROWB + (d0 * 16 + hi * 8) * 2);
    f32x16 gt[4];
#pragma unroll
    for (int st = 0; st < 4; ++st) { gt[st] = f32x16{};
#pragma unroll
        for (int d0 = 0; d0 < 8; ++d0) { const f16x8 bf = *(const LAS f16x8*)(lds + BM_OFF + (st * 32 + r32) * KROWB + (d0 * 16 + hi * 8) * 2);
            gt[st] = __builtin_amdgcn_mfma_f32_32x32x16_f16(bf, qr[d0], gt[st], 0, 0, 0); } }
    const int lrow = li * 32 + r32;
    float ssacc[16];
#pragma unroll
    for (int r = 0; r < 16; ++r) ssacc[r] = 0.f;
    f16* GT = WSP(f16, WS_GATED);
    const f16* Sp = (const f16*)(F.ws + WS_SC);
#pragma unroll 1
    for (int hq = 0; hq < 2; ++hq) {
        __syncthreads();
        stage_x(F, u, hq, lds);
        __syncthreads();
#pragma unroll 1
        for (int e2 = 0; e2 < 2; ++e2) {
            const int hx = (wid >> 2) * 2 + e2, hh = hq * 4 + hx, h = u.g * 8 + hh;
            const LAS f32x4* tab = (const LAS f32x4*)(lds + TAB_OFF) + hh * 128;
            const int lane = lane_id_opaque(), r32 = lane & 31, hi = lane >> 5; const int lrow_ = li * 32 + r32;
            const f32x4 tl = tab[lrow_];
            f16x8 pa[8];
#define SSD_W(ST, R) ({ const int s_ = 32 * (ST) + (R & 3) + 8 * (R >> 2) + 4 * hi; const f32x4 ts_ = tab[s_]; \
                const float arg_ = s_ < lrow_ ? tl[0] - ts_[0] : (s_ > lrow_ ? tl[1] - ts_[1] : 0.f); \
                const float mul_ = s_ < lrow_ ? ts_[2] : (s_ > lrow_ ? ts_[3] : ts_[2] + ts_[3]); \
                gt[ST][R] * fast_exp(arg_) * mul_; })
#define SSD_PK4(ST, BASE, OUT) do { const unsigned a0 = pkh(SSD_W(ST, BASE + 0), SSD_W(ST, BASE + 1)), a1 = pkh(SSD_W(ST, BASE + 2), SSD_W(ST, BASE + 3)); \
                const unsigned b0 = pkh(SSD_W(ST, BASE + 4), SSD_W(ST, BASE + 5)), b1 = pkh(SSD_W(ST, BASE + 6), SSD_W(ST, BASE + 7)); \
                auto r0 = __builtin_amdgcn_permlane32_swap(a0, b0, false, false); auto r1 = __builtin_amdgcn_permlane32_swap(a1, b1, false, false); \
                u32x4 w = {r0[0], r1[0], r0[1], r1[1]}; OUT = __builtin_bit_cast(f16x8, w); } while (0)
#define SB_ __builtin_amdgcn_sched_barrier(0)
            SB_; SSD_PK4(0, 0, pa[0]); SB_; SSD_PK4(0, 8, pa[1]); SB_; SSD_PK4(1, 0, pa[2]); SB_; SSD_PK4(1, 8, pa[3]); SB_;
            SSD_PK4(2, 0, pa[4]); SB_; SSD_PK4(2, 8, pa[5]); SB_; SSD_PK4(3, 0, pa[6]); SB_; SSD_PK4(3, 8, pa[7]); SB_;
#undef SB_
#undef SSD_PK4
#undef SSD_W
            f32x16 o[2] = {f32x16{}, f32x16{}};
            const int xb = (int)(unsigned)(uintptr_t)(lds + XS_OFF + hx * 16384) + v_rd_base(lane);
#define SSD_PV(KS) do { const s16x4 l0 = tr_read<(KS) * 2048>(xb), h0 = tr_read<(KS) * 2048 + 1024>(xb), l1 = tr_read<512 + (KS) * 2048>(xb), h1 = tr_read<512 + (KS) * 2048 + 1024>(xb); \
                asm volatile("s_waitcnt lgkmcnt(0)" ::: "memory"); __builtin_amdgcn_sched_barrier(0); \
                o[0] = __builtin_amdgcn_mfma_f32_32x32x16_f16(pa[KS], SSD_FRAG(l0, h0), o[0], 0, 0, 0); o[1] = __builtin_amdgcn_mfma_f32_32x32x16_f16(pa[KS], SSD_FRAG(l1, h1), o[1], 0, 0, 0); } while (0)
            SSD_PV(0); SSD_PV(1); SSD_PV(2); SSD_PV(3); SSD_PV(4); SSD_PV(5); SSD_PV(6); SSD_PV(7);
#undef SSD_PV
            { const f16 ef = (f16)fast_exp(tl[0]), eb = (f16)fast_exp(tl[1]);
              const f16* sf = Sp + state_index(u.b, u.sc, h, 0) + (size_t)r32 * 128 + hi * 8; const f16* sb = sf + L_ELEMS;
#define SSD_ST(D0) do { const f16x8 af = qr[D0] * ef, ab = qr[D0] * eb; \
                  const f16x8 f0 = *(const f16x8*)(sf + (D0) * 16), f1 = *(const f16x8*)(sf + 32 * 128 + (D0) * 16); \
                  const f16x8 b0 = *(const f16x8*)(sb + (D0) * 16), b1 = *(const f16x8*)(sb + 32 * 128 + (D0) * 16); \
                  o[0] = __builtin_amdgcn_mfma_f32_32x32x16_f16(af, f0, o[0], 0, 0, 0); o[1] = __builtin_amdgcn_mfma_f32_32x32x16_f16(af, f1, o[1], 0, 0, 0); \
                  o[0] = __builtin_amdgcn_mfma_f32_32x32x16_f16(ab, b0, o[0], 0, 0, 0); o[1] = __builtin_amdgcn_mfma_f32_32x32x16_f16(ab, b1, o[1], 0, 0, 0); } while (0)
              __builtin_amdgcn_sched_barrier(0);
              SSD_ST(0); SSD_ST(1); SSD_ST(2); SSD_ST(3); __builtin_amdgcn_sched_barrier(0);
              SSD_ST(4); SSD_ST(5); SSD_ST(6); SSD_ST(7); __builtin_amdgcn_sched_barrier(0);
#undef SSD_ST
            }
            const float dsk = INP(I_SD, l, 16)[h];
#pragma unroll
            for (int r = 0; r < 16; ++r) { const int lr = li * 32 + crow(r, hi), row = u.row0 + u.i0 + lr;
#pragma unroll
                for (int pt = 0; pt < 2; ++pt) { const int p = 32 * pt + r32;
                    const float x = (float)*(const LAS f16*)(lds + XS_OFF + hx * 16384 + v_st<2>(lr, p & ~7) + (p & 7) * 2);
                    const float z = (float)P[(size_t)row * NPAD + C_SZ + h * 64 + p];
                    const float gv = (o[pt][r] + x * dsk) * siluf_(z);
                    GT[(size_t)row * 1024 + h * 64 + p] = (f16)gv; ssacc[r] += gv * gv; } }
        }
    }
#pragma unroll
    for (int r = 0; r < 16; ++r) { float v = ssacc[r];
#pragma unroll
        for (int o = 1; o < 32; o <<= 1) v += __shfl_xor(v, o);
        if (r32 == 0) ((LAS float*)(lds + SSQ_OFF))[(wid >> 2) * 128 + li * 32 + crow(r, hi)] = v; }
    asm volatile("s_waitcnt vmcnt(0)" ::: "memory");
    __syncthreads();
    { const LAS float* sq = (const LAS float*)(lds + SSQ_OFF);
      for (int e = F.tid; e < 128 * 64; e += NTHREADS) { const int i = e >> 6, ck = e & 63;
          const float rs = 1.0f / sqrtf((sq[i] + sq[128 + i]) * (1.f / 512.f) + LN_EPS);
          f16* gp = GT + (size_t)(u.row0 + u.i0 + i) * 1024 + u.g * 512 + ck * 8;
          f16x8 v = *(const f16x8*)gp;
#pragma unroll
          for (int j = 0; j < 8; ++j) v[j] = (f16)((float)v[j] * rs);
          *(f16x8*)gp = v; } }
}
__device__ __forceinline__ void s3_phase(Frame& F, int l) {
    const int nsc = l == 0 ? 18 : 16, sc0 = l == 0 ? 0 : 2;
    for (int it = F.bid; it < 4 * nsc * 2; it += F.G) { const int b = it / (nsc * 2), q = it % (nsc * 2); s3_unit(F, make_unit(b, sc0 + (q >> 1), q & 1), l); }
}
#undef SSD_FRAG
}

#ifndef USE_MFMA_GQA
#define USE_MFMA_GQA 1
#endif
#ifndef USE_MFMA_MLA
#define USE_MFMA_MLA 1
#endif
#ifndef USE_MFMA_HY
#define USE_MFMA_HY 1
#endif
#ifndef DUP
#define DUP 0
#endif
#define REP(k) for (int rep_ = 0; rep_ < ((DUP == (k)) ? 2 : 1); ++rep_)
#ifndef MK_ONE_LAUNCH
#define MK_ONE_LAUNCH 1
#endif
constexpr int PH_PER_LAYER = 7, N_PHASES = 2 + PH_PER_LAYER * DEPTH;
constexpr int CW_BAR = 4096;

__device__ __forceinline__ int opaque_zero() { int v = 0; asm volatile("" : "+v"(v)); return __builtin_amdgcn_readfirstlane(v); }
__device__ __forceinline__ unsigned long long opaque_u64(unsigned long long x) { unsigned lo = (unsigned)x, hi = (unsigned)(x >> 32); asm volatile("" : "+v"(lo), "+v"(hi));
    lo = __builtin_amdgcn_readfirstlane(lo); hi = __builtin_amdgcn_readfirstlane(hi); return ((unsigned long long)hi << 32) | lo; }
__device__ __forceinline__ int dq_next(Frame& F, int qid) {
    LAS int* slot = (LAS int*)(F.lds + MISC_OFF + 64);
    __syncthreads();
    if (F.tid == 0) *slot = (int)__hip_atomic_fetch_add((unsigned*)(F.ws + WS_CTL) + 8192 + 64 * qid, 1u, __ATOMIC_RELAXED, __HIP_MEMORY_SCOPE_AGENT);
    __syncthreads();
    return *slot;
}
__device__ __forceinline__ void mix2_phase(Frame& F, int l) {
    const int nhl = 512, ngl = 512, ngc = l == 0 ? 64 : 0, nhc = l == 0 ? 512 : 0, ns2 = 256;
    const int total = nhl + ngl + ngc + nhc + ns2;
    for (;;) {
        int it = dq_next(F, l * 4 + 0); if (it >= total) break;
        F.lane = lane_id_opaque(); F.tid = F.wave * 64 + F.lane;
        if (it < nhl) { hy::hyena_unit(F, l, it >> 7, 0, it & 127); continue; } it -= nhl;
        if (it < ngl) { att::UnitDesc u; u.b = it >> 7; u.h = (it >> 6) & 1; u.qb = (it >> 2) & 15; u.hp = it & 3; u.isctx = 0; att::attn_unit<false>(F, u, l, (LAS char*)F.lds); continue; } it -= ngl;
        if (it < ngc) { att::UnitDesc u; u.b = it >> 4; u.h = (it >> 3) & 1; u.qb = (it >> 2) & 1; u.hp = it & 3; u.isctx = 1; att::attn_unit<false>(F, u, l, (LAS char*)F.lds); continue; } it -= ngc;
        if (it < nhc) { hy::hyena_unit(F, l, it >> 7, 1, it & 127); continue; } it -= nhc;
        ssd::s2_piece(F, it);
    }
}
__device__ __forceinline__ void mix3_phase(Frame& F, int l) {
    const int nsc = l == 0 ? 18 : 16, sc0 = l == 0 ? 0 : 2, n3 = 4 * nsc * 2, nml = 256, nmc = l == 0 ? 32 : 0;
    const int total = n3 + nml + nmc;
    for (;;) {
        int it = dq_next(F, l * 4 + 1); if (it >= total) break;
        F.lane = lane_id_opaque(); F.tid = F.wave * 64 + F.lane;
        if (it < n3) { const int b = it / (nsc * 2), q = it % (nsc * 2); ssd::s3_unit(F, ssd::make_unit(b, sc0 + (q >> 1), q & 1), l); continue; } it -= n3;
        att::UnitDesc u; u.hp = 0;
        if (it < nml) { u.b = it >> 6; u.h = (it >> 3) & 7; u.qb = it & 7; u.isctx = 0; } else { const int q = it - nml; u.b = q >> 3; u.h = q & 7; u.qb = 0; u.isctx = 1; }
        att::attn_unit<true>(F, u, l, (LAS char*)F.lds);
    }
}
__global__ void __launch_bounds__(NTHREADS, 2) fwd_kernel(Args args) {
    extern __shared__ __attribute__((aligned(16))) unsigned char lds_raw[];
    Frame F;
    F.lds = (LAS unsigned char*)lds_raw; F.ws = args.ws; F.in = args.in; F.out = args.out;
    F.wave = __builtin_amdgcn_readfirstlane((int)threadIdx.x >> 6); F.lane = lane_id_opaque(); F.tid = F.wave * 64 + F.lane;
    F.G = gridDim.x; F.bid = blockIdx.x; F.gw = F.bid * NWAVES + F.wave; F.NGW = F.G * NWAVES; F.zin = 0;
    volatile LAS unsigned* MISC = (volatile LAS unsigned*)(F.lds + MISC_OFF);
    for (int u = F.tid; u < (LDS_BYTES - LDSCTL_OFF) / 4; u += NTHREADS) ((LAS unsigned*)(F.lds + LDSCTL_OFF))[u] = 0u;
    __syncthreads();
    XcdBarrier bar; bar.bar = (unsigned*)(F.ws + WS_CTL) + CW_BAR; bar.x = 0; bar.st = nullptr;
    if (MK_ONE_LAUNCH) bar = xcd_barrier_post((unsigned*)(F.ws + WS_CTL) + CW_BAR, MISC + 8);
    const int lo = args.ph_lo, hi = args.ph_hi;
#define IN_PH(k) (lo <= (k) && (k) < hi)
#define FENCE() do { const int z_ = opaque_zero(); F.lane = lane_id_opaque(); F.tid = F.wave * 64 + F.lane; F.ws += z_; F.zin = z_; } while (0)
#define SEAM(k) do { if (IN_PH(k) && IN_PH((k) + 1)) xcd_barrier(bar); } while (0)

    if (IN_PH(0)) { FENCE(); pa_weights(F); FENCE(); pa_mod(F); FENCE(); pa_rope(F); FENCE(); pa_filters(F); __syncthreads(); } SEAM(0);
    if (IN_PH(1)) { FENCE(); filter_gemm(F); FENCE(); prologue_b(F); } SEAM(1);
#define LAYER_BODY(LL) { constexpr int l = LL; constexpr int base = 2 + PH_PER_LAYER * l; constexpr int mrows = (l == DEPTH - 1) ? NLAT : MROWS; \
        if (IN_PH(base + 0)) { FENCE(); \
            typedef pg8::Shape<NTOT, DM, DM, DM, 1, 0, 0> SH; \
            pg8::Gemm g{WSP(f16, WS_H), WSP(f16, WS_WTIN) + (size_t)l * NTOT * DM}; \
            pg8::StaticOrder<NTOT / 256, 1> S; if (l == DEPTH - 1) S.init(NLAT, F.G, F.bid, 48); else S.init(MROWS, F.G, F.bid); \
            EpiInProj E{WSP(f16, WS_P), WSP(f16, WS_G)}; \
            pg8::gemm_phase<SH, EpiInProj>(F.lds, g, S, E, F.wave); } \
        SEAM(base + 0); \
        if (IN_PH(base + 1)) { FENCE(); prep_naive(F, l); FENCE(); ssd::s1_phase(F, l); } \
        SEAM(base + 1); \
        if (IN_PH(base + 2)) { FENCE(); \
            { typedef pg8::Shape<1536, 512, NPAD, 512, 1, 0, 0> SH; \
              pg8::Gemm g{WSP(f16, WS_P) + C_CQ, WSP(f16, WS_WTUQ) + (size_t)l * 1536 * 512}; \
              pg8::StaticOrder<6, 1> S; S.init(mrows, F.G, F.bid); \
              EpiRowScale E{WSP(f16, WS_QM), 1536, WSP(float, WS_RS)}; \
              pg8::gemm_phase<SH, EpiRowScale>(F.lds, g, S, E, F.wave); } \
            FENCE(); \
            { typedef pg8::Shape<2048, 256, NPAD, 256, 1, 0, 0> SH; \
              pg8::Gemm g{WSP(f16, WS_P) + C_CKV, WSP(f16, WS_WTUKV) + (size_t)l * 2048 * 256}; \
              pg8::StaticOrder<8, 1> S; S.init(MROWS, F.G, (F.bid + 128) % F.G); \
              EpiRowScale E{WSP(f16, WS_KVM), 2048, WSP(float, WS_RS) + MROWS}; \
              pg8::gemm_phase<SH, EpiRowScale>(F.lds, g, S, E, F.wave); } \
            FENCE(); mix2_phase(F, l); } \
        SEAM(base + 2); \
        if (IN_PH(base + 3)) { FENCE(); mix3_phase(F, l); } \
        SEAM(base + 3); \
        if (IN_PH(base + 4)) { FENCE(); \
            typedef pg8::Shape<DM, 1024, 1024, 1024, 4, (long)MROWS * 1024, (long)DM * 1024> SH; \
            pg8::Gemm g{WSP(f16, WS_GATED), WSP(f16, WS_WTBR) + (size_t)l * 4 * DM * 1024}; \
            pg8::StaticOrder<8, 4> S; S.init(NLAT, F.G, F.bid); \
            EpiMerge E{WSP(f16, WS_G), WSP(float, WS_Y), WSP(f16, WS_MIX)}; \
            pg8::gemm_phase<SH, EpiMerge>(F.lds, g, S, E, F.wave); \
            if (l == 0) { FENCE(); pg8::TailOrder T; T.init(F.G, F.bid, 0, 128); \
                EpiMergeSlab EA{WSP(f16, WS_G), (float*)(F.ws + WS_SA)}; \
                pg8::gemm_phase<SH, EpiMergeSlab>(F.lds, g, T, EA, F.wave); \
                if (F.bid < 128) merge_tail_reduce(F, F.bid, (const float*)(F.ws + WS_SA), WSP(f16, WS_MIX), (unsigned*)(F.ws + WS_CTL) + 16384); } } \
        SEAM(base + 4); \
        if (IN_PH(base + 5)) { FENCE(); \
            typedef pg8::Shape<DM, DM, DM, DM, 1, 0, 0> SH; \
            pg8::Gemm g{WSP(f16, WS_MIX), WSP(f16, WS_WTOUT) + (size_t)l * DM * DM}; \
            pg8::StaticOrder<8, 1> S; S.init(NLAT, F.G, F.bid); \
            EpiOut E{l == 0 ? F.in[F.zin + I_X] : WSP(float, WS_X1), l == 0 ? F.in[F.zin + I_CTX] : WSP(float, WS_X1) + (size_t)NLAT * DM, WSP(float, WS_MOD) + (size_t)l * 5 * 6144, WSP(float, WS_Y)}; \
            pg8::gemm_phase<SH, EpiOut>(F.lds, g, S, E, F.wave); \
            if (l == 0) { FENCE(); typedef pg8::Shape<DM, 512, DM, DM, 4, 512, 512> SHQ; pg8::TailOrder T; T.init(F.G, F.bid, 128, 128); \
                EpiOutSlab EA{WSP(float, WS_MOD) + (size_t)l * 5 * 6144, (float*)(F.ws + WS_SA) + (size_t)4 * NCTX * DM}; \
                pg8::gemm_phase<SHQ, EpiOutSlab>(F.lds, g, T, EA, F.wave); } } \
        SEAM(base + 5); \
        if (IN_PH(base + 6)) { FENCE(); ln_phase(F, l); } \
        SEAM(base + 6); }
    LAYER_BODY(0)
    LAYER_BODY(1)
#undef LAYER_BODY
#undef IN_PH
#undef SEAM
}

extern "C" void kernel_launch(void* const* d_in, const int* in_sizes, int n_in, void* d_out, int out_size, void* d_ws, size_t ws_size, hipStream_t stream) {
    static int grid = 0;
    if (grid == 0) {
        if (n_in != N_IN || out_size != NLAT * DM || ws_size < WS_END) { fprintf(stderr, "kernel_launch: unexpected shapes: n_in %d out %d ws %zu (need %zu)\n", n_in, out_size, ws_size, (size_t)WS_END); grid = -1; return; }
        int dev = 0, cus = 0, per_cu = 0;
        if (hipGetDevice(&dev) != hipSuccess || hipDeviceGetAttribute(&cus, hipDeviceAttributeMultiprocessorCount, dev) != hipSuccess) { grid = -1; return; }
        if (hipFuncSetAttribute((const void*)fwd_kernel, hipFuncAttributeMaxDynamicSharedMemorySize, LDS_BYTES) != hipSuccess) { fprintf(stderr, "kernel_launch: hipFuncSetAttribute failed\n"); grid = -1; return; }
        if (hipOccupancyMaxActiveBlocksPerMultiprocessor(&per_cu, (const void*)fwd_kernel, NTHREADS, LDS_BYTES) != hipSuccess || per_cu < 1) { fprintf(stderr, "kernel_launch: occupancy query says %d blocks per CU\n", per_cu); (void)hipGetLastError(); grid = -1; return; }
        grid = cus;
    }
    if (grid < 0) return;
    (void)hipMemsetAsync((char*)d_ws + WS_CTL, 0, CTL_BYTES, stream);
    Args a{};
    for (int i = 0; i < N_IN; ++i) a.in[i] = (const float*)d_in[i];
    a.out = (float*)d_out; a.ws = (unsigned char*)d_ws;
#if MK_ONE_LAUNCH
    a.ph_lo = 0; a.ph_hi = N_PHASES;
    hipLaunchKernelGGL(fwd_kernel, dim3(grid), dim3(NTHREADS), LDS_BYTES, stream, a);
#else
    for (int ph = 0; ph < N_PHASES; ++ph) { a.ph_lo = ph; a.ph_hi = ph + 1; hipLaunchKernelGGL(fwd_kernel, dim3(grid), dim3(NTHREADS), LDS_BYTES, stream, a); }
#endif
}
```

```cpp
#ifndef USE_MFMA_GQA
#define USE_MFMA_GQA 1
#endif
#ifndef USE_MFMA_MLA
#define USE_MFMA_MLA 1
#endif
#ifndef USE_MFMA_HY
#define USE_MFMA_HY 1
#endif
#ifndef USE_MFMA_SSD
#define USE_MFMA_SSD 1
#endif
#ifndef IN_BF16
#define IN_BF16 1
#endif
#include <hip/hip_runtime.h>
#include <cstdio>
#include <cstdint>
#include <cmath>

constexpr int DM = 2048, NB = 4, SEQ = 2048, CTXL = 256, DEPTH = 2;
constexpr int NLAT = NB * SEQ;
constexpr int NCTX = NB * CTXL;
constexpr int MROWS = NLAT + NCTX;
constexpr int INW = 19040;
constexpr int NPAD = 11008;
constexpr int NGATE = 8192;
constexpr int NTOT = NPAD + NGATE;
constexpr int NPT = NPAD / 256;
constexpr int C_SZ = 0, C_XBC = 1024, C_DT = 2560, C_CQ = 2592, C_CKV = 3104, C_KPE = 3360, C_MZ = 3424, C_GQ = 4448,
              C_GK = 5472, C_GV = 5600, C_GZ = 5728, C_HXV = 6752, C_HZ = 9824, C_MERGE = 10848;
constexpr float LN_EPS = 1e-6f;
constexpr float DN_ALPHA = 1.4142135623730951f;

enum { I_X = 0, I_C, I_CTX, I_CCTX, I_WADA, I_BADA, I_WIN, I_SCW, I_SCB, I_SDTB, I_SALOG, I_SD, I_SNW, I_MQN, I_MWUQ, I_MKVN, I_MWUKV,
       I_GSINK, I_HCW, I_HCB, I_HW1, I_HB1, I_HW2, I_HB2, I_HW3, I_HFREQ, I_HD, I_WBR, I_WOUT, I_LNG, I_LNB, N_IN };

constexpr size_t al256(size_t x) { return (x + 255) & ~(size_t)255; }
constexpr size_t WS_CTL = 0, CTL_BYTES = 1u << 20;
constexpr size_t WS_WTIN = CTL_BYTES;
constexpr size_t WS_WTUQ = WS_WTIN + (size_t)2 * NTOT * DM * 2;
constexpr size_t WS_WTUKV = WS_WTUQ + (size_t)2 * 1536 * 512 * 2;
constexpr size_t WS_WTBR = WS_WTUKV + (size_t)2 * 2048 * 256 * 2;
constexpr size_t WS_WTOUT = WS_WTBR + (size_t)2 * 4 * 2048 * 1024 * 2;
constexpr size_t WS_MOD = WS_WTOUT + (size_t)2 * 2048 * 2048 * 2;
constexpr size_t WS_ROPE = al256(WS_MOD + (size_t)2 * 5 * 6144 * 4);
constexpr size_t WS_HF = al256(WS_ROPE + (size_t)2 * 2048 * 32 * 4);
constexpr size_t HF_LAT = (size_t)4096 * 1024 * 2, HF_CTX = (size_t)512 * 1024 * 2, HF_LAYER = HF_LAT + HF_CTX;
constexpr size_t WS_HD2 = al256(WS_HF + 2 * HF_LAYER);
constexpr size_t WS_H = al256(WS_HD2 + (size_t)2 * 2304 * 64 * 2);
constexpr size_t WS_P = WS_H + (size_t)MROWS * DM * 2;
constexpr size_t WS_G = WS_P + (size_t)MROWS * NPAD * 2;
constexpr size_t WS_RS = WS_G + (size_t)MROWS * NGATE * 2;
constexpr size_t WS_DEC = WS_RS + (size_t)2 * MROWS * 4;
constexpr size_t WS_QM = al256(WS_DEC + (size_t)4 * 18 * 16 * 2 * 4);
constexpr size_t WS_KVM = WS_QM + (size_t)MROWS * 1536 * 2;
constexpr size_t WS_GATED = WS_KVM + (size_t)MROWS * 2048 * 2;
constexpr size_t WS_MIX = WS_GATED + (size_t)4 * MROWS * 1024 * 2;
constexpr size_t WS_Y = WS_MIX + (size_t)MROWS * DM * 2;
constexpr size_t WS_X1 = WS_Y + (size_t)MROWS * DM * 4;
constexpr size_t WS_SA = WS_X1 + (size_t)MROWS * DM * 4;
constexpr size_t SA_BYTES = (size_t)MROWS * 2048 * 4;
constexpr size_t WS_SC = WS_SA + SA_BYTES;
constexpr size_t SC_BYTES = (size_t)MROWS * 1024 * 4;
constexpr int PC_SPLIT = 2592, PC_CHUNKS = PC_SPLIT / 8 + 4096 / 8;
constexpr size_t WS_PC = WS_SC + SC_BYTES;
constexpr size_t WS_SB = WS_PC;
constexpr size_t WS_H8 = WS_PC + (size_t)PC_CHUNKS * MROWS * 16;
constexpr size_t WS_HS = WS_H8 + (size_t)MROWS * DM;
constexpr size_t WS_CS = al256(WS_HS + (size_t)MROWS * 4);
constexpr size_t WS_END = al256(WS_CS + (size_t)2 * NGATE * 4);
constexpr size_t CTL_CMAX = 512 * 1024;
__host__ __device__ constexpr size_t ws_w8(int l) { return WS_WTIN + ((size_t)l * NTOT + NPAD) * DM * 2; }
__host__ __device__ constexpr int pc_chunk(int col) { return col < PC_SPLIT ? (col >> 3) : PC_SPLIT / 8 + ((col - C_HXV) >> 3); }

#define GAS __attribute__((address_space(1)))
#define LAS __attribute__((address_space(3)))
typedef _Float16 f16;
typedef _Float16 f16x2 __attribute__((ext_vector_type(2)));
typedef _Float16 f16x4 __attribute__((ext_vector_type(4)));
typedef _Float16 f16x8 __attribute__((ext_vector_type(8)));
typedef float f32x2 __attribute__((ext_vector_type(2)));
typedef float f32x4 __attribute__((ext_vector_type(4)));
typedef float f32x16 __attribute__((ext_vector_type(16)));
typedef unsigned u32x2 __attribute__((ext_vector_type(2)));
typedef unsigned u32x4 __attribute__((ext_vector_type(4)));
typedef GAS unsigned gu32;
#define RLX_AGENT __ATOMIC_RELAXED, __HIP_MEMORY_SCOPE_AGENT
#define LDS_WAIT() asm volatile("s_waitcnt lgkmcnt(0)" ::: "memory")
#define VM_WAIT() asm volatile("s_waitcnt vmcnt(0)" ::: "memory")

typedef __bf16 bf16x2_t __attribute__((ext_vector_type(2)));
typedef __bf16 bf16x8_t __attribute__((ext_vector_type(8)));
__device__ __forceinline__ unsigned pkb(float lo, float hi) { f32x2 v = {lo, hi}; bf16x2_t b = __builtin_convertvector(v, bf16x2_t); return __builtin_bit_cast(unsigned, b); }
__device__ __forceinline__ u32x4 pkb8(f32x4 a, f32x4 b) { u32x4 w; w.x = pkb(a[0], a[1]); w.y = pkb(a[2], a[3]); w.z = pkb(b[0], b[1]); w.w = pkb(b[2], b[3]); return w; }
__device__ __forceinline__ float bf_lo(unsigned w) { return __builtin_bit_cast(float, w << 16); }
__device__ __forceinline__ float bf_hi(unsigned w) { return __builtin_bit_cast(float, w & 0xffff0000u); }
__device__ __forceinline__ unsigned pkh(float lo, float hi) { f16x2 v = {(f16)lo, (f16)hi}; return __builtin_bit_cast(unsigned, v); }
__device__ __forceinline__ u32x4 pkh8(f32x4 a, f32x4 b) { u32x4 w; w.x = pkh(a[0], a[1]); w.y = pkh(a[2], a[3]); w.z = pkh(b[0], b[1]); w.w = pkh(b[2], b[3]); return w; }
__device__ __forceinline__ float fast_exp(float x) { return __builtin_amdgcn_exp2f(x * 1.4426950408889634f); }
__device__ __forceinline__ float sigmoidf_(float x) { return __builtin_amdgcn_rcpf(1.0f + fast_exp(-x)); }
__device__ __forceinline__ float siluf_(float x) { return x * sigmoidf_(x); }
__device__ __forceinline__ float softplusf_(float x) { return x > 20.f ? x : log1pf(expf(x)); }
__device__ __forceinline__ int lane_id_opaque() { int l; asm volatile("v_mbcnt_lo_u32_b32 %0, -1, 0\n\tv_mbcnt_hi_u32_b32 %0, -1, %0" : "=v"(l)); return l; }
#define WAVE_RED_(OP) \
    { int t; \
      t = __builtin_amdgcn_update_dpp(0, __builtin_bit_cast(int, v), 0xB1, 0xF, 0xF, true);  v = OP(v, __builtin_bit_cast(float, t)); \
      t = __builtin_amdgcn_update_dpp(0, __builtin_bit_cast(int, v), 0x4E, 0xF, 0xF, true);  v = OP(v, __builtin_bit_cast(float, t)); \
      t = __builtin_amdgcn_update_dpp(0, __builtin_bit_cast(int, v), 0x141, 0xF, 0xF, true); v = OP(v, __builtin_bit_cast(float, t)); \
      t = __builtin_amdgcn_update_dpp(0, __builtin_bit_cast(int, v), 0x140, 0xF, 0xF, true); v = OP(v, __builtin_bit_cast(float, t)); \
      { const unsigned u = __builtin_bit_cast(unsigned, v); auto p = __builtin_amdgcn_permlane16_swap(u, u, false, false); v = OP(__builtin_bit_cast(float, (unsigned)p[0]), __builtin_bit_cast(float, (unsigned)p[1])); } \
      { const unsigned u = __builtin_bit_cast(unsigned, v); auto p = __builtin_amdgcn_permlane32_swap(u, u, false, false); v = OP(__builtin_bit_cast(float, (unsigned)p[0]), __builtin_bit_cast(float, (unsigned)p[1])); } }
__device__ __forceinline__ float wr_add_(float a, float b) { return a + b; }
__device__ __forceinline__ float wave_sum(float v) { WAVE_RED_(wr_add_) return v; }
__device__ __forceinline__ float wave_max(float v) { WAVE_RED_(fmaxf) return v; }
#undef WAVE_RED_

#ifdef TPROBE
#define TP_BEGIN(U) unsigned tsum_ = 0; unsigned long long tlast_ = __builtin_amdgcn_s_memrealtime(); const unsigned long long tstart_ = tlast_; constexpr bool tpon_ = ((U) == TPUNIT)
#define TP(k) do { if (tpon_) { const unsigned long long n_ = __builtin_amdgcn_s_memrealtime(); if ((k) == TPROBE) tsum_ += (unsigned)(n_ - tlast_); tlast_ = n_; } } while (0)
#define TP_END() do { if (tpon_) { TP(99); if (TPROBE == 0) tsum_ = (unsigned)(tlast_ - tstart_); if (F.tid == 0) { unsigned* tm_ = (unsigned*)(F.ws + WS_CTL) + 32768; atomicAdd(tm_, tsum_); atomicAdd(tm_ + 15, 1u); } } } while (0)
#else
#define TP_BEGIN(U) do {} while (0)
#define TP(k) do {} while (0)
#define TP_END() do {} while (0)
#endif
namespace pg8 {
constexpr int BM = 256, BK = 64, HALF = 128, HTB = HALF * BK * 2, STAGE_BYTES = 8 * HTB, NXCD = 8, WGM = 8;
__host__ __device__ __forceinline__ int lds_byte(int r, int c) { const int st = (r >> 4) * 2 + (c >> 5), rr = r & 15, cc = c & 31, ob = rr * 64 + cc * 2; return st * 1024 + (ob ^ (((ob >> 9) & 1) << 5)); }
__host__ __device__ __forceinline__ void stage_rc(int b, int& R, int& C) { const int st = b / 1024, sb = b % 1024, swz = sb ^ (((sb >> 9) & 1) << 5); R = (st >> 1) * 16 + swz / 64; C = (st & 1) * 32 + (swz % 64) / 2; }
__host__ __device__ __forceinline__ int perm32(int rho) { const int n = rho >> 4, i = rho & 15; return 8 * (i >> 2) + 4 * n + (i & 3); }

struct Unit { int pm, pn, kz; };
constexpr int NGATE_TILES = 32;
struct Gemm { const f16* A; const f16* Bt; };
template <int N_, int K_, int LDA_, int LDB_, int NZ_, long AZS_, long BZS_, int DT_ = 0> struct Shape { static constexpr int N = N_, K = K_, LDA = LDA_, LDB = LDB_, NZ = NZ_; static constexpr long AZS = AZS_, BZS = BZS_; static constexpr int DT = DT_; };
typedef int i32x4 __attribute__((ext_vector_type(4)));

template <int NN, int NZ> struct StaticOrder {
    int nM, nwg, G, c, ntail;
    __device__ __forceinline__ void init(int M, int G_, int c_, int ntail_ = 0) { nM = M / BM; nwg = nM * NN; G = G_; c = c_; ntail = ntail_; }
    __device__ __forceinline__ bool next(int i, Unit& u) const {
        const int j = i / NZ; u.kz = i - j * NZ;
        const int L = j * G + c; if (L >= nwg) { const int q = L - nwg; if (q >= ntail) return false; const int t = q % 12; u.pm = nM + q / 12; u.pn = t < 10 ? 4 + t : 11 + t; return true; }
        map(L, u); return true;
    }
    __device__ __forceinline__ void map(int L, Unit& u) const {
        int wgid = L; { const int q = nwg / NXCD, r = nwg % NXCD, xcd = wgid % NXCD, off = wgid / NXCD; wgid = (xcd < r ? xcd * (q + 1) : r * (q + 1) + (xcd - r) * q) + off; }
        constexpr int nig = WGM * NN; const int gid = wgid / nig, fm = gid * WGM, gsz = (nM - fm) < WGM ? (nM - fm) : WGM;
        u.pm = fm + ((wgid % nig) % gsz); u.pn = (wgid % nig) / gsz;
    }
};
struct GateOrderL0 {
    StaticOrder<NGATE_TILES, 1> S; int c;
    __device__ __forceinline__ void init(int M, int G_, int c_) { S.init(M, G_, c_); c = c_; }
    __device__ __forceinline__ bool next(int i, Unit& u) const {
        u.kz = 0; int L;
        if (S.G == 256 && S.nwg == 1024) {
            if (i < 2) L = i * 256 + c;
            else if (i == 2) { if (c < 32) return false; L = 512 + (c - 32); }
            else if (i == 3 || i == 4) { if (c < 112) return false; L = (i == 3 ? 736 : 880) + (c - 112); }
            else return false;
            S.map(L, u); return true; }
        if (S.G != 256 || S.nwg != 1152) return S.next(i, u);
        if (i < 3) L = i * 256 + c;
        else { if (c >= 128 && c < 144) return false; const int idx = c < 128 ? c : c - 16; if (i == 3) L = 768 + idx; else if (i == 4 && idx < 144) L = 1008 + idx; else return false; }
        S.map(L, u); return true;
    }
};
struct POrderL1 {
    StaticOrder<NPAD / 256, 1> S; int c;
    __device__ __forceinline__ void init(int M, int G_, int c_) { S.init(M, G_, c_, 48); c = c_; }
    __device__ __forceinline__ bool next(int i, Unit& u) const {
        if (S.G != 256) return S.next(i, u);
        u.kz = 0; int L;
        if (i < 5) L = i * 256 + c;
        else if (i == 5) { if (c >= 112) return false; L = 1280 + c; }
        else if (i == 6) { if (c >= 32) return false; L = 1392 + c; }
        else return false;
        if (L >= S.nwg) { const int q = L - S.nwg; if (q >= S.ntail) return false; const int t = q % 12; u.pm = S.nM + q / 12; u.pn = t < 10 ? 4 + t : 11 + t; return true; }
        S.map(L, u); return true;
    }
};

struct TailOrder {
    int G, c, nq;
    __device__ __forceinline__ void init(int G_, int c_, int shift, int nq_) { G = G_; c = (c_ + G_ - shift % G_) % G_; nq = nq_; }
    __device__ __forceinline__ bool next(int i, Unit& u) const { const int q = i * G + c; if (q >= nq) return false; const int t = q >> 2; u.kz = q & 3; u.pm = 32 + (t >> 3); u.pn = t & 7; return true; }
};
template <class SH, class Epi, class Sched>
__device__ __forceinline__ void gemm_phase(LAS unsigned char* lds, const Gemm g, const Sched& S, const Epi& E, const int wid) {
    const int lane = lane_id_opaque(), tid = wid * 64 + lane,
               wr = wid >> 2, wc = wid & 3, fr = lane & 15, fq = lane >> 4;
    constexpr int K = SH::K, nt = K / BK;
    unsigned voffA[2], voffB[2];
#pragma unroll
    for (int i = 0; i < 2; ++i) { int R, C; stage_rc(tid * 16 + i * 8192, R, C); const int Rb = Epi::PERM ? ((R & ~31) + perm32(R & 31)) : R;
        voffA[i] = (unsigned)(R * SH::LDA + C) * 2u; voffB[i] = (unsigned)(Rb * SH::LDB + C) * 2u; }
    constexpr size_t kstep = (size_t)(BK * 2);
    constexpr size_t hstepA = (size_t)HALF * SH::LDA * 2, hstepB = (size_t)HALF * SH::LDB * 2;
    constexpr size_t tstepA = 2 * hstepA, tstepB = 2 * hstepB;
    const unsigned ldsw = (unsigned)wid * 1024u;
    const int aoff = lds_byte(wr * 64 + fr, fq * 8), boff = lds_byte(wc * 32 + fr, fq * 8);
#define PG8_SA(b, h) (((b) * 2 + (h)) * HTB)
#define PG8_SB(b, h) ((4 + (b) * 2 + (h)) * HTB)
#define PG8_STAGE(bufoff, gbase, voff) do { _Pragma("unroll") for (int _i = 0; _i < 2; ++_i) \
        __builtin_amdgcn_global_load_lds((const unsigned*)((const char*)(gbase) + (voff)[_i]), (LAS unsigned*)(lds + (bufoff) + ldsw + _i * 8192), 16, 0, 0); } while (0)
#define PG8_LDA(dst, b, h) do { _Pragma("unroll") for (int m = 0; m < 4; ++m) _Pragma("unroll") for (int k = 0; k < 2; ++k) dst[m][k] = *(const LAS f16x8*)(lds + PG8_SA(b, h) + aoff + m * 2048 + k * 1024); } while (0)
#define PG8_LDB(dst, b, h) do { _Pragma("unroll") for (int n = 0; n < 2; ++n) _Pragma("unroll") for (int k = 0; k < 2; ++k) dst[n][k] = *(const LAS f16x8*)(lds + PG8_SB(b, h) + boff + n * 2048 + k * 1024); } while (0)
#define PG8_MMA(ai, bj, At, Bt) do { __builtin_amdgcn_s_setprio(1); _Pragma("unroll") for (int m = 0; m < 4; ++m) _Pragma("unroll") for (int n = 0; n < 2; ++n) _Pragma("unroll") for (int k = 0; k < 2; ++k) \
        { if constexpr (SH::DT == 2) acc[ai][bj][m][n] = __builtin_bit_cast(f32x4, __builtin_amdgcn_mfma_i32_16x16x64_i8(__builtin_bit_cast(i32x4, Bt[n][k]), __builtin_bit_cast(i32x4, At[m][k]), __builtin_bit_cast(i32x4, acc[ai][bj][m][n]), 0, 0, 0)); \
          else if constexpr (SH::DT == 1) acc[ai][bj][m][n] = __builtin_amdgcn_mfma_f32_16x16x32_bf16(__builtin_bit_cast(bf16x8_t, Bt[n][k]), __builtin_bit_cast(bf16x8_t, At[m][k]), acc[ai][bj][m][n], 0, 0, 0); \
          else acc[ai][bj][m][n] = __builtin_amdgcn_mfma_f32_16x16x32_f16(Bt[n][k], At[m][k], acc[ai][bj][m][n], 0, 0, 0); } __builtin_amdgcn_s_setprio(0); } while (0)
#define PG8_WAIT_V(n) asm volatile("s_waitcnt vmcnt(" #n ")" ::: "memory")
#define PG8_WAIT_L(n) asm volatile("s_waitcnt lgkmcnt(" #n ")" ::: "memory")
#define PG8_BAR __builtin_amdgcn_s_barrier()
#define PG8_SCHED __builtin_amdgcn_sched_barrier(0)
    Unit cur, nxt; int ui = 0;
    if (!S.next(0, cur)) return;
    f32x4 acc[2][2][4][2];
#pragma unroll
    for (int a = 0; a < 2; ++a)
#pragma unroll
        for (int b = 0; b < 2; ++b)
#pragma unroll
            for (int m = 0; m < 4; ++m)
#pragma unroll
                for (int n = 0; n < 2; ++n) acc[a][b][m][n] = (f32x4){0.f, 0.f, 0.f, 0.f};
    f16x8 At[4][2], B0[2][2], B1[2][2];
    const char* cA = (const char*)(g.A + (size_t)cur.kz * SH::AZS) + (size_t)cur.pm * tstepA;
    const char* cB = (const char*)(g.Bt + (size_t)cur.kz * SH::BZS) + (size_t)cur.pn * tstepB;
    PG8_STAGE(PG8_SB(0, 0), cB, voffB); PG8_STAGE(PG8_SB(0, 1), cB + hstepB, voffB); PG8_STAGE(PG8_SA(0, 0), cA, voffA); PG8_STAGE(PG8_SA(0, 1), cA + hstepA, voffA);
    if (wr == 1) PG8_BAR;
    PG8_WAIT_V(2); PG8_BAR;
    PG8_STAGE(PG8_SB(1, 0), cB + kstep, voffB); PG8_STAGE(PG8_SA(1, 0), cA + kstep, voffA); PG8_STAGE(PG8_SB(1, 1), cB + hstepB + kstep, voffB);
    PG8_WAIT_V(6); PG8_BAR;
    for (;;) {
        const bool has_next = S.next(ui + 1, nxt);
        const char* nA = has_next ? (const char*)(g.A + (size_t)nxt.kz * SH::AZS) + (size_t)nxt.pm * tstepA : cA;
        const char* nB = has_next ? (const char*)(g.Bt + (size_t)nxt.kz * SH::BZS) + (size_t)nxt.pn * tstepB : cB;
        for (int t = 0; t < nt; t += 2) {
            const bool last = (t == nt - 2);
            const char* a1 = cA + (size_t)(t + 1) * kstep;
            const char* a2 = last ? nA : cA + (size_t)(t + 2) * kstep; const char* b2 = last ? nB : cB + (size_t)(t + 2) * kstep;
            const char* a3 = a2 + kstep; const char* b3 = b2 + kstep;
            PG8_LDB(B0, 0, 0); PG8_LDB(B1, 0, 1); PG8_SCHED; PG8_LDA(At, 0, 0); PG8_STAGE(PG8_SA(1, 1), a1 + hstepA, voffA);
            PG8_WAIT_V(8); PG8_WAIT_L(0); PG8_BAR; PG8_MMA(0, 0, At, B0); PG8_MMA(0, 1, At, B1); PG8_BAR; PG8_SCHED;
            PG8_LDA(At, 0, 1); PG8_STAGE(PG8_SB(0, 0), b2, voffB); PG8_STAGE(PG8_SB(0, 1), b2 + hstepB, voffB); PG8_STAGE(PG8_SA(0, 0), a2, voffA);
            PG8_WAIT_V(8); PG8_WAIT_L(0); PG8_BAR; PG8_MMA(1, 0, At, B0); PG8_MMA(1, 1, At, B1); PG8_BAR; PG8_SCHED;
            PG8_LDB(B0, 1, 0); PG8_LDB(B1, 1, 1); PG8_SCHED; PG8_LDA(At, 1, 0); PG8_STAGE(PG8_SA(0, 1), a2 + hstepA, voffA);
            PG8_WAIT_V(8); PG8_WAIT_L(0); PG8_BAR; PG8_MMA(0, 0, At, B0); PG8_MMA(0, 1, At, B1); PG8_BAR; PG8_SCHED;
            PG8_LDA(At, 1, 1); PG8_STAGE(PG8_SB(1, 0), b3, voffB); PG8_STAGE(PG8_SB(1, 1), b3 + hstepB, voffB); PG8_STAGE(PG8_SA(1, 0), a3, voffA);
            PG8_WAIT_V(8); PG8_WAIT_L(0); PG8_BAR; PG8_MMA(1, 0, At, B0); PG8_MMA(1, 1, At, B1); PG8_BAR; PG8_SCHED;
        }
        if (wr == 0) PG8_BAR;
        E(acc, cur, wr, wc, fr, fq);
        if (!has_next) break;
        if (!Epi::KEEP || nxt.kz == 0)
#pragma unroll
        for (int a = 0; a < 2; ++a)
#pragma unroll
            for (int b = 0; b < 2; ++b)
#pragma unroll
                for (int m = 0; m < 4; ++m)
#pragma unroll
                    for (int n = 0; n < 2; ++n) acc[a][b][m][n] = (f32x4){0.f, 0.f, 0.f, 0.f};
        cur = nxt; cA = nA; cB = nB; ++ui;
        if (wr == 1) PG8_BAR;
    }
    PG8_WAIT_V(0);
    PG8_BAR;
#undef PG8_SA
#undef PG8_SB
#undef PG8_STAGE
#undef PG8_LDA
#undef PG8_LDB
#undef PG8_MMA
#undef PG8_WAIT_V
#undef PG8_WAIT_L
#undef PG8_BAR
#undef PG8_SCHED
}
}

constexpr int RING_BYTES = 131072;
constexpr int LDSCTL_OFF = RING_BYTES, MISC_OFF = LDSCTL_OFF + 320;
constexpr int LDS_BYTES = 147456;
constexpr int NWAVES = 8, NTHREADS = 512;

#define XB_TMO      128
#define XB_XCNT(j)  (256  + 64 * (j))
#define XB_XSUB(j)  (1280 + 64 * (j))
#define XB_XGEN(j)  (2304 + 64 * (j))
#define XB_TOP      3328
#define XB_TOPGEN   3392
#define XCD_BAR_WORDS 3456
#define XB_SPIN_CAP (1u << 24)
__device__ __forceinline__ unsigned xb_ld(unsigned* p)              { return __hip_atomic_load(p, __ATOMIC_RELAXED, __HIP_MEMORY_SCOPE_AGENT); }
__device__ __forceinline__ unsigned xb_add(unsigned* p, unsigned v) { return __hip_atomic_fetch_add(p, v, __ATOMIC_RELAXED, __HIP_MEMORY_SCOPE_AGENT); }
__device__ __forceinline__ unsigned xb_xcc_id() { return (unsigned)__builtin_amdgcn_s_getreg((3 << 11) | 20) & 0xFu; }
#define XB_SPIN(cond, bar) do { unsigned _sp = 0; while (cond) { __builtin_amdgcn_s_sleep(1); \
    if ((++_sp & 255u) == 0u) { if (xb_ld(&(bar)[XB_TMO])) break; if (_sp > XB_SPIN_CAP) { atomicAdd(&(bar)[XB_TMO], 1u); break; } } } } while (0)
struct XcdBarrier { unsigned* bar; unsigned x; volatile LAS unsigned* st; };
__device__ __forceinline__ XcdBarrier xcd_barrier_post(unsigned* bar, volatile LAS unsigned* st) {
    XcdBarrier b; b.bar = bar; b.x = xb_xcc_id(); b.st = st;
    if (threadIdx.x == 0) (void)xb_add(&bar[XB_XCNT(b.x)], 1u);
    return b;
}
__device__ __forceinline__ void xcd_barrier_complete(unsigned* bar, unsigned x, unsigned& nloc, unsigned& nx) {
    const unsigned G = gridDim.x * gridDim.y * gridDim.z;
    unsigned sum, cnt, mine, sp = 0u;
    for (;;) {
        sum = 0u; cnt = 0u; mine = 0u;
#pragma unroll
        for (unsigned j = 0; j < 16; ++j) { const unsigned c = xb_ld(&bar[XB_XCNT(j)]); sum += c; cnt += (c > 0u) ? 1u : 0u; mine = (j == x) ? c : mine; }
        if (sum == G) break;
        __builtin_amdgcn_s_sleep(1);
        if ((++sp & 255u) == 0u) { if (xb_ld(&bar[XB_TMO])) break; if (sp > XB_SPIN_CAP) { atomicAdd(&bar[XB_TMO], 1u); break; } }
    }
    nloc = mine > 0u ? mine : 1u; nx = cnt > 0u ? cnt : 1u;
}
__device__ __forceinline__ void xcd_barrier(const XcdBarrier& b) {
    asm volatile("s_waitcnt vmcnt(0)" ::: "memory");
    __syncthreads();
    if (threadIdx.x == 0) {
        unsigned* bar = b.bar;
        __builtin_amdgcn_s_waitcnt(0);
        unsigned nloc = b.st[0], nx = b.st[1];
        if (nloc == 0u) { xcd_barrier_complete(bar, b.x, nloc, nx); b.st[0] = nloc; b.st[1] = nx; }
        const unsigned old = xb_add(&bar[XB_XSUB(b.x)], 1u);
        const unsigned gen = old / nloc;
        if (old + 1u == (gen + 1u) * nloc) {
            __builtin_amdgcn_fence(__ATOMIC_RELEASE, "agent");
            asm volatile("s_waitcnt vmcnt(0)" ::: "memory");
            const unsigned og = xb_add(&bar[XB_TOP], 1u);
            const unsigned tg = og / nx;
            if (og + 1u == (tg + 1u) * nx) xb_add(&bar[XB_TOPGEN], 1u);
            else XB_SPIN(xb_ld(&bar[XB_TOPGEN]) == tg, bar);
            __builtin_amdgcn_fence(__ATOMIC_ACQUIRE, "agent");
            xb_add(&bar[XB_XGEN(b.x)], 1u);
            asm volatile("s_waitcnt vmcnt(0)" ::: "memory");
        } else {
            XB_SPIN(xb_ld(&bar[XB_XGEN(b.x)]) == gen, bar);
            __builtin_amdgcn_fence(__ATOMIC_ACQUIRE, "agent");
            asm volatile("s_waitcnt vmcnt(0)" ::: "memory");
        }
    }
    __syncthreads();
}

struct Args { const float* in[N_IN]; float* out; unsigned char* ws; int ph_lo, ph_hi; };
struct Frame {
    LAS unsigned char* lds;
    unsigned char* ws;
    const float* const* in;
    float* out;
    int tid, lane, wave, G, gw, NGW, bid, zin;
};
#define WSP(T, off) ((T*)(F.ws + (off)))
#define INP(i, l, per) (F.in[(i) + F.zin] + (size_t)(l) * (per))

struct TTile { const float* W; f16* WT; const float* kscale; int K, N, k0, n0, dfrom, dshift, bf, bf8l; };
__device__ __forceinline__ bool ttile_get(Frame& F, int it, TTile& t) {
    constexpr int T_IN = 32 * 75, T_BR = 16 * 8, T_OUT = 32 * 8, T_UQ = 8 * 6, T_UKV = 4 * 8;
    constexpr int T_LAYER = T_IN + 4 * T_BR + T_OUT + T_UQ + T_UKV;
    if (it >= 2 * T_LAYER) return false;
    const int l = it / T_LAYER; int r = it % T_LAYER;
    t.dfrom = 1 << 30; t.dshift = 0; t.kscale = nullptr; t.bf = 0; t.bf8l = l;
    if (r < T_IN) { t.W = INP(I_WIN, l, (size_t)DM * INW); t.K = DM; t.N = INW; t.WT = WSP(f16, WS_WTIN) + (size_t)l * NTOT * DM; t.k0 = (r % 32) * 64; t.n0 = (r / 32) * 256; t.dfrom = C_MERGE; t.dshift = NPAD - C_MERGE; t.bf = IN_BF16; return true; }
    r -= T_IN;
    if (r < 4 * T_BR) { const int kz = r / T_BR, q = r % T_BR; t.W = INP(I_WBR, l, (size_t)4 * 1024 * DM) + (size_t)kz * 1024 * DM; t.K = 1024; t.N = DM; t.WT = WSP(f16, WS_WTBR) + ((size_t)l * 4 + kz) * DM * 1024;
        t.k0 = (q % 16) * 64; t.n0 = (q / 16) * 256; t.kscale = kz == 0 ? INP(I_SNW, l, 1024) : nullptr; t.bf = 1; return true; }
    r -= 4 * T_BR;
    if (r < T_OUT) { t.W = INP(I_WOUT, l, (size_t)DM * DM); t.K = DM; t.N = DM; t.WT = WSP(f16, WS_WTOUT) + (size_t)l * DM * DM; t.k0 = (r % 32) * 64; t.n0 = (r / 32) * 256; t.bf = 1; return true; }
    r -= T_OUT;
    if (r < T_UQ) { t.W = INP(I_MWUQ, l, (size_t)512 * 1536); t.K = 512; t.N = 1536; t.WT = WSP(f16, WS_WTUQ) + (size_t)l * 1536 * 512; t.k0 = (r % 8) * 64; t.n0 = (r / 8) * 256; t.kscale = INP(I_MQN, l, 512); return true; }
    r -= T_UQ;
    t.W = INP(I_MWUKV, l, (size_t)256 * 2048); t.K = 256; t.N = 2048; t.WT = WSP(f16, WS_WTUKV) + (size_t)l * 2048 * 256; t.k0 = (r % 4) * 64; t.n0 = (r / 4) * 256; t.kscale = INP(I_MKVN, l, 256); return true;
}
__device__ __forceinline__ void ttile_load(Frame& F, const TTile& t, float (&v)[4][4][2]) {
#pragma unroll
    for (int rp = 0; rp < 4; ++rp) { const int k = t.k0 + 2 * (F.wave * 4 + rp);
#pragma unroll
        for (int cc = 0; cc < 4; ++cc) { const int n = t.n0 + cc * 64 + F.lane;
            v[rp][cc][0] = n < t.N ? __builtin_nontemporal_load(t.W + (size_t)k * t.N + n) : 0.f; v[rp][cc][1] = n < t.N ? __builtin_nontemporal_load(t.W + (size_t)(k + 1) * t.N + n) : 0.f; } }
}
__device__ __forceinline__ void pa_weights(Frame& F) {
    TTile ta, tb, done; float va[4][4][2], vb[4][4][2];
    int it = F.bid; bool have_a = ttile_get(F, it, ta);
    if (have_a) ttile_load(F, ta, va);
    it += F.G; bool have_b = ttile_get(F, it, tb);
    if (have_b) ttile_load(F, tb, vb);
#define PA_STEP(cur, v, have, IMGOFF) do { LAS unsigned* img = (LAS unsigned*)(F.lds + (IMGOFF)); \
        if (cur.dfrom < (1 << 30) && cur.n0 + 256 > cur.dfrom) {        \
            _Pragma("unroll") for (int cc = 0; cc < 4; ++cc) { const int n = cur.n0 + cc * 64 + F.lane; float mx = 0.f; \
                _Pragma("unroll") for (int rp = 0; rp < 4; ++rp) mx = fmaxf(mx, fmaxf(fabsf(v[rp][cc][0]), fabsf(v[rp][cc][1]))); \
                if (n >= cur.dfrom && n < cur.N) atomicMax((unsigned*)(F.ws + WS_CTL + CTL_CMAX) + (size_t)cur.bf8l * NGATE + (n - cur.dfrom), __float_as_uint(mx)); } } \
        _Pragma("unroll") for (int rp = 0; rp < 4; ++rp) { const int k = cur.k0 + 2 * (F.wave * 4 + rp); \
            const float s0 = cur.kscale ? cur.kscale[k] : 1.f, s1 = cur.kscale ? cur.kscale[k + 1] : 1.f; \
            _Pragma("unroll") for (int cc = 0; cc < 4; ++cc) img[(cc * 64 + F.lane) * 33 + F.wave * 4 + rp] = cur.bf ? pkb(v[rp][cc][0] * s0, v[rp][cc][1] * s1) : pkh(v[rp][cc][0] * s0, v[rp][cc][1] * s1); } \
        __syncthreads(); \
        done = cur; it += F.G; have = ttile_get(F, it, cur); \
        if (have) ttile_load(F, cur, v);                                \
        { const int q = F.tid & 7; \
          _Pragma("unroll") for (int i = 0; i < 4; ++i) { const int c = (F.tid >> 3) + 64 * i, n = done.n0 + c; \
            if (n < done.N && n < done.dfrom) { const LAS unsigned* r = img + c * 33 + 4 * q; u32x4 o; o.x = r[0]; o.y = r[1]; o.z = r[2]; o.w = r[3];     \
                *(u32x4*)(done.WT + (size_t)(n + (n >= done.dfrom ? done.dshift : 0)) * done.K + done.k0 + 8 * q) = o; } } } } while (0)
    for (;;) {
        if (!have_a) break;
        PA_STEP(ta, va, have_a, 0);
        if (!have_b) break;
        PA_STEP(tb, vb, have_b, 256 * 33 * 4 + 256);
    }
#undef PA_STEP
    __syncthreads();
    const int lane = F.lane;
    for (int i = F.gw * 64 + lane; i < 2 * 40960; i += F.NGW * 64) { const int l = i / 40960, q = i % 40960;
        *(u32x4*)(WSP(f16, WS_WTIN) + ((size_t)l * NTOT + C_MERGE) * DM + (size_t)q * 8) = (u32x4){0u, 0u, 0u, 0u}; }
}
__device__ __forceinline__ void pa_mod(Frame& F) {
    const int lane = F.lane;
    {
        LAS float* sl = (LAS float*)F.lds;
        LAS float* part = (LAS float*)(F.lds + 5 * 2048 * 4);
        if (F.bid < 2 * 96) {
            __syncthreads();
            for (int i = F.tid; i < 5 * DM; i += NTHREADS) { const int j = i / DM, k = i % DM; sl[i] = siluf_(j < 4 ? F.in[F.zin + I_C][j * DM + k] : F.in[F.zin + I_CCTX][k]); }
            __syncthreads();
        }
        for (int it = F.bid; it < 2 * 96; it += F.G) {
            const int l = it / 96, n = (it % 96) * 64 + lane;
            const float* wa = INP(I_WADA, l, (size_t)DM * 6144) + n + (size_t)(F.wave * 256) * 6144;
            const LAS float* s0 = sl + F.wave * 256;
            float a0 = 0.f, a1 = 0.f, a2 = 0.f, a3 = 0.f, a4 = 0.f;
#pragma unroll 64
            for (int k = 0; k < 256; ++k) { const float w = wa[(size_t)k * 6144];
                a0 += s0[k] * w; a1 += s0[DM + k] * w; a2 += s0[2 * DM + k] * w; a3 += s0[3 * DM + k] * w; a4 += s0[4 * DM + k] * w; }
            LAS float* pw = part + F.wave * 320 + lane;
            pw[0] = a0; pw[64] = a1; pw[128] = a2; pw[192] = a3; pw[256] = a4;
            __syncthreads();
            if (F.tid < 320) { float t = 0.f;
#pragma unroll
                for (int w = 0; w < 8; ++w) t += part[w * 320 + F.tid];
                const int j = F.tid >> 6, nn = (it % 96) * 64 + (F.tid & 63);
                WSP(float, WS_MOD)[((size_t)l * 5 + j) * 6144 + nn] = t + INP(I_BADA, l, 6144)[nn]; }
            __syncthreads();
        }
        __syncthreads();
    }
}
__device__ __forceinline__ void pa_rope(Frame& F) {
    const int lane = F.lane;
    for (int i = F.gw * 64 + lane; i < 2048 * 32; i += F.NGW * 64) {
        const int p = i >> 5, f = i & 31;
        const float invf = powf(10000.0f, -(float)(f & 15) / 16.0f);
        const float ang = (float)(f < 16 ? (p >> 6) : (p & 63)) * invf;
        WSP(float, WS_ROPE)[i] = cosf(ang); WSP(float, WS_ROPE)[2048 * 32 + i] = sinf(ang);
    }
}
__device__ __forceinline__ void pa_filters(Frame& F) {
    const int lane = F.lane;
    for (int it = F.gw; it < 2 * 2304; it += F.NGW) {
        const int l = it / 2304, q = it % 2304, isctx = q >= 2048, m = isctx ? q - 2048 : q, n = isctx ? 256 : 2048;
        const float* w1 = INP(I_HW1, l, 33 * 64); const float* w2 = INP(I_HW2, l, 64 * 64);
        const float t = (float)m / (float)(n - 1), wang = (6.283185307179586f / (float)n) * (float)m;
        float pre = INP(I_HB1, l, 64)[lane] + t * w1[lane];
#pragma unroll
        for (int i = 0; i < 16; ++i) { const float band = 1e-4f + (float)i * ((15.0f - 1e-4f) / 15.0f); const float a = band * wang;
            pre += cosf(a) * w1[(1 + i) * 64 + lane] - sinf(a) * w1[(17 + i) * 64 + lane]; }
        const float hd1 = sinf(INP(I_HFREQ, l, 128)[lane] * pre);
        float pre2 = INP(I_HB2, l, 64)[lane];
#pragma unroll 8
        for (int k = 0; k < 64; ++k) pre2 += __shfl(hd1, k) * w2[k * 64 + lane];
        WSP(f16, WS_HD2)[((size_t)l * 2304 + q) * 64 + lane] = (f16)sinf(INP(I_HFREQ, l, 128)[64 + lane] * pre2);
    }
}
__device__ __forceinline__ void pb_w8(Frame& F) {
    constexpr int NT8 = 2 * 32 * 32;
    float va[4][4][2], vb[4][4][2]; unsigned ca[4], cb[4];
#define PB_LOAD(IT, v, cmv) do { const int l_ = (IT) >> 10, nb_ = ((IT) >> 5) & 31, kb_ = (IT) & 31, k0_ = kb_ * 64, n0_ = nb_ * 256; \
        const float* W_ = INP(I_WIN, l_, (size_t)DM * INW) + C_MERGE; const unsigned* cm_ = (const unsigned*)(F.ws + WS_CTL + CTL_CMAX) + (size_t)l_ * NGATE; \
        _Pragma("unroll") for (int rp = 0; rp < 4; ++rp) { const int k = k0_ + 2 * (F.wave * 4 + rp); \
            _Pragma("unroll") for (int cc = 0; cc < 4; ++cc) { const int n = n0_ + cc * 64 + F.lane; v[rp][cc][0] = __builtin_nontemporal_load(W_ + (size_t)k * INW + n); v[rp][cc][1] = __builtin_nontemporal_load(W_ + (size_t)(k + 1) * INW + n); } } \
        _Pragma("unroll") for (int cc = 0; cc < 4; ++cc) cmv[cc] = __hip_atomic_load(cm_ + n0_ + cc * 64 + F.lane, __ATOMIC_RELAXED, __HIP_MEMORY_SCOPE_AGENT); } while (0)
#define PB_STEP(IT, v, cmv, IMGOFF) do { LAS unsigned* img = (LAS unsigned*)(F.lds + (IMGOFF)); \
        const int l = (IT) >> 10, nb = ((IT) >> 5) & 31, kb = (IT) & 31, k0 = kb * 64, n0 = nb * 256; \
        _Pragma("unroll") for (int cc = 0; cc < 4; ++cc) { const int n = n0 + cc * 64 + F.lane; \
            const float mx = fmaxf(__uint_as_float(cmv[cc]), 1e-30f), qs = 127.0f / mx; \
            if (kb == 0 && F.wave == 0) WSP(float, WS_CS)[(size_t)l * NGATE + n] = mx * (1.0f / 127.0f); \
            _Pragma("unroll") for (int h2 = 0; h2 < 2; ++h2) { unsigned w = 0; \
                _Pragma("unroll") for (int e = 0; e < 4; ++e) { const int qv = (int)rintf(v[2 * h2 + (e >> 1)][cc][e & 1] * qs); w |= ((unsigned)qv & 0xffu) << (8 * e); } \
                img[(cc * 64 + F.lane) * 17 + F.wave * 2 + h2] = w; } } \
        __syncthreads(); \
        { const int nx_ = (IT) + 2 * F.G; if (nx_ < NT8) PB_LOAD(nx_, v, cmv); }          \
        { char* W8 = (char*)F.ws + ws_w8(l); \
          _Pragma("unroll") for (int i = 0; i < 2; ++i) { const int c = (F.tid >> 2) + 128 * i, q = F.tid & 3; const LAS unsigned* r = img + c * 17 + 4 * q; \
            u32x4 o; o.x = r[0]; o.y = r[1]; o.z = r[2]; o.w = r[3]; \
            *(u32x4*)(W8 + (size_t)(n0 + c) * DM + k0 + 16 * q) = o; } } } while (0)
    int it = F.bid;
    if (it < NT8) PB_LOAD(it, va, ca);
    if (it + F.G < NT8) PB_LOAD(it + F.G, vb, cb);
    for (;;) {
        if (it >= NT8) break;
        PB_STEP(it, va, ca, 0); it += F.G;
        if (it >= NT8) break;
        PB_STEP(it, vb, cb, 256 * 17 * 4 + 256); it += F.G;
    }
#undef PB_LOAD
#undef PB_STEP
    __syncthreads();
}
__device__ __forceinline__ void filter_gemm(Frame& F) {
    for (int it = F.gw; it < 2 * 72 * 8; it += F.NGW) {
        const int lane = lane_id_opaque(), r32 = lane & 31, hi = lane >> 5;
        const int l = it / 576, q = it % 576, pt = q >> 3, cc = q & 7, isctx = pt >= 64, n = isctx ? 256 : 2048;
        const int m0 = isctx ? (pt - 64) * 32 : pt * 32, posbase = isctx ? 2048 + m0 : m0, c0 = cc * 256;
        const f16* hd = WSP(f16, WS_HD2) + ((size_t)l * 2304 + posbase + r32) * 64 + hi * 8;
        f16x8 A[4];
#pragma unroll
        for (int ks = 0; ks < 4; ++ks) A[ks] = *(const f16x8*)(hd + ks * 16);
        const float* w3u = INP(I_HW3, l, 64 * 2048);
        const unsigned loff = (unsigned)(8 * hi * 2048 + c0 + r32);
        f16* hf = (f16*)(F.ws + WS_HF + (size_t)l * HF_LAYER + (isctx ? HF_LAT : 0));
#pragma unroll 1
        for (int half4 = 0; half4 < 2; ++half4) {
            f32x16 acc[4];
#pragma unroll
            for (int ct = 0; ct < 4; ++ct) { acc[ct] = f32x16{};
#pragma unroll
                for (int ks = 0; ks < 4; ++ks) { float wv[8];
#pragma unroll
                    for (int j = 0; j < 8; ++j) wv[j] = (w3u + (size_t)(16 * ks + j) * 2048 + (half4 * 4 + ct) * 32)[loff];
                    f32x4 w0 = {wv[0], wv[1], wv[2], wv[3]}, w1 = {wv[4], wv[5], wv[6], wv[7]};
                    acc[ct] = __builtin_amdgcn_mfma_f32_32x32x16_f16(A[ks], __builtin_bit_cast(f16x8, pkh8(w0, w1)), acc[ct], 0, 0, 0); } }
#pragma unroll
            for (int ct = 0; ct < 4; ++ct) { const int c = c0 + (half4 * 4 + ct) * 32 + r32, ch = c & 1023;
                const float delta = fabsf(-15.350567286626973f + (float)ch * ((-3.0701134573253945f + 15.350567286626973f) / 1023.0f));
#pragma unroll
                for (int r = 0; r < 16; ++r) { const int m = m0 + (r & 3) + 8 * (r >> 2) + 4 * hi;
                    const float o = acc[ct][r] * expf(-((float)m / (float)(n - 1)) * delta);
                    f16* hg = hf + (size_t)(ch >> 3) * (2 * n) * 8 + (ch & 7);
                    if (c < 1024) hg[(size_t)(n - m) * 8] = (f16)o;
                    else if (m >= 1) hg[(size_t)(n + m) * 8] = (f16)o;
                    if (m == 0 && c < 1024) hg[0] = (f16)0.f; } }
        }
    }
}

__device__ __forceinline__ void row_stats(const f32x4 (&v)[8], float& mean, float& rstd) {
    float s = 0.f;
#pragma unroll
    for (int j = 0; j < 8; ++j) s += (v[j][0] + v[j][1]) + (v[j][2] + v[j][3]);
    mean = wave_sum(s) * (1.f / DM); float s2 = 0.f;
#pragma unroll
    for (int j = 0; j < 8; ++j) { const f32x4 d = v[j] - mean; s2 += (d[0] * d[0] + d[1] * d[1]) + (d[2] * d[2] + d[3] * d[3]); }
    rstd = 1.0f / sqrtf(wave_sum(s2) * (1.f / DM) + LN_EPS);
}
__device__ __forceinline__ void write_h_row(Frame& F, const f32x4 (&v)[8], int row, int l) {
    const int bidx = row < NLAT ? row / SEQ : 4;
    const float* mo = WSP(float, WS_MOD) + ((size_t)l * 5 + bidx) * 6144;
    f32x4 shv[8], scv[8];
#pragma unroll
    for (int j = 0; j < 8; ++j) { const int col = 4 * F.lane + 256 * j; shv[j] = *(const f32x4*)(mo + col); scv[j] = *(const f32x4*)(mo + 2048 + col); }
    float mean, rstd; row_stats(v, mean, rstd);
    f16* hr = WSP(f16, WS_H) + (size_t)row * DM;
    f32x4 hq[8]; float mx = 0.f;
#pragma unroll
    for (int j = 0; j < 8; ++j) { const int col = 4 * F.lane + 256 * j;
        const f32x4 sh = shv[j], sc = scv[j];
        const f32x4 h = (v[j] - mean) * rstd * (sc + 1.0f) + sh; hq[j] = h;
        mx = fmaxf(mx, fmaxf(fmaxf(fabsf(h[0]), fabsf(h[1])), fmaxf(fabsf(h[2]), fabsf(h[3]))));
        u32x2 w; if (IN_BF16) { w.x = pkb(h[0], h[1]); w.y = pkb(h[2], h[3]); } else { w.x = pkh(h[0], h[1]); w.y = pkh(h[2], h[3]); } *(u32x2*)(hr + col) = w; }
    mx = wave_max(mx);
    mx = fmaxf(mx, 1e-30f); const float qs = 127.0f / mx;
    unsigned* h8 = (unsigned*)(F.ws + WS_H8 + (size_t)row * DM);
#pragma unroll
    for (int j = 0; j < 8; ++j) { unsigned w = 0;
#pragma unroll
        for (int e = 0; e < 4; ++e) w |= ((unsigned)(int)rintf(hq[j][e] * qs) & 0xffu) << (8 * e);
        h8[F.lane + 64 * j] = w; }
    if (F.lane == 0) WSP(float, WS_HS)[row] = mx * (1.0f / 127.0f);
}
__device__ __forceinline__ void prologue_b(Frame& F) {
    f32x4 nv[8];
    { const int row = F.gw; const float* xr = row < NLAT ? F.in[F.zin + I_X] + (size_t)row * DM : F.in[F.zin + I_CTX] + (size_t)(row - NLAT) * DM;
#pragma unroll
      for (int j = 0; j < 8; ++j) nv[j] = __builtin_nontemporal_load((const f32x4*)(xr + 4 * F.lane + 256 * j)); }
    for (int row = F.gw; row < MROWS; row += F.NGW) {
        f32x4 v[8];
#pragma unroll
        for (int j = 0; j < 8; ++j) v[j] = nv[j];
        const int nrow = row + F.NGW;
        if (nrow < MROWS) { const float* xr = nrow < NLAT ? F.in[F.zin + I_X] + (size_t)nrow * DM : F.in[F.zin + I_CTX] + (size_t)(nrow - NLAT) * DM;
#pragma unroll
            for (int j = 0; j < 8; ++j) nv[j] = __builtin_nontemporal_load((const f32x4*)(xr + 4 * F.lane + 256 * j)); }
        write_h_row(F, v, row, 0);
    }
}
__device__ __forceinline__ void ln_phase(Frame& F, int l) {
    const int nrows = (l == DEPTH - 1) ? NLAT : MROWS;
    const float* lg = INP(I_LNG, l, DM); const float* lb = INP(I_LNB, l, DM);
    u32x2 raw[8];
    const f16* ybase = WSP(f16, WS_Y) + (size_t)MROWS * DM;
    const bool bal = (l == 0 && F.NGW == 2048), clsA = F.gw < 1024;
    const int nk = bal ? (clsA ? 4 : 5) : (F.gw < nrows ? (nrows - 1 - F.gw) / F.NGW + 1 : 0);
#define LN_ROWOF(k) (!bal ? F.gw + (k) * F.NGW : (clsA ? ((k) < 3 ? F.gw + 1024 * (k) : NLAT + F.gw) : 3072 + (F.gw - 1024) + 1024 * (k)))
    if (nk > 0) { const int row0 = LN_ROWOF(0);
      if (!(l == 0 && row0 >= NLAT)) {
#pragma unroll
        for (int j = 0; j < 8; ++j) raw[j] = __builtin_nontemporal_load((const u32x2*)(ybase + (size_t)row0 * DM + 4 * F.lane + 256 * j)); } }
    for (int kk = 0; kk < nk; ++kk) { const int row = LN_ROWOF(kk);
        f32x4 v[8];
        if (l == 0 && row >= NLAT) {
            const float* rr = F.in[F.zin + I_CTX] + (size_t)(row - NLAT) * DM; const f16* sl = (const f16*)(F.ws + WS_SA) + (size_t)4 * NCTX * DM + (size_t)(row - NLAT) * DM;
#pragma unroll
            for (int j = 0; j < 8; ++j) { const int col = 4 * F.lane + 256 * j; f32x4 a = *(const f32x4*)(rr + col) * DN_ALPHA;
#pragma unroll
                for (int k = 0; k < 4; ++k) { const f16x4 t = *(const f16x4*)(sl + (size_t)k * NCTX * DM + col); a += (f32x4){(float)t[0], (float)t[1], (float)t[2], (float)t[3]}; }
                v[j] = a; }
        } else {
#pragma unroll
        for (int j = 0; j < 8; ++j) { const f16x4 t = __builtin_bit_cast(f16x4, raw[j]); v[j] = (f32x4){(float)t[0], (float)t[1], (float)t[2], (float)t[3]}; } }
        { const int nrow = LN_ROWOF(kk + 1);
          if (kk + 1 < nk && !(l == 0 && nrow >= NLAT)) {
#pragma unroll
              for (int j = 0; j < 8; ++j) raw[j] = __builtin_nontemporal_load((const u32x2*)(ybase + (size_t)nrow * DM + 4 * F.lane + 256 * j)); } }
        f32x4 lgv[8], lbv[8];
#pragma unroll
        for (int j = 0; j < 8; ++j) { lgv[j] = *(const f32x4*)(lg + 4 * F.lane + 256 * j); lbv[j] = *(const f32x4*)(lb + 4 * F.lane + 256 * j); }
        float mean, rstd; row_stats(v, mean, rstd);
        float* xo = F.out + (size_t)row * DM; f16* x1 = WSP(f16, WS_X1) + (size_t)row * DM;
#pragma unroll
        for (int j = 0; j < 8; ++j) { const int col = 4 * F.lane + 256 * j;
            v[j] = (v[j] - mean) * rstd * lgv[j] + lbv[j];
            if (l == DEPTH - 1) __builtin_nontemporal_store(v[j], (f32x4*)(xo + col));
            else { u32x2 w; w.x = pkh(v[j][0], v[j][1]); w.y = pkh(v[j][2], v[j][3]); __builtin_nontemporal_store(w, (u32x2*)(x1 + col)); } }
        if (l < DEPTH - 1) write_h_row(F, v, row, l + 1);
    }
#undef LN_ROWOF
}

struct EpiInProj {
    static constexpr bool PERM = true, KEEP = false;
    f16* P; f16* G; f16* PC;
    __device__ __forceinline__ void operator()(const f32x4 (&acc)[2][2][4][2], const pg8::Unit& u, int wr, int wc, int fr, int fq) const {
        const int row0 = u.pm * 256 + wr * 64 + fr;
        const bool sig = u.pn >= NPT;
        f16* base = sig ? G : P; const int ld = sig ? NGATE : NPAD;
        const int col0 = (sig ? u.pn - NPT : u.pn) * 256 + wc * 32 + 8 * fq;
        const bool cm0 = !sig && (col0 < PC_SPLIT || (col0 >= C_HXV && col0 < C_MERGE)), cm1 = !sig && (col0 + 128 < PC_SPLIT || (col0 + 128 >= C_HXV && col0 + 128 < C_MERGE));
        f16* pc0 = PC + (size_t)pc_chunk(cm0 ? col0 : 0) * MROWS * 8; f16* pc1 = PC + (size_t)pc_chunk(cm1 ? col0 + 128 : 0) * MROWS * 8;
#pragma unroll
        for (int ai = 0; ai < 2; ++ai)
#pragma unroll
            for (int m = 0; m < 4; ++m) { f16* rowp = base + (size_t)(row0 + ai * 128 + m * 16) * ld + col0;
#pragma unroll
                for (int bj = 0; bj < 2; ++bj) { f32x4 v0 = acc[ai][bj][m][0], v1 = acc[ai][bj][m][1];
                    const int row = row0 + ai * 128 + m * 16;
                    if (bj == 0 ? cm0 : cm1) *(u32x4*)((bj == 0 ? pc0 : pc1) + (size_t)row * 8) = pkh8(v0, v1);
                    else if (sig) __builtin_nontemporal_store(pkh8(v0, v1), (u32x4*)(rowp + bj * 128));
                    else *(u32x4*)(rowp + bj * 128) = pkh8(v0, v1); } }
    }
};
struct EpiGate {
    static constexpr bool PERM = true, KEEP = false;
    unsigned char* G; const float* hs; const float* cs;
    __device__ __forceinline__ void operator()(const f32x4 (&acc)[2][2][4][2], const pg8::Unit& u, int wr, int wc, int fr, int fq) const {
        const int row0 = u.pm * 256 + wr * 64 + fr, col0 = u.pn * 256 + wc * 32 + 8 * fq;
        f32x4 c4[2][2];
#pragma unroll
        for (int bj = 0; bj < 2; ++bj)
#pragma unroll
            for (int n = 0; n < 2; ++n) c4[bj][n] = *(const f32x4*)(cs + col0 + bj * 128 + n * 4);
        float rsv[2][4];
#pragma unroll
        for (int ai = 0; ai < 2; ++ai)
#pragma unroll
            for (int m = 0; m < 4; ++m) rsv[ai][m] = hs[row0 + ai * 128 + m * 16];
#pragma unroll
        for (int ai = 0; ai < 2; ++ai)
#pragma unroll
            for (int m = 0; m < 4; ++m) { const int row = row0 + ai * 128 + m * 16; const float rs = rsv[ai][m];
#pragma unroll
                for (int bj = 0; bj < 2; ++bj) { const pg8::i32x4 a0 = __builtin_bit_cast(pg8::i32x4, acc[ai][bj][m][0]), a1 = __builtin_bit_cast(pg8::i32x4, acc[ai][bj][m][1]);
                    unsigned w0 = 0u, w1 = 0u;
#pragma unroll
                    for (int e = 0; e < 4; ++e) {
                        const unsigned q0 = (unsigned)__builtin_rintf(sigmoidf_((float)a0[e] * rs * c4[bj][0][e]) * 255.0f), q1 = (unsigned)__builtin_rintf(sigmoidf_((float)a1[e] * rs * c4[bj][1][e]) * 255.0f);
                        w0 |= (q0 < 1u ? 1u : q0) << (8 * e); w1 |= (q1 < 1u ? 1u : q1) << (8 * e); }
                    u32x2 w; w.x = w0; w.y = w1;
                    *(u32x2*)(G + (size_t)row * NGATE + col0 + bj * 128) = w; } }
    }
};
struct EpiRowScale {
    static constexpr bool PERM = true, KEEP = false;
    f16* O; int ldc; const float* rs;
    __device__ __forceinline__ void operator()(const f32x4 (&acc)[2][2][4][2], const pg8::Unit& u, int wr, int wc, int fr, int fq) const {
        const int row0 = u.pm * 256 + wr * 64 + fr, col0 = u.pn * 256 + wc * 32 + 8 * fq;
        float rsv[2][4];
#pragma unroll
        for (int ai = 0; ai < 2; ++ai)
#pragma unroll
            for (int m = 0; m < 4; ++m) rsv[ai][m] = rs[row0 + ai * 128 + m * 16];
#pragma unroll
        for (int ai = 0; ai < 2; ++ai)
#pragma unroll
            for (int m = 0; m < 4; ++m) { const int row = row0 + ai * 128 + m * 16; const float s = rsv[ai][m]; f16* rowp = O + (size_t)row * ldc + col0;
#pragma unroll
                for (int bj = 0; bj < 2; ++bj) *(u32x4*)(rowp + bj * 128) = pkh8(acc[ai][bj][m][0] * s, acc[ai][bj][m][1] * s); }
    }
};
struct EpiMerge {
    static constexpr bool PERM = true, KEEP = true;
    const unsigned char* G; f16* MIX;
    __device__ __forceinline__ void operator()(f32x4 (&acc)[2][2][4][2], const pg8::Unit& u, int wr, int wc, int fr, int fq) const {
        const int row0 = u.pm * 256 + wr * 64 + fr, col0 = u.pn * 256 + wc * 32 + 8 * fq;
        const unsigned char* gp = G + (size_t)row0 * NGATE + u.kz * 2048 + col0;
        f16* op = MIX + (size_t)row0 * DM + col0;
        const bool last = u.kz == 3;
#pragma unroll
        for (int ai = 0; ai < 2; ++ai) { u32x2 gk[4][2], gn[4][2];
#pragma unroll
            for (int m = 0; m < 4; ++m)
#pragma unroll
                for (int bj = 0; bj < 2; ++bj) gk[m][bj] = *(const u32x2*)(gp + (size_t)(ai * 128 + m * 16) * NGATE + bj * 128);
            if (!last) {
#pragma unroll
                for (int m = 0; m < 4; ++m)
#pragma unroll
                    for (int bj = 0; bj < 2; ++bj) gn[m][bj] = *(const u32x2*)(gp + (size_t)(ai * 128 + m * 16) * NGATE + bj * 128 + 2048);
            } else {
#pragma unroll
                for (int m = 0; m < 4; ++m)
#pragma unroll
                    for (int bj = 0; bj < 2; ++bj) gn[m][bj] = (u32x2){0xffffffffu, 0xffffffffu};
            }
#pragma unroll
            for (int m = 0; m < 4; ++m)
#pragma unroll
                for (int bj = 0; bj < 2; ++bj)
#pragma unroll
                    for (int e = 0; e < 4; ++e) {
                        acc[ai][bj][m][0][e] *= (float)((gk[m][bj].x >> (8 * e)) & 255u) * __builtin_amdgcn_rcpf((float)((gn[m][bj].x >> (8 * e)) & 255u));
                        acc[ai][bj][m][1][e] *= (float)((gk[m][bj].y >> (8 * e)) & 255u) * __builtin_amdgcn_rcpf((float)((gn[m][bj].y >> (8 * e)) & 255u)); }
            if (last) {
#pragma unroll
                for (int m = 0; m < 4; ++m)
#pragma unroll
                    for (int bj = 0; bj < 2; ++bj) *(u32x4*)(op + (size_t)(ai * 128 + m * 16) * DM + bj * 128) = pkb8(acc[ai][bj][m][0], acc[ai][bj][m][1]);
            }
        }
    }
};
template <bool RES16>
struct EpiOut {
    static constexpr bool PERM = true, KEEP = false;
    const void* res_lat; const void* res_ctx; const float* mod; f16* Y;
    __device__ __forceinline__ void operator()(const f32x4 (&acc)[2][2][4][2], const pg8::Unit& u, int wr, int wc, int fr, int fq) const {
        const int row0 = u.pm * 256 + wr * 64 + fr, col0 = u.pn * 256 + wc * 32 + 8 * fq;
        const bool lat = u.pm < NLAT / 256;
        const float* res = lat ? (const float*)res_lat : (const float*)res_ctx - (size_t)NLAT * DM;
        const f16* res16 = lat ? (const f16*)res_lat : (const f16*)res_ctx - (size_t)NLAT * DM;
        const float* gv = mod + (size_t)(lat ? u.pm / 8 : 4) * 6144 + 4096;
        f32x4 g4[2][2];
#pragma unroll
        for (int bj = 0; bj < 2; ++bj)
#pragma unroll
            for (int n = 0; n < 2; ++n) g4[bj][n] = *(const f32x4*)(gv + col0 + bj * 128 + n * 4);
#pragma unroll
        for (int ai = 0; ai < 2; ++ai) { f32x4 rv[4][2][2];
#pragma unroll
            for (int m = 0; m < 4; ++m) { const size_t off = (size_t)(row0 + ai * 128 + m * 16) * DM + col0;
#pragma unroll
                for (int bj = 0; bj < 2; ++bj) {
                    if constexpr (RES16) { const f16x8 t = __builtin_bit_cast(f16x8, __builtin_nontemporal_load((const u32x4*)(res16 + off + bj * 128)));
                        rv[m][bj][0] = (f32x4){(float)t[0], (float)t[1], (float)t[2], (float)t[3]}; rv[m][bj][1] = (f32x4){(float)t[4], (float)t[5], (float)t[6], (float)t[7]}; }
                    else { rv[m][bj][0] = __builtin_nontemporal_load((const f32x4*)(res + off + bj * 128)); rv[m][bj][1] = __builtin_nontemporal_load((const f32x4*)(res + off + bj * 128 + 4)); } } }
#pragma unroll
            for (int m = 0; m < 4; ++m) { const size_t off = (size_t)(row0 + ai * 128 + m * 16) * DM + col0;
#pragma unroll
                for (int bj = 0; bj < 2; ++bj)
                    *(u32x4*)(Y + off + bj * 128) = pkh8(rv[m][bj][0] * DN_ALPHA + g4[bj][0] * acc[ai][bj][m][0], rv[m][bj][1] * DN_ALPHA + g4[bj][1] * acc[ai][bj][m][1]); } }
    }
};
struct EpiMergeSlab {
    static constexpr bool PERM = true, KEEP = false;
    const unsigned char* G; f16* slab;
    __device__ __forceinline__ void operator()(const f32x4 (&acc)[2][2][4][2], const pg8::Unit& u, int wr, int wc, int fr, int fq) const {
        const int row0 = u.pm * 256 + wr * 64 + fr, col0 = u.pn * 256 + wc * 32 + 8 * fq;
#pragma unroll
        for (int ai = 0; ai < 2; ++ai) { u32x2 gtv[4][2];
#pragma unroll
            for (int m = 0; m < 4; ++m)
#pragma unroll
                for (int bj = 0; bj < 2; ++bj) gtv[m][bj] = *(const u32x2*)(G + (size_t)(row0 + ai * 128 + m * 16) * NGATE + u.kz * 2048 + col0 + bj * 128);
#pragma unroll
            for (int m = 0; m < 4; ++m) { const int row = row0 + ai * 128 + m * 16;
#pragma unroll
                for (int bj = 0; bj < 2; ++bj) { const int col = col0 + bj * 128;
                    const unsigned g0 = gtv[m][bj].x, g1 = gtv[m][bj].y;
                    f32x4 v0 = acc[ai][bj][m][0], v1 = acc[ai][bj][m][1];
#pragma unroll
                    for (int e = 0; e < 4; ++e) { v0[e] *= (float)((g0 >> (8 * e)) & 255u) * (1.0f / 255.0f); v1[e] *= (float)((g1 >> (8 * e)) & 255u) * (1.0f / 255.0f); }
                    *(u32x4*)(slab + ((size_t)u.kz * NCTX + (row - NLAT)) * DM + col) = pkh8(v0, v1); } } }
    }
};
__device__ __forceinline__ void merge_ctx_reduce(Frame& F) {
    const f16* slab = (const f16*)(F.ws + WS_SA); f16* MIX = WSP(f16, WS_MIX) + (size_t)NLAT * DM;
    const int gt = F.gw * 64 + F.lane, NT = F.NGW * 64;
    for (int p0 = gt; p0 < NCTX * DM / 8; p0 += 2 * NT) {
        u32x4 a[2][4];
#pragma unroll
        for (int u = 0; u < 2; ++u) { const int p = p0 + u * NT;
#pragma unroll
            for (int k = 0; k < 4; ++k) { a[u][k] = (u32x4){0u, 0u, 0u, 0u};
                if (p < NCTX * DM / 8) a[u][k] = __builtin_nontemporal_load((const u32x4*)(slab + (size_t)k * NCTX * DM + (size_t)p * 8)); } }
#pragma unroll
        for (int u = 0; u < 2; ++u) { const int p = p0 + u * NT;
            if (p < NCTX * DM / 8) { f32x4 s0 = {0.f, 0.f, 0.f, 0.f}, s1 = s0;
#pragma unroll
                for (int k = 0; k < 4; ++k) { const f16x8 h = __builtin_bit_cast(f16x8, a[u][k]);
#pragma unroll
                    for (int e = 0; e < 4; ++e) { s0[e] += (float)h[e]; s1[e] += (float)h[4 + e]; } }
                *(u32x4*)(MIX + (size_t)p * 8) = pkb8(s0, s1); } }
    }
}
struct EpiOutSlab {
    static constexpr bool PERM = false, KEEP = false;
    const float* mod; f16* slab;
    __device__ __forceinline__ void operator()(const f32x4 (&acc)[2][2][4][2], const pg8::Unit& u, int wr, int wc, int fr, int fq) const {
        const int row0 = u.pm * 256 + wr * 64 + fr, col0 = u.pn * 256 + wc * 32 + 4 * fq;
        const float* gv = mod + (size_t)4 * 6144 + 4096;
        f32x4 g4v[2][2];
#pragma unroll
        for (int bj = 0; bj < 2; ++bj)
#pragma unroll
            for (int n = 0; n < 2; ++n) g4v[bj][n] = *(const f32x4*)(gv + col0 + bj * 128 + n * 16);
#pragma unroll
        for (int bj = 0; bj < 2; ++bj)
#pragma unroll
            for (int n = 0; n < 2; ++n) { const f32x4 g4 = g4v[bj][n];
#pragma unroll
                for (int ai = 0; ai < 2; ++ai)
#pragma unroll
                    for (int m = 0; m < 4; ++m) { const f32x4 v = g4 * acc[ai][bj][m][n]; u32x2 w; w.x = pkh(v[0], v[1]); w.y = pkh(v[2], v[3]);
                        *(u32x2*)(slab + ((size_t)u.kz * NCTX + (row0 + ai * 128 + m * 16 - NLAT)) * DM + col0 + bj * 128 + n * 16) = w; } }
    }
};

constexpr size_t SA_U = 0, SA_DT = (size_t)MROWS * 1536 * 4, SA_KPE = SA_DT + (size_t)MROWS * 32 * 4, SA_GK = SA_KPE + (size_t)MROWS * 64 * 4;
static_assert(SA_GK + (size_t)MROWS * 128 * 4 <= SA_BYTES, "scratch A");

__device__ __forceinline__ bool has_prev(int row) { return row < NLAT ? (row & (SEQ - 1)) != 0 : ((row - NLAT) & (CTXL - 1)) != 0; }
__device__ __forceinline__ bool has_next(int row) { return row < NLAT ? (row & (SEQ - 1)) != SEQ - 1 : ((row - NLAT) & (CTXL - 1)) != CTXL - 1; }
__device__ __forceinline__ float conv3(const f16* P, int row, int col, const float* w, int wc, int nch, float bias) {
    float a = w[nch + wc] * (float)P[(size_t)row * NPAD + col] + bias;
    if (has_prev(row)) a += w[wc] * (float)P[(size_t)(row - 1) * NPAD + col];
    if (has_next(row)) a += w[2 * nch + wc] * (float)P[(size_t)(row + 1) * NPAD + col];
    return a;
}
__device__ __forceinline__ void prep_naive(Frame& F, int l) {
    f16* Pw = WSP(f16, WS_P);
    const int gt = F.gw * 64 + F.lane, NT = F.NGW * 64;
    const float* cosT = WSP(float, WS_ROPE); const float* sinT = cosT + 2048 * 32;
    for (int row0 = F.gw; row0 < MROWS; row0 += 5 * F.NGW) {
        f16x8 vq[5], vk[5];
#pragma unroll
        for (int k = 0; k < 5; ++k) { const int row = row0 + k * F.NGW; vq[k] = f16x8{}; vk[k] = f16x8{};
            if (row < MROWS) { const f16* pr = Pw + (size_t)row * NPAD + C_CQ;
                vq[k] = *(const f16x8*)(pr + F.lane * 8); if (F.lane < 32) vk[k] = *(const f16x8*)(pr + 512 + F.lane * 8); } }
#pragma unroll
        for (int k = 0; k < 5; ++k) { const int row = row0 + k * F.NGW;
            if (row < MROWS) { float sq = 0.f, sk = 0.f;
#pragma unroll
                for (int j = 0; j < 8; ++j) { sq += (float)vq[k][j] * (float)vq[k][j]; sk += (float)vk[k][j] * (float)vk[k][j]; }
                sq = wave_sum(sq); sk = wave_sum(sk);
                if (F.lane == 0) { WSP(float, WS_RS)[row] = 1.0f / sqrtf(sq * (1.f / 512.f) + LN_EPS); WSP(float, WS_RS)[MROWS + row] = 1.0f / sqrtf(sk * (1.f / 256.f) + LN_EPS); } } }
    }
    for (int i = gt; i < NLAT * 12; i += NT) { const int row = i / 12, s = i % 12, p = row & (SEQ - 1);
        f16* a = Pw + (size_t)row * NPAD + (s < 4 ? C_KPE + s * 8 : C_GK + ((s - 4) >> 2) * 64 + ((s - 4) & 3) * 8);
        const int f0 = (s < 4 ? s : (s - 4) & 3) * 8;
        const f16x8 t1 = *(const f16x8*)a, t2 = *(const f16x8*)(a + 32);
        const f32x4 c0 = *(const f32x4*)(cosT + p * 32 + f0), c1 = *(const f32x4*)(cosT + p * 32 + f0 + 4), s0 = *(const f32x4*)(sinT + p * 32 + f0), s1 = *(const f32x4*)(sinT + p * 32 + f0 + 4);
        f16x8 o1, o2;
#pragma unroll
        for (int j = 0; j < 8; ++j) { const float cc = j < 4 ? c0[j] : c1[j - 4], ss = j < 4 ? s0[j] : s1[j - 4], x = (float)t1[j], y = (float)t2[j];
            o1[j] = (f16)(x * cc - y * ss); o2[j] = (f16)(x * ss + y * cc); }
        *(f16x8*)a = o1; *(f16x8*)(a + 32) = o2; }
}

__device__ __forceinline__ void ssd_naive(Frame& F, int l) {
    const float* U = (const float*)(F.ws + WS_SA + SA_U); const float* DT = (const float*)(F.ws + WS_SA + SA_DT);
    float* YD = WSP(float, WS_Y);
    LAS float* tile = (LAS float*)F.lds;
    for (int item = F.bid; item < 256; item += F.G) {
        const int b = item >> 6, h = (item >> 2) & 15, dir = (item >> 1) & 1, ph = item & 1, g = h >> 3;
        const float a = -expf(INP(I_SALOG, l, 32)[dir * 16 + h]);
        const int pl = F.tid >> 4, nc = F.tid & 15;
        float st[8];
#pragma unroll
        for (int j = 0; j < 8; ++j) st[j] = 0.f;
        for (int s0 = 0; s0 < CTXL + SEQ; s0 += 16) {
            __syncthreads();
            for (int e = F.tid; e < 16 * 290; e += NTHREADS) { const int k = e / 290, q = e % 290, s = s0 + k;
                int row; if (s < CTXL) row = NLAT + b * CTXL + (dir ? CTXL - 1 - s : s); else row = b * SEQ + (dir ? SEQ - 1 - (s - CTXL) : (s - CTXL));
                float v;
                if (q < 32) v = U[(size_t)row * 1536 + h * 64 + ph * 32 + q];
                else if (q < 160) v = U[(size_t)row * 1536 + 1024 + g * 128 + (q - 32)];
                else if (q < 288) v = U[(size_t)row * 1536 + 1280 + g * 128 + (q - 160)];
                else if (q == 288) v = DT[(size_t)row * 32 + dir * 16 + h];
                else v = __int_as_float(row);
                tile[k * 292 + q] = v; }
            __syncthreads();
            for (int k = 0; k < 16; ++k) {
                const LAS float* tk = tile + k * 292;
                const float dtv = tk[288], dec = expf(dtv * a), xv = tk[pl] * dtv;
                float yp = 0.f;
#pragma unroll
                for (int j = 0; j < 8; ++j) { st[j] = dec * st[j] + xv * tk[32 + nc * 8 + j]; yp += st[j] * tk[160 + nc * 8 + j]; }
                yp += __shfl_xor(yp, 1); yp += __shfl_xor(yp, 2); yp += __shfl_xor(yp, 4); yp += __shfl_xor(yp, 8);
                if (nc == 0) { const int row = __float_as_int(tk[289]); YD[((size_t)dir * MROWS + row) * 1024 + h * 64 + ph * 32 + pl] = yp; }
            }
        }
        __syncthreads();
    }
}
__device__ __forceinline__ void ssd_gate_naive(Frame& F, int l) {
    const f16* P = WSP(f16, WS_P); const float* U = (const float*)(F.ws + WS_SA + SA_U); const float* YD = WSP(float, WS_Y);
    f16* GT = WSP(f16, WS_GATED);
    const int nrows = l == 0 ? MROWS : NLAT;
    for (int row = F.gw; row < nrows; row += F.NGW) {
        float gv[16]; float ss = 0.f;
#pragma unroll
        for (int j = 0; j < 16; ++j) { const int c = F.lane * 16 + j;
            const float y = YD[(size_t)row * 1024 + c] + YD[((size_t)MROWS + row) * 1024 + c] + U[(size_t)row * 1536 + c] * INP(I_SD, l, 16)[c >> 6];
            const float g = y * siluf_((float)P[(size_t)row * NPAD + C_SZ + c]); gv[j] = g; ss += g * g; }
#pragma unroll
        for (int o = 1; o < 32; o <<= 1) ss += __shfl_xor(ss, o);
        const float r = 1.0f / sqrtf(ss * (1.f / 512.f) + LN_EPS);
#pragma unroll
        for (int j = 0; j < 16; ++j) GT[(size_t)row * 1024 + F.lane * 16 + j] = (f16)(gv[j] * r);
    }
}
__device__ __forceinline__ void gqa_naive(Frame& F, int l) {
    const f16* P = WSP(f16, WS_P);
    const float* cosT = WSP(float, WS_ROPE); const float* sinT = cosT + 2048 * 32;
    f16* GT = WSP(f16, WS_GATED) + (size_t)2 * MROWS * 1024;
    const int nrows = l == 0 ? MROWS : NLAT;
    const int d = F.lane, f = d & 31;
    for (int it = F.gw; it < nrows * 16; it += F.NGW) {
        const int row = it >> 4, hq = it & 15, kv = hq >> 3;
        const bool lat = row < NLAT; const int b = lat ? row / SEQ : (row - NLAT) / CTXL, p = row & (SEQ - 1);
        const float t1 = (float)P[(size_t)row * NPAD + C_GQ + hq * 64 + f], t2 = (float)P[(size_t)row * NPAD + C_GQ + hq * 64 + 32 + f];
        float q;
        if (lat) { const float c = cosT[p * 32 + f], s = sinT[p * 32 + f]; q = d < 32 ? t1 * c - t2 * s : t1 * s + t2 * c; } else q = d < 32 ? t1 : t2;
        q *= 0.125f;
        float m = INP(I_GSINK, l, 16)[hq], lsum = 1.0f, acc = 0.f;
        const int nkeys = CTXL + (lat ? (min(p + 128, SEQ - 1) - max(p - 128, 0) + 1) : 0);
        for (int j = 0; j < nkeys; ++j) {
            const int krow = j < CTXL ? NLAT + b * CTXL + j : b * SEQ + max(p - 128, 0) + (j - CTXL);
            const float s = wave_sum(q * (float)P[(size_t)krow * NPAD + C_GK + kv * 64 + d]);
            const float v = (float)P[(size_t)krow * NPAD + C_GV + kv * 64 + d];
            const float mn = fmaxf(m, s), corr = fast_exp(m - mn), pe = fast_exp(s - mn);
            lsum = lsum * corr + pe; acc = acc * corr + pe * v; m = mn;
        }
        const float y = acc / lsum;
        GT[(size_t)row * 1024 + hq * 64 + d] = (f16)(y * siluf_((float)P[(size_t)row * NPAD + C_GZ + hq * 64 + d]));
    }
}
__device__ __forceinline__ void mla_naive(Frame& F, int l) {
    const f16* P = WSP(f16, WS_P); const f16* QM = WSP(f16, WS_QM); const f16* KVM = WSP(f16, WS_KVM);
    const float* cosT = WSP(float, WS_ROPE); const float* sinT = cosT + 2048 * 32;
    f16* GT = WSP(f16, WS_GATED) + (size_t)1 * MROWS * 1024;
    const int nrows = l == 0 ? MROWS : NLAT;
    const int d = F.lane, f = d & 31;
    const float scale = 0.07216878364870322f;
    for (int it = F.gw; it < nrows * 8; it += F.NGW) {
        const int row = it >> 3, h = it & 7;
        const bool lat = row < NLAT; const int b = lat ? row / SEQ : (row - NLAT) / CTXL, p = row & (SEQ - 1);
        const f16* qr = QM + (size_t)row * 1536 + h * 192;
        const float q0 = (float)qr[d] * scale, q1 = (float)qr[64 + d] * scale;
        const float t1 = (float)qr[128 + f], t2 = (float)qr[128 + 32 + f];
        float qp;
        if (lat) { const float c = cosT[p * 32 + f], s = sinT[p * 32 + f]; qp = d < 32 ? t1 * c - t2 * s : t1 * s + t2 * c; } else qp = d < 32 ? t1 : t2;
        qp *= scale;
        float m = -1e30f, lsum = 0.f, a0 = 0.f, a1 = 0.f;
        const int nkeys = CTXL + (lat ? SEQ : 0);
        for (int j = 0; j < nkeys; ++j) {
            const int krow = j < CTXL ? NLAT + b * CTXL + j : b * SEQ + (j - CTXL);
            const f16* kr = KVM + (size_t)krow * 2048 + h * 256;
            const float s = wave_sum(q0 * (float)kr[d] + q1 * (float)kr[64 + d] + qp * (float)P[(size_t)krow * NPAD + C_KPE + d]);
            const float v0 = (float)kr[128 + d], v1 = (float)kr[192 + d];
            const float mn = fmaxf(m, s), corr = fast_exp(m - mn), pe = fast_exp(s - mn);
            lsum = lsum * corr + pe; a0 = a0 * corr + pe * v0; a1 = a1 * corr + pe * v1; m = mn;
        }
        const float inv = 1.0f / lsum;
        const f16* zr = P + (size_t)row * NPAD + C_MZ + h * 128;
        GT[(size_t)row * 1024 + h * 128 + d] = (f16)(a0 * inv * siluf_((float)zr[d]));
        GT[(size_t)row * 1024 + h * 128 + 64 + d] = (f16)(a1 * inv * siluf_((float)zr[64 + d]));
    }
}
__device__ __forceinline__ void hyena_naive(Frame& F, int l) {
    const float* HW = (const float*)(F.ws + WS_SB); const float* HM = HW + (size_t)MROWS * 1024;
    f16* GT = WSP(f16, WS_GATED) + (size_t)3 * MROWS * 1024;
    const int nlat_items = NB * (SEQ / 8) * 16, nctx_items = (l == 0) ? NB * (CTXL / 8) * 16 : 0;
    for (int it = F.bid; it < nlat_items + nctx_items; it += F.G) {
        const bool isctx = it >= nlat_items; const int q = isctx ? it - nlat_items : it;
        const int n = isctx ? CTXL : SEQ, cg = q & 15, pb = (q >> 4) % (n / 8), b = (q >> 4) / (n / 8);
        const int i = pb * 8 + F.wave, c = cg * 64 + F.lane;
        const int row0 = isctx ? NLAT + b * CTXL : b * SEQ;
        const f16* hf = (const f16*)(F.ws + WS_HF + (size_t)l * HF_LAYER + (isctx ? HF_LAT : 0));
        float acc = 0.f;
#pragma unroll 4
        for (int j = 0; j < n; ++j) acc += (float)hf[(size_t)(n - (i - j)) * 1024 + c] * HW[(size_t)(row0 + j) * 1024 + c];
        const size_t o = (size_t)(row0 + i) * 1024 + c;
        GT[o] = (f16)(HM[o] * (acc + HW[o] * INP(I_HD, l, 1024)[c]));
    }
}

namespace att {
typedef short s16x4 __attribute__((ext_vector_type(4)));
__device__ __forceinline__ int crow(int r, int hi) { return (r & 3) + 8 * (r >> 2) + 4 * hi; }
#define ATT_SBAR() __builtin_amdgcn_sched_barrier(0)
__device__ __forceinline__ int v_rd_base(int lane) { return ((lane & 3) << 3) | (((lane >> 2) & 3) << 6) | (((lane >> 4) & 1) << 5) | (((lane >> 5) & 1) << 8); }
template <int OFF> __device__ __forceinline__ s16x4 tr_read(int vb) { s16x4 r; asm volatile("ds_read_b64_tr_b16 %0, %1 offset:%2" : "=&v"(r) : "v"(vb), "i"(OFF) : "memory"); return r; }

template <bool MLA> struct Cfg {
    static constexpr int DQK = MLA ? 192 : 64, DV = MLA ? 128 : 64, NCB = DV / 32, ND0 = DQK / 16;
    static constexpr int KROWB = DQK * 2 + 16, SHM_K = 64 * KROWB, SHM_V = 64 * DV * 2;
    static constexpr int OFF_V = 0, OFF_K = 2 * SHM_V, OFF_WS = 2 * SHM_V + 2 * SHM_K, OFF_Q = OFF_WS + 8 * 64 * 4, LDS_TOTAL = OFF_Q + (MLA ? 8 * 32 * 144 : 0);
    static constexpr int NREG = MLA ? 8 : 4;
};
template <int NCB> __device__ __forceinline__ int v_st(int k, int c) { const int kk = (k & ~0xC) | ((k & 4) << 1) | ((k & 8) >> 1); return ((kk >> 3) * NCB + (c >> 5)) * 512 + ((kk & 7) * 32 + (c & 31)) * 2; }

__device__ __forceinline__ void partialSM(f32x16& p0, f32x16& p1, float& m_reg, float& alpha, const float C, const float thr_raw) {
    float pmax = p0[0];
#pragma unroll
    for (int r = 1; r < 16; ++r) pmax = fmaxf(pmax, p0[r]);
#pragma unroll
    for (int r = 0; r < 16; ++r) pmax = fmaxf(pmax, p1[r]);
    { auto rr = __builtin_amdgcn_permlane32_swap(__float_as_uint(pmax), __float_as_uint(pmax), false, false); pmax = fmaxf(__uint_as_float(rr[0]), __uint_as_float(rr[1])); }
    float mn;
    if (__builtin_expect(__all(pmax - m_reg <= thr_raw), 1)) { mn = m_reg; alpha = 1.f; }
    else { mn = fmaxf(m_reg, pmax); alpha = __builtin_amdgcn_exp2f((m_reg - mn) * C); m_reg = mn; }
    const float mnC = -mn * C;
#pragma unroll
    for (int r = 0; r < 16; ++r) p0[r] = fmaf(p0[r], C, mnC);
#pragma unroll
    for (int r = 0; r < 16; ++r) p1[r] = fmaf(p1[r], C, mnC);
#pragma unroll
    for (int r = 0; r < 16; ++r) p0[r] = __builtin_amdgcn_exp2f(p0[r]);
}
__device__ __forceinline__ void finishSM(f32x16& p0, f32x16& p1, float alpha, float& l_reg, f16x8& pa0, f16x8& pa1, f16x8& pa2, f16x8& pa3) {
#pragma unroll
    for (int r = 0; r < 16; ++r) p1[r] = __builtin_amdgcn_exp2f(p1[r]);
    float ps = 0;
#pragma unroll
    for (int r = 0; r < 16; ++r) ps += p0[r];
#pragma unroll
    for (int r = 0; r < 16; ++r) ps += p1[r];
    { auto rr = __builtin_amdgcn_permlane32_swap(__float_as_uint(ps), __float_as_uint(ps), false, false); ps = __uint_as_float(rr[0]) + __uint_as_float(rr[1]); }
    l_reg = l_reg * alpha + ps;
#define ATT_PK4(P, BASE, OUT) do { unsigned a0 = pkh(P[BASE + 0], P[BASE + 1]), a1 = pkh(P[BASE + 2], P[BASE + 3]); \
    unsigned b0 = pkh(P[BASE + 4], P[BASE + 5]), b1 = pkh(P[BASE + 6], P[BASE + 7]); \
    auto r0 = __builtin_amdgcn_permlane32_swap(a0, b0, false, false); auto r1 = __builtin_amdgcn_permlane32_swap(a1, b1, false, false); \
    u32x4 w = {r0[0], r1[0], r0[1], r1[1]}; OUT = __builtin_bit_cast(f16x8, w); } while (0)
    ATT_PK4(p0, 0, pa0); ATT_PK4(p0, 8, pa1); ATT_PK4(p1, 0, pa2); ATT_PK4(p1, 8, pa3);
#undef ATT_PK4
}
template <int ND0, int NREG, int KROWB> __device__ __forceinline__ void qkt(f32x16& p0, f32x16& p1, const LAS char* Ks, const f16x8* qr, const LAS char* ql, int r32, int hi) {
    p0 = f32x16{}; p1 = f32x16{};
#pragma unroll
    for (int d0 = 0; d0 < ND0; ++d0) { const int cb = (d0 * 16 + hi * 8) * 2;
        const f16x8 b0 = *(const LAS f16x8*)(Ks + r32 * KROWB + cb);
        const f16x8 b1 = *(const LAS f16x8*)(Ks + (32 + r32) * KROWB + cb);
        f16x8 qf; if (d0 < NREG) qf = qr[d0 < NREG ? d0 : 0]; else qf = *(const LAS f16x8*)(ql + (d0 - NREG) * 32);
        p0 = __builtin_amdgcn_mfma_f32_32x32x16_f16(b0, qf, p0, 0, 0, 0);
        p1 = __builtin_amdgcn_mfma_f32_32x32x16_f16(b1, qf, p1, 0, 0, 0); }
}
template <int NCB, int D0> __device__ __forceinline__ void pv_one(f32x16& od, int vb, f16x8 pa0, f16x8 pa1, f16x8 pa2, f16x8 pa3) {
    constexpr int KS = 2 * NCB * 512, HF = NCB * 512, B0 = D0 * 512;
    const s16x4 l0 = tr_read<B0 + 0 * KS>(vb), h0 = tr_read<B0 + 0 * KS + HF>(vb), l1 = tr_read<B0 + 1 * KS>(vb), h1 = tr_read<B0 + 1 * KS + HF>(vb);
    const s16x4 l2 = tr_read<B0 + 2 * KS>(vb), h2 = tr_read<B0 + 2 * KS + HF>(vb), l3 = tr_read<B0 + 3 * KS>(vb), h3 = tr_read<B0 + 3 * KS + HF>(vb);
    asm volatile("s_waitcnt lgkmcnt(0)" ::: "memory"); ATT_SBAR();
#define ATT_PK(L, H) __builtin_bit_cast(f16x8, (short __attribute__((ext_vector_type(8)))){L[0], L[1], L[2], L[3], H[0], H[1], H[2], H[3]})
    od = __builtin_amdgcn_mfma_f32_32x32x16_f16(pa0, ATT_PK(l0, h0), od, 0, 0, 0);
    od = __builtin_amdgcn_mfma_f32_32x32x16_f16(pa1, ATT_PK(l1, h1), od, 0, 0, 0);
    od = __builtin_amdgcn_mfma_f32_32x32x16_f16(pa2, ATT_PK(l2, h2), od, 0, 0, 0);
    od = __builtin_amdgcn_mfma_f32_32x32x16_f16(pa3, ATT_PK(l3, h3), od, 0, 0, 0);
#undef ATT_PK
}
template <int NCB> __device__ __forceinline__ void pv_all(f32x16* o, int vb, f16x8 pa0, f16x8 pa1, f16x8 pa2, f16x8 pa3) {
    pv_one<NCB, 0>(o[0], vb, pa0, pa1, pa2, pa3); pv_one<NCB, 1>(o[1], vb, pa0, pa1, pa2, pa3);
    if constexpr (NCB == 4) { pv_one<NCB, 2>(o[2], vb, pa0, pa1, pa2, pa3); pv_one<NCB, 3>(o[3], vb, pa0, pa1, pa2, pa3); }
}

struct UnitDesc { int b, h, qb, isctx, hp; };
template <bool MLA>
__device__ __forceinline__ void attn_unit(Frame& F, const UnitDesc u, int l, LAS char* lds) {
    typedef Cfg<MLA> C_;
    constexpr int DQK = C_::DQK, DV = C_::DV, NCB = C_::NCB, ND0 = C_::ND0, KROWB = C_::KROWB, NREG = C_::NREG;
    const int tid = F.tid, wid = F.wave, lane = F.lane, r32 = lane & 31, hi = lane >> 5;
    TP_BEGIN(MLA ? 3 : 4);
    LAS char* V_lds = lds + C_::OFF_V; LAS char* K_lds = lds + C_::OFF_K;
    LAS float* ws = (LAS float*)(lds + C_::OFF_WS) + wid * 64; LAS float* li_l = ws; LAS float* al_l = ws + 32;
    const f16* P = WSP(f16, WS_P); const f16* KVM = WSP(f16, WS_KVM);
    const float scale = MLA ? 0.07216878364870322f : 0.125f, Cc = scale * 1.4426950408889634f, thr_raw = 8.0f / scale;
    int qrow0, qpos0, hq;
    if constexpr (MLA) { hq = u.h; qpos0 = u.qb * 256 + wid * 32; qrow0 = (u.isctx ? NLAT + u.b * CTXL : u.b * SEQ) + qpos0; }
    else { hq = u.h * 8 + u.hp * 2 + (wid >> 2); qpos0 = u.qb * 128 + (wid & 3) * 32; qrow0 = (u.isctx ? NLAT + u.b * CTXL : u.b * SEQ) + qpos0; }
    f16x8 qr[ND0];
    { const f16* Qw = MLA ? WSP(f16, WS_QM) + (size_t)(qrow0 + r32) * 1536 + hq * 192 + hi * 8 : P + (size_t)(qrow0 + r32) * NPAD + C_GQ + hq * 64 + hi * 8;
#pragma unroll
      for (int d0 = 0; d0 < ND0; ++d0) qr[d0] = *reinterpret_cast<const f16x8*>(Qw + d0 * 16);
      if (!u.isctx) {
          constexpr int R0 = ND0 - 4;
          const float* cosT = WSP(float, WS_ROPE) + (size_t)(qpos0 + r32) * 32; const float* sinT = cosT + 2048 * 32;
#pragma unroll
          for (int i = 0; i < 2; ++i) {
              const f32x4 c0 = *(const f32x4*)(cosT + 16 * i + 8 * hi), c1 = *(const f32x4*)(cosT + 16 * i + 8 * hi + 4);
              const f32x4 s0 = *(const f32x4*)(sinT + 16 * i + 8 * hi), s1 = *(const f32x4*)(sinT + 16 * i + 8 * hi + 4);
              f16x8 a = qr[R0 + i], b2 = qr[R0 + i + 2], oa, ob;
#pragma unroll
              for (int j = 0; j < 8; ++j) { const float cc = j < 4 ? c0[j] : c1[j - 4], ss = j < 4 ? s0[j] : s1[j - 4]; const float t1 = (float)a[j], t2 = (float)b2[j];
                  oa[j] = (f16)(t1 * cc - t2 * ss); ob[j] = (f16)(t1 * ss + t2 * cc); }
              qr[R0 + i] = oa; qr[R0 + i + 2] = ob; }
      } }
    const LAS char* ql = lds + C_::OFF_Q + wid * (32 * 144) + r32 * 144 + hi * 16;
    f16x8 qreg[NREG];
#pragma unroll
    for (int d0 = 0; d0 < NREG; ++d0) qreg[d0] = qr[d0];
    if constexpr (ND0 > NREG) { __syncthreads();
#pragma unroll
        for (int d0 = NREG; d0 < ND0; ++d0) *(LAS f16x8*)(lds + C_::OFF_Q + wid * (32 * 144) + r32 * 144 + hi * 16 + (d0 - NREG) * 32) = qr[d0]; }
    const int kstart = MLA ? 0 : max(0, 128 * (u.qb - 1));
    const int nlat_tiles = u.isctx ? 0 : (MLA ? 32 : ((u.qb == 0 || u.qb == 15) ? 4 : 6));
    const int NT = 4 + nlat_tiles;
    const int sk = tid >> 3, sj = tid & 7;
    const int ctxrow0 = NLAT + u.b * CTXL, latrow0 = u.b * SEQ + kstart;
#define ATT_KROW(t) ((t) < 4 ? ctxrow0 + 64 * (t) : latrow0 + 64 * ((t) - 4))
    u32x4 aK0, aK1, aK2, aV0, aV1, bK0, bK1, bK2, bV0, bV1;
#define ATT_LOAD(S, t) do { const int kr_ = ATT_KROW(t) + sk; \
      if constexpr (MLA) { const f16* kp_ = KVM + (size_t)kr_ * 2048 + u.h * 256 + sj * 8; \
          S##K0 = *(const u32x4*)kp_; S##K1 = *(const u32x4*)(kp_ + 64); S##K2 = *(const u32x4*)(P + (size_t)kr_ * NPAD + C_KPE + sj * 8); \
          S##V0 = *(const u32x4*)(kp_ + 128); S##V1 = *(const u32x4*)(kp_ + 192); } \
      else { S##K0 = *(const u32x4*)(P + (size_t)kr_ * NPAD + C_GK + u.h * 64 + sj * 8); S##V0 = *(const u32x4*)(P + (size_t)kr_ * NPAD + C_GV + u.h * 64 + sj * 8); } } while (0)
#define ATT_KWRITE(S, bf) do { LAS char* kb_ = K_lds + (bf) * C_::SHM_K + sk * KROWB + sj * 16; *(LAS u32x4*)kb_ = S##K0; \
      if constexpr (MLA) { *(LAS u32x4*)(kb_ + 128) = S##K1; *(LAS u32x4*)(kb_ + 256) = S##K2; } } while (0)
#define ATT_VWRITE(S, bf) do { LAS char* vb_ = V_lds + (bf) * C_::SHM_V; *(LAS u32x4*)(vb_ + v_st<NCB>(sk, sj * 8)) = S##V0; \
      if constexpr (MLA) { *(LAS u32x4*)(vb_ + v_st<NCB>(sk, 64 + sj * 8)) = S##V1; } } while (0)
#define ATT_RESC(a) do { if (__any((a) < 1.f)) { if (hi == 0) al_l[r32] = (a); asm volatile("s_waitcnt lgkmcnt(0)" ::: "memory"); \
      _Pragma("unroll") for (int d = 0; d < NCB; ++d) _Pragma("unroll") for (int r = 0; r < 16; ++r) o[d][r] *= al_l[crow(r, hi)]; } } while (0)
#define ATT_MASK(p0, p1, t) do { if constexpr (!MLA) { if ((t) >= 4) { const int kb_ = kstart + 64 * ((t) - 4) + 4 * hi - (qpos0 + r32); \
      if (kb_ < -128 || kb_ + 63 > 128) { _Pragma("unroll") for (int r = 0; r < 16; ++r) { const int dk = kb_ + (r & 3) + 8 * (r >> 2); \
          if (dk < -128 || dk > 128) p0[r] = -1e30f; if (dk + 32 < -128 || dk + 32 > 128) p1[r] = -1e30f; } } } } } while (0)
    const int vb0 = (int)(unsigned)(uintptr_t)V_lds + v_rd_base(lane);
    float m_reg = -1e30f, l_reg = 0.f, alA; f32x16 o[NCB];
#pragma unroll
    for (int d = 0; d < NCB; ++d) o[d] = f32x16{};
    f32x16 pA0, pA1; f16x8 pa0, pa1, pa2, pa3;
    __syncthreads();
    TP(1);
    ATT_LOAD(a, 0); ATT_KWRITE(a, 0); ATT_VWRITE(a, 0); __syncthreads();
    ATT_LOAD(a, 1); if (2 < NT) ATT_LOAD(b, 2);
#define ATT_STEP(t, bf, S) do { \
        TP(2); qkt<ND0, NREG, KROWB>(pA0, pA1, K_lds + (bf) * C_::SHM_K, qreg, ql, r32, hi); ATT_MASK(pA0, pA1, t); TP(3); \
        partialSM(pA0, pA1, m_reg, alA, Cc, thr_raw); \
        ATT_RESC(alA); \
        finishSM(pA0, pA1, alA, l_reg, pa0, pa1, pa2, pa3); ATT_SBAR(); TP(4); \
        if ((t) + 1 < NT) { ATT_KWRITE(S, (bf) ^ 1); } ATT_SBAR(); \
        pv_all<NCB>(o, vb0 + (bf) * C_::SHM_V, pa0, pa1, pa2, pa3); TP(5); \
        if ((t) + 1 < NT) { ATT_VWRITE(S, (bf) ^ 1); } \
        if ((t) + 3 < NT) { ATT_LOAD(S, (t) + 3); } \
        __syncthreads(); TP(6); } while (0)
#pragma unroll 1
    for (int t = 0; t < NT; t += 2) { ATT_STEP(t, 0, a); ATT_STEP(t + 1, 1, b); }
#undef ATT_STEP
    if constexpr (!MLA) l_reg += __builtin_amdgcn_exp2f(INP(I_GSINK, l, 16)[hq] * 1.4426950408889634f - m_reg * Cc);
    if (hi == 0) li_l[r32] = l_reg; asm volatile("s_waitcnt lgkmcnt(0)" ::: "memory");
    f16* GT = WSP(f16, WS_GATED) + (size_t)(MLA ? 1 : 2) * MROWS * 1024;
    const int zc = MLA ? C_MZ + hq * 128 : C_GZ + hq * 64, oc = MLA ? hq * 128 : hq * 64;
    LAS char* tile = lds + wid * (32 * DV * 2);
    constexpr int PPR = DV / 8;
    { u32x4 zt[DV / 16];
#pragma unroll
      for (int k = 0; k < DV / 16; ++k) { const int pc = lane + 64 * k, rw = pc / PPR, ck = pc % PPR; zt[k] = *(const u32x4*)(P + (size_t)(qrow0 + rw) * NPAD + zc + ck * 8); }
#pragma unroll
      for (int k = 0; k < DV / 16; ++k) { const int pc = lane + 64 * k, rw = pc / PPR, ck = pc % PPR; *(LAS u32x4*)(tile + rw * (DV * 2) + ck * 16) = zt[k]; } }
    f16 zr_[16][NCB];
#pragma unroll
    for (int r = 0; r < 16; ++r)
#pragma unroll
        for (int d0 = 0; d0 < NCB; ++d0) zr_[r][d0] = *(const LAS f16*)(tile + crow(r, hi) * (DV * 2) + (d0 * 32 + r32) * 2);
#pragma unroll
    for (int r = 0; r < 16; ++r) { const float rl = __builtin_amdgcn_rcpf(li_l[crow(r, hi)]);
#pragma unroll
        for (int d0 = 0; d0 < NCB; ++d0) *(LAS unsigned short*)(tile + crow(r, hi) * (DV * 2) + (d0 * 32 + r32) * 2) = (unsigned short)pkb(o[d0][r] * rl * siluf_((float)zr_[r][d0]), 0.f); }
#pragma unroll
    for (int k = 0; k < DV / 16; ++k) { const int pc = lane + 64 * k, rw = pc / PPR, ck = pc % PPR;
        *(u32x4*)(GT + (size_t)(qrow0 + rw) * 1024 + oc + ck * 8) = *(const LAS u32x4*)(tile + rw * (DV * 2) + ck * 16); }
    TP(7); if (!u.isctx) TP_END();
#undef ATT_KROW
#undef ATT_LOAD
#undef ATT_KWRITE
#undef ATT_VWRITE
#undef ATT_RESC
#undef ATT_MASK
}
#undef ATT_SBAR
}

__device__ __forceinline__ void mla_phase(Frame& F, int l) {
    const int nunits = 256 + (l == 0 ? 32 : 0);
    for (int it = F.bid; it < nunits; it += F.G) {
        att::UnitDesc u;
        if (it < 256) { u.b = it >> 6; u.h = (it >> 3) & 7; u.qb = it & 7; u.isctx = 0; } else { const int q = it - 256; u.b = q >> 3; u.h = q & 7; u.qb = 0; u.isctx = 1; }
        u.hp = 0;
        att::attn_unit<true>(F, u, l, (LAS char*)F.lds);
    }
}
__device__ __forceinline__ void gqa_phase(Frame& F, int l) {
    const int nunits = 512 + (l == 0 ? 64 : 0);
    for (int it = F.bid; it < nunits; it += F.G) {
        att::UnitDesc u;
        if (it < 512) { u.b = it >> 7; u.h = (it >> 6) & 1; u.qb = (it >> 2) & 15; u.hp = it & 3; u.isctx = 0; }
        else { const int q = it - 512; u.b = q >> 4; u.h = (q >> 3) & 1; u.qb = (q >> 2) & 1; u.hp = q & 3; u.isctx = 1; }
        att::attn_unit<false>(F, u, l, (LAS char*)F.lds);
    }
}

#ifndef HY_PROBE
#define HY_PROBE 0
#endif
namespace hy {
constexpr int FREG = 8448;
constexpr int WBLK = 80;
constexpr int WREG = 65 * WBLK;
constexpr int OFF_F = 0, OFF_W = 8 * FREG, OFF_CW = OFF_W + 8 * WREG, LDS_TOTAL = OFF_CW + 512;
static_assert(LDS_TOTAL <= RING_BYTES, "hyena LDS");

__device__ __forceinline__ const f16* pcp(const f16* PC, int col, int row) { return PC + ((size_t)pc_chunk(col) * MROWS + row) * 8; }
__device__ __forceinline__ void load8(const f16* p, float (&o)[8]) { const f16x8 v = *(const f16x8*)p;
#pragma unroll
    for (int j = 0; j < 8; ++j) o[j] = (float)v[j]; }

__device__ __forceinline__ void conv8(const f16* P, int row0, int i, int n, int col, const LAS float* cw, int t, float (&o)[8]) {
    float a[8], b[8], c[8];
    load8(pcp(P, col, row0 + i), b);
    if (i > 0) load8(pcp(P, col, row0 + i - 1), a); else {
#pragma unroll
        for (int j = 0; j < 8; ++j) a[j] = 0.f; }
    if (i < n - 1) load8(pcp(P, col, row0 + i + 1), c); else {
#pragma unroll
        for (int j = 0; j < 8; ++j) c[j] = 0.f; }
#pragma unroll
    for (int j = 0; j < 8; ++j) o[j] = cw[(t * 4 + 0) * 8 + j] * a[j] + cw[(t * 4 + 1) * 8 + j] * b[j] + cw[(t * 4 + 2) * 8 + j] * c[j] + cw[(t * 4 + 3) * 8 + j];
}

struct Raw3 { f16x8 a, b, c; };
__device__ __forceinline__ Raw3 load3(const f16* P, int row0, int i, int n, int col) {
    Raw3 r; const f16x8 z = {0, 0, 0, 0, 0, 0, 0, 0};
    const f16* p = pcp(P, col, row0 + i);
    r.b = *(const f16x8*)p;
    r.a = i > 0 ? *(const f16x8*)(p - 8) : z;
    r.c = i < n - 1 ? *(const f16x8*)(p + 8) : z;
    return r;
}
__device__ __forceinline__ void conv3x8(const Raw3& r, const LAS float* cw, int t, float (&o)[8]) {
#pragma unroll
    for (int j = 0; j < 8; ++j) o[j] = cw[(t * 4 + 0) * 8 + j] * (float)r.a[j] + cw[(t * 4 + 1) * 8 + j] * (float)r.b[j] + cw[(t * 4 + 2) * 8 + j] * (float)r.c[j] + cw[(t * 4 + 3) * 8 + j];
}
__device__ __forceinline__ void hyena_unit(Frame& F, int l, int b, int isctx, int cg) {
    const int tid = F.tid, lane = F.lane, wid = F.wave;
    const int n = isctx ? CTXL : SEQ, nblk = n / 32, c0 = cg * 8;
    const int row0 = isctx ? NLAT + b * CTXL : b * SEQ;
    const f16* P = WSP(f16, WS_PC);
    LAS char* lds = (LAS char*)F.lds;
    LAS float* cw = (LAS float*)(lds + OFF_CW);
    TP_BEGIN(2);
    for (int rp_ = 0; rp_ < (HY_PROBE == 1 ? 2 : 1); ++rp_) {
    __syncthreads();
    if (tid < 96) { const int t = tid / 32, q = (tid % 32) / 8, j = tid & 7; const int ch = t * 1024 + c0 + j;
        cw[(t * 4 + q) * 8 + j] = q < 3 ? INP(I_HCW, l, 3 * 3072)[q * 3072 + ch] : INP(I_HCB, l, 3072)[ch]; }
    { const f16* hf = (const f16*)(F.ws + WS_HF + (size_t)l * HF_LAYER + (isctx ? HF_LAT : 0)) + (size_t)cg * (2 * n) * 8;
      if (!isctx) { f16x8 v[8];
#pragma unroll
          for (int q = 0; q < 8; ++q) v[q] = *(const f16x8*)(hf + (size_t)(tid + q * NTHREADS) * 8);
#pragma unroll
          for (int q = 0; q < 8; ++q)
#pragma unroll
              for (int j = 0; j < 8; ++j) *(LAS f16*)(lds + OFF_F + j * FREG + (tid + q * NTHREADS) * 2) = v[q][j]; }
      else { const f16x8 v = *(const f16x8*)(hf + (size_t)tid * 8);
#pragma unroll
          for (int j = 0; j < 8; ++j) *(LAS f16*)(lds + OFF_F + j * FREG + tid * 2) = v[j]; } }
    if (tid < 8 * 5) { const int j = tid / 5, q = tid % 5; *(LAS u32x4*)(lds + OFF_W + j * WREG + nblk * WBLK + q * 16) = (u32x4){0u, 0u, 0u, 0u}; }
    __syncthreads();
    TP(1);
    if (!isctx) { Raw3 r1[4], r2[4];
#pragma unroll
        for (int q = 0; q < 4; ++q) { r1[q] = load3(P, row0, tid + q * NTHREADS, n, C_HXV + 1024 + c0); r2[q] = load3(P, row0, tid + q * NTHREADS, n, C_HXV + 2048 + c0); }
#pragma unroll
        for (int q = 0; q < 4; ++q) { const int i = tid + q * NTHREADS; float x1[8], vv[8]; conv3x8(r1[q], cw, 1, x1); conv3x8(r2[q], cw, 2, vv);
#pragma unroll
            for (int j = 0; j < 8; ++j) *(LAS f16*)(lds + OFF_W + j * WREG + (i >> 5) * WBLK + (i & 31) * 2) = (f16)(x1[j] * vv[j]); } }
    else if (tid < n) { const int i = tid; float x1[8], vv[8];
        conv8(P, row0, i, n, C_HXV + 1024 + c0, cw, 1, x1); conv8(P, row0, i, n, C_HXV + 2048 + c0, cw, 2, vv);
#pragma unroll
        for (int j = 0; j < 8; ++j) *(LAS f16*)(lds + OFF_W + j * WREG + (i >> 5) * WBLK + (i & 31) * 2) = (f16)(x1[j] * vv[j]); }
    __syncthreads();
    }
    TP(2);
    f32x16 acc0 = f32x16{}, acc1 = f32x16{};
    for (int rp_ = 0; rp_ < (HY_PROBE == 2 ? 2 : 1); ++rp_) {
        if (rp_) { acc0 = f32x16{}; acc1 = f32x16{}; asm volatile("" : "+v"(acc0), "+v"(acc1)); }
        const int r = lane & 31, half = lane >> 5;
        const LAS char* fb = lds + OFF_F + wid * FREG; const LAS char* wb = lds + OFF_W + wid * WREG;
        struct Fr { unsigned d0, d1, d2, d3, d4, e0, e1, e2, e3, e4, sh; f16x8 b00, b01, b10, b11; };
#define HY_LOAD(FR, dd, T0, T1) do { const int y0_ = n - 32 * (dd) - r + 8 * half; FR.sh = (unsigned)(y0_ & 1) << 4; \
            const LAS unsigned* fp_ = (const LAS unsigned*)(fb + ((y0_ >> 1) << 2)); \
            FR.d0 = fp_[0]; FR.d1 = fp_[1]; FR.d2 = fp_[2]; FR.d3 = fp_[3]; FR.d4 = fp_[4]; FR.e0 = fp_[8]; FR.e1 = fp_[9]; FR.e2 = fp_[10]; FR.e3 = fp_[11]; FR.e4 = fp_[12]; \
            if (T0) { int blk_ = r - (dd); blk_ = (blk_ >= 0 && blk_ < nblk) ? blk_ : nblk; const LAS char* bp_ = wb + blk_ * WBLK + 16 * half; FR.b00 = *(const LAS f16x8*)bp_; FR.b01 = *(const LAS f16x8*)(bp_ + 32); } \
            if (T1) { int blk_ = 32 + r - (dd); blk_ = (blk_ >= 0 && blk_ < nblk) ? blk_ : nblk; const LAS char* bp_ = wb + blk_ * WBLK + 16 * half; FR.b10 = *(const LAS f16x8*)bp_; FR.b11 = *(const LAS f16x8*)(bp_ + 32); } } while (0)
#define HY_MMA(FR, T0, T1) do { u32x4 a0w_, a1w_; \
            a0w_[0] = __builtin_amdgcn_alignbit(FR.d1, FR.d0, FR.sh); a0w_[1] = __builtin_amdgcn_alignbit(FR.d2, FR.d1, FR.sh); a0w_[2] = __builtin_amdgcn_alignbit(FR.d3, FR.d2, FR.sh); a0w_[3] = __builtin_amdgcn_alignbit(FR.d4, FR.d3, FR.sh); \
            a1w_[0] = __builtin_amdgcn_alignbit(FR.e1, FR.e0, FR.sh); a1w_[1] = __builtin_amdgcn_alignbit(FR.e2, FR.e1, FR.sh); a1w_[2] = __builtin_amdgcn_alignbit(FR.e3, FR.e2, FR.sh); a1w_[3] = __builtin_amdgcn_alignbit(FR.e4, FR.e3, FR.sh); \
            const f16x8 A0_ = __builtin_bit_cast(f16x8, a0w_), A1_ = __builtin_bit_cast(f16x8, a1w_); \
            __builtin_amdgcn_s_setprio(1); \
            if (T0 && T1) { acc0 = __builtin_amdgcn_mfma_f32_32x32x16_f16(A0_, FR.b00, acc0, 0, 0, 0); acc1 = __builtin_amdgcn_mfma_f32_32x32x16_f16(A0_, FR.b10, acc1, 0, 0, 0);        \
                            acc0 = __builtin_amdgcn_mfma_f32_32x32x16_f16(A1_, FR.b01, acc0, 0, 0, 0); acc1 = __builtin_amdgcn_mfma_f32_32x32x16_f16(A1_, FR.b11, acc1, 0, 0, 0); } \
            else if (T0) { acc0 = __builtin_amdgcn_mfma_f32_32x32x16_f16(A0_, FR.b00, acc0, 0, 0, 0); acc0 = __builtin_amdgcn_mfma_f32_32x32x16_f16(A1_, FR.b01, acc0, 0, 0, 0); } \
            else if (T1) { acc1 = __builtin_amdgcn_mfma_f32_32x32x16_f16(A0_, FR.b10, acc1, 0, 0, 0); acc1 = __builtin_amdgcn_mfma_f32_32x32x16_f16(A1_, FR.b11, acc1, 0, 0, 0); } \
            __builtin_amdgcn_s_setprio(0); } while (0)
#define HY_RANGE(lo, hi, T0, T1) do { if ((lo) <= (hi)) { Fr fa_, fb2_, fc_; HY_LOAD(fa_, (lo), T0, T1); if ((lo) + 1 <= (hi)) HY_LOAD(fb2_, (lo) + 1, T0, T1); \
            _Pragma("unroll 1") for (int dd = (lo); dd <= (hi); dd += 3) { \
                if (dd + 2 <= (hi)) HY_LOAD(fc_, dd + 2, T0, T1); \
                HY_MMA(fa_, T0, T1); \
                if (dd + 1 <= (hi)) { if (dd + 3 <= (hi)) HY_LOAD(fa_, dd + 3, T0, T1); HY_MMA(fb2_, T0, T1); \
                    if (dd + 2 <= (hi)) { if (dd + 4 <= (hi)) HY_LOAD(fb2_, dd + 4, T0, T1); HY_MMA(fc_, T0, T1); } } } } } while (0)
        const int ntile = nblk > 32 ? 2 : 1;
        if (ntile == 2) { HY_RANGE(-(nblk - 1), -32, true, false); HY_RANGE(-31, 31, true, true); HY_RANGE(32, nblk - 1, false, true); }
        else { HY_RANGE(-(nblk - 1), nblk - 1, true, false); }
#undef HY_LOAD
#undef HY_MMA
#undef HY_RANGE
        TP(3);
        asm volatile("s_waitcnt lgkmcnt(0)" ::: "memory");
        LAS float* yo = (LAS float*)(lds + OFF_F + wid * FREG);
#pragma unroll
        for (int q = 0; q < 16; ++q) { const int rr = (q & 3) + 8 * (q >> 2) + 4 * half;
            if (r < nblk) yo[(32 * r + rr) + r] = acc0[q];
            if (ntile == 2) yo[(32 * (32 + r) + rr) + (32 + r)] = acc1[q]; }
    }
    __syncthreads();
    TP(4);
    for (int rp_ = 0; rp_ < (HY_PROBE == 3 ? 2 : 1); ++rp_) {
        f16* GT = WSP(f16, WS_GATED) + (size_t)3 * MROWS * 1024;
        const float* dsk = INP(I_HD, l, 1024) + c0;
        const int nq = isctx ? 1 : 4;
        Raw3 r0[4]; f16x8 zr[4];
        const f32x4 dk0 = *(const f32x4*)dsk, dk1 = *(const f32x4*)(dsk + 4);
#pragma unroll
        for (int q = 0; q < 4; ++q) if (q < nq && tid + q * NTHREADS < n) { r0[q] = load3(P, row0, tid + q * NTHREADS, n, C_HXV + c0); zr[q] = *(const f16x8*)pcp(P, C_HZ + c0, row0 + tid + q * NTHREADS); }
#pragma unroll
        for (int q = 0; q < 4; ++q) if (q < nq && tid + q * NTHREADS < n) { const int i = tid + q * NTHREADS;
            float x0[8]; conv3x8(r0[q], cw, 0, x0);
            f32x4 o0, o1;
#pragma unroll
            for (int j = 0; j < 8; ++j) {
                const float y = *(const LAS float*)(lds + OFF_F + j * FREG + (i + (i >> 5)) * 4);
                const float w = (float)*(const LAS f16*)(lds + OFF_W + j * WREG + (i >> 5) * WBLK + (i & 31) * 2);
                const float o = x0[j] * siluf_((float)zr[q][j]) * (y + w * (j < 4 ? dk0[j & 3] : dk1[j & 3]));
                if (j < 4) o0[j] = o; else o1[j - 4] = o; }
            *(u32x4*)(GT + (size_t)(row0 + i) * 1024 + c0) = pkb8(o0, o1);
        }
    }
    TP(5); if (!isctx) TP_END();
}
}
__device__ __forceinline__ void hyena_phase(Frame& F, int l) {
    const int nunits = 512 + (l == 0 ? 512 : 0);
    for (int it = F.bid; it < nunits; it += F.G) {
        const int isctx = it >= 512, q = it & 511;
        hy::hyena_unit(F, l, q >> 7, isctx, q & 127);
    }
}

namespace ssd {
using att::s16x4; using att::tr_read; using att::v_st; using att::v_rd_base; using att::crow;
constexpr size_t L_ELEMS = (size_t)64 * 128;
__device__ __forceinline__ size_t state_index(int b, int sc, int h, int dir) { return ((((size_t)b * 18 + sc) * 16 + h) * 2 + dir) * L_ELEMS; }
constexpr int TAB_OFF = 0;
constexpr int CW_OFF = 16384;
constexpr int END_OFF = CW_OFF + 12288;
constexpr int SSQ_OFF = END_OFF + 64;
constexpr int BM_OFF = 29824;
constexpr int XS_OFF = BM_OFF + 34816;
constexpr int LDS_TOTAL = XS_OFF + 65536;
static_assert(LDS_TOTAL <= RING_BYTES, "ssd LDS");
constexpr int KROWB = 272;

struct Unit { int b, sc, g, row0, n, i0; };
__device__ __forceinline__ Unit make_unit(int b, int sc, int g) { Unit u; u.b = b; u.sc = sc; u.g = g;
    if (sc < 2) { u.row0 = NLAT + b * CTXL; u.n = CTXL; u.i0 = sc * 128; } else { u.row0 = b * SEQ; u.n = SEQ; u.i0 = (sc - 2) * 128; } return u; }

__device__ __forceinline__ void stage_common(Frame& F, const Unit& u, int l, LAS char* lds) {
    const f16* P = WSP(f16, WS_PC);
    LAS float* cw = (LAS float*)(lds + CW_OFF);
    { const float* scw = INP(I_SCW, l, 3 * 1536); const float* scb = INP(I_SCB, l, 1536);
      float cv[6];
#pragma unroll
      for (int k = 0; k < 6; ++k) { const int i = F.tid + k * NTHREADS, q = i / 768, c = i % 768;
          const int ch = c < 512 ? u.g * 512 + c : (c < 640 ? 1024 + u.g * 128 + (c - 512) : 1280 + u.g * 128 + (c - 640));
          const float* src = q < 3 ? scw + q * 1536 + ch : scb + ch; cv[k] = *src; }
#pragma unroll
      for (int k = 0; k < 6; ++k) cw[F.tid + k * NTHREADS] = cv[k]; }
    { const int h = u.g * 8 + F.wave, lane = F.lane;
      const float af = -expf(INP(I_SALOG, l, 32)[h]), ab = -expf(INP(I_SALOG, l, 32)[16 + h]);
      const float bf = INP(I_SDTB, l, 32)[h], bb = INP(I_SDTB, l, 32)[16 + h];
      const f16* pf = hy::pcp(P, C_DT + (h & ~7), u.row0 + u.i0 + 2 * lane) + (h & 7); const f16* pb = hy::pcp(P, C_DT + 16 + (h & ~7), u.row0 + u.i0 + 2 * lane) + (h & 7);
      unsigned rf0 = *(const unsigned short*)pf, rf1 = *(const unsigned short*)(pf + 8), rb0 = *(const unsigned short*)pb, rb1 = *(const unsigned short*)(pb + 8);
      asm volatile("" : "+v"(rf0), "+v"(rf1), "+v"(rb0), "+v"(rb1));
      const float xf0 = (float)__builtin_bit_cast(f16, (unsigned short)rf0), xf1 = (float)__builtin_bit_cast(f16, (unsigned short)rf1), xb0 = (float)__builtin_bit_cast(f16, (unsigned short)rb0), xb1 = (float)__builtin_bit_cast(f16, (unsigned short)rb1);
      const float dtf0 = softplusf_(xf0 + bf), dtf1 = softplusf_(xf1 + bf);
      const float dtb0 = softplusf_(xb0 + bb), dtb1 = softplusf_(xb1 + bb);
      const float laf0 = dtf0 * af, laf1 = dtf1 * af, lab0 = dtb0 * ab, lab1 = dtb1 * ab;
      float sf = laf0 + laf1, sb = lab0 + lab1;
#pragma unroll
      for (int o = 1; o < 64; o <<= 1) { const float tf = __shfl_up(sf, o), tb = __shfl_up(sb, o); if (lane >= o) { sf += tf; sb += tb; } }
      const float totb = __shfl(sb, 63), totf = __shfl(sf, 63);
      const float exf = sf - (laf0 + laf1), exb = sb - (lab0 + lab1);
      LAS f32x4* tab = (LAS f32x4*)(lds + TAB_OFF) + F.wave * 128;
      tab[2 * lane] = (f32x4){exf + laf0, totb - exb, dtf0, dtb0};
      tab[2 * lane + 1] = (f32x4){sf, totb - sb + lab1, dtf1, dtb1};
      if (lane == 0) { LAS float* en = (LAS float*)(lds + END_OFF) + F.wave * 2; en[0] = totf; en[1] = totb; } }
}
__device__ __forceinline__ hy::Raw3 xbc_load3(const f16* P, const Unit& u, int i, int cl) {
    const int col = C_XBC + (cl < 512 ? u.g * 512 + cl : (cl < 640 ? 1024 + u.g * 128 + (cl - 512) : 1280 + u.g * 128 + (cl - 640)));
    return hy::load3(P, u.row0, u.i0 + i, u.n, col);
}
__device__ __forceinline__ u32x4 conv_silu_pack(const hy::Raw3& r, int cl, const LAS float* cw) {
    float o[8];
#pragma unroll
    for (int j = 0; j < 8; ++j) o[j] = siluf_(cw[cl + j] * (float)r.a[j] + cw[768 + cl + j] * (float)r.b[j] + cw[1536 + cl + j] * (float)r.c[j] + cw[2304 + cl + j]);
    u32x4 w; w.x = pkh(o[0], o[1]); w.y = pkh(o[2], o[3]); w.z = pkh(o[4], o[5]); w.w = pkh(o[6], o[7]); return w;
}
__device__ __forceinline__ u32x4 pack8(const float (&o)[8]) { u32x4 w; w.x = pkh(o[0], o[1]); w.y = pkh(o[2], o[3]); w.z = pkh(o[4], o[5]); w.w = pkh(o[6], o[7]); return w; }
__device__ __forceinline__ void stage_x(Frame& F, const Unit& u, int hq, LAS char* lds) {
    const f16* P = WSP(f16, WS_PC); const LAS float* cw = (const LAS float*)(lds + CW_OFF);
#pragma unroll 1
    for (int k0 = 0; k0 < 8; k0 += 4) {
        hy::Raw3 r[4];
#pragma unroll
        for (int k = 0; k < 4; ++k) { const int e = F.tid + (k0 + k) * NTHREADS, i = e >> 5, q = e & 31; r[k] = xbc_load3(P, u, i, (hq * 4 + (q >> 3)) * 64 + (q & 7) * 8); }
#pragma unroll
        for (int k = 0; k < 4; ++k) { const int e = F.tid + (k0 + k) * NTHREADS, i = e >> 5, q = e & 31, hh = q >> 3, ck = q & 7;
            *(LAS u32x4*)(lds + XS_OFF + hh * 16384 + v_st<2>(i, ck * 8)) = conv_silu_pack(r[k], (hq * 4 + hh) * 64 + ck * 8, cw); } }
}
#define SSD_FRAG(L, H) __builtin_bit_cast(f16x8, (short __attribute__((ext_vector_type(8)))){L[0], L[1], L[2], L[3], H[0], H[1], H[2], H[3]})

__device__ __forceinline__ void s1_unit(Frame& F, const Unit u, int l) {
    LAS char* lds = (LAS char*)F.lds; const f16* P = WSP(f16, WS_PC);
    const int lane = F.lane, wid = F.wave, r32 = lane & 31, hi = lane >> 5;
    __syncthreads();
    stage_common(F, u, l, lds);
    __syncthreads();
    { const LAS float* cw = (const LAS float*)(lds + CW_OFF);
      hy::Raw3 r[4];
#pragma unroll
      for (int k = 0; k < 4; ++k) { const int e = F.tid + k * NTHREADS; r[k] = xbc_load3(P, u, e >> 4, 512 + (e & 15) * 8); }
#pragma unroll
      for (int k = 0; k < 4; ++k) { const int e = F.tid + k * NTHREADS, i = e >> 4, ck = e & 15;
          *(LAS u32x4*)(lds + BM_OFF + v_st<4>(i, ck * 8)) = conv_silu_pack(r[k], 512 + ck * 8, cw); } }
    if (F.tid < 16) { const int hh = F.tid >> 1, dir = F.tid & 1; const LAS float* en = (const LAS float*)(lds + END_OFF) + hh * 2;
        WSP(float, WS_DEC)[(((size_t)u.b * 18 + u.sc) * 16 + u.g * 8 + hh) * 2 + dir] = expf(en[dir]); }
#pragma unroll 1
    for (int hq = 0; hq < 2; ++hq) {
        __syncthreads();
        stage_x(F, u, hq, lds);
        __syncthreads();
        const int hh = hq * 4 + (wid >> 1), dir = wid & 1;
        const LAS f32x4* tab = (const LAS f32x4*)(lds + TAB_OFF) + hh * 128;
        const float cend = ((const LAS float*)(lds + END_OFF))[hh * 2 + dir];
        const int xb = (int)(unsigned)(uintptr_t)(lds + XS_OFF + (wid >> 1) * 16384) + v_rd_base(lane);
        const int bb = (int)(unsigned)(uintptr_t)(lds + BM_OFF) + v_rd_base(lane);
        f32x16 acc[2][4];
#pragma unroll
        for (int a = 0; a < 2; ++a)
#pragma unroll
            for (int c = 0; c < 4; ++c) acc[a][c] = f32x16{};
#define SSD_S1_STEP(KS) do { \
            f16x8 wv; { _Pragma("unroll") for (int j = 0; j < 8; ++j) { const f32x4 t = tab[(KS) * 16 + 8 * hi + j]; wv[j] = (f16)(fast_exp(cend - (dir ? t[1] : t[0])) * (dir ? t[3] : t[2])); } } \
            const s16x4 xl0 = tr_read<0 * 512 + (KS) * 2048>(xb), xh0 = tr_read<0 * 512 + (KS) * 2048 + 1024>(xb), xl1 = tr_read<1 * 512 + (KS) * 2048>(xb), xh1 = tr_read<1 * 512 + (KS) * 2048 + 1024>(xb); \
            const s16x4 bl0 = tr_read<0 * 512 + (KS) * 4096>(bb), bh0 = tr_read<0 * 512 + (KS) * 4096 + 2048>(bb), bl1 = tr_read<1 * 512 + (KS) * 4096>(bb), bh1 = tr_read<1 * 512 + (KS) * 4096 + 2048>(bb); \
            const s16x4 bl2 = tr_read<2 * 512 + (KS) * 4096>(bb), bh2 = tr_read<2 * 512 + (KS) * 4096 + 2048>(bb), bl3 = tr_read<3 * 512 + (KS) * 4096>(bb), bh3 = tr_read<3 * 512 + (KS) * 4096 + 2048>(bb); \
            asm volatile("s_waitcnt lgkmcnt(0)" ::: "memory"); __builtin_amdgcn_sched_barrier(0); \
            const f16x8 A0 = SSD_FRAG(xl0, xh0) * wv, A1 = SSD_FRAG(xl1, xh1) * wv; \
            const f16x8 B0 = SSD_FRAG(bl0, bh0), B1 = SSD_FRAG(bl1, bh1), B2 = SSD_FRAG(bl2, bh2), B3 = SSD_FRAG(bl3, bh3); \
            __builtin_amdgcn_s_setprio(1); \
            acc[0][0] = __builtin_amdgcn_mfma_f32_32x32x16_f16(A0, B0, acc[0][0], 0, 0, 0); acc[0][1] = __builtin_amdgcn_mfma_f32_32x32x16_f16(A0, B1, acc[0][1], 0, 0, 0); \
            acc[0][2] = __builtin_amdgcn_mfma_f32_32x32x16_f16(A0, B2, acc[0][2], 0, 0, 0); acc[0][3] = __builtin_amdgcn_mfma_f32_32x32x16_f16(A0, B3, acc[0][3], 0, 0, 0); \
            acc[1][0] = __builtin_amdgcn_mfma_f32_32x32x16_f16(A1, B0, acc[1][0], 0, 0, 0); acc[1][1] = __builtin_amdgcn_mfma_f32_32x32x16_f16(A1, B1, acc[1][1], 0, 0, 0); \
            acc[1][2] = __builtin_amdgcn_mfma_f32_32x32x16_f16(A1, B2, acc[1][2], 0, 0, 0); acc[1][3] = __builtin_amdgcn_mfma_f32_32x32x16_f16(A1, B3, acc[1][3], 0, 0, 0); __builtin_amdgcn_s_setprio(0); } while (0)
        SSD_S1_STEP(0); SSD_S1_STEP(1); SSD_S1_STEP(2); SSD_S1_STEP(3); SSD_S1_STEP(4); SSD_S1_STEP(5); SSD_S1_STEP(6); SSD_S1_STEP(7);
#undef SSD_S1_STEP
        float* Lo = (float*)(F.ws + WS_SA) + state_index(u.b, u.sc, u.g * 8 + hh, dir);
#pragma unroll
        for (int a = 0; a < 2; ++a)
#pragma unroll
            for (int r = 0; r < 16; ++r) { const int p = 32 * a + crow(r, hi);
#pragma unroll
                for (int c = 0; c < 4; ++c) Lo[(size_t)p * 128 + 32 * c + r32] = acc[a][c][r]; }
    }
}
__device__ __forceinline__ void s1_phase(Frame& F, int l) {
    for (int it = F.bid; it < 4 * 18 * 2; it += F.G) { const int b = it / 36, q = it % 36; F.lane = lane_id_opaque(); F.tid = F.wave * 64 + F.lane; s1_unit(F, make_unit(b, q >> 1, q & 1), l); }
}
__device__ __forceinline__ void s2_piece(Frame& F, int piece) {
    const float* Lb = (const float*)(F.ws + WS_SA); f16* Sp = (f16*)(F.ws + WS_SC); const float* DEC = WSP(float, WS_DEC);
    { const int e = piece * NTHREADS + F.tid;
        const int q8 = e & 1023, dir = (e >> 10) & 1, h = (e >> 11) & 15, b = e >> 15;
        f32x4 s0 = {0.f, 0.f, 0.f, 0.f}, s1 = {0.f, 0.f, 0.f, 0.f};
#pragma unroll 1
        for (int k0 = 0; k0 < 18; k0 += 6) {
            f32x4 la[6], lb[6]; float dd[6];
#pragma unroll
            for (int j = 0; j < 6; ++j) { const int k = k0 + j, sc = dir == 0 ? k : (k < 2 ? 1 - k : 19 - k);
                const size_t off = state_index(b, sc, h, dir) + (size_t)q8 * 8;
                dd[j] = DEC[(((size_t)b * 18 + sc) * 16 + h) * 2 + dir]; la[j] = *(const f32x4*)(Lb + off); lb[j] = *(const f32x4*)(Lb + off + 4); }
#pragma unroll
            for (int j = 0; j < 6; ++j) { const int k = k0 + j, sc = dir == 0 ? k : (k < 2 ? 1 - k : 19 - k);
                const size_t off = state_index(b, sc, h, dir) + (size_t)q8 * 8;
                *(u32x4*)(Sp + off) = pkh8(s0, s1);
                s0 = s0 * dd[j] + la[j]; s1 = s1 * dd[j] + lb[j]; }
        }
    }
}
__device__ __forceinline__ void s3_unit(Frame& F, const Unit u, int l) {
    LAS char* lds = (LAS char*)F.lds; const f16* P = WSP(f16, WS_PC);
    TP_BEGIN(1);
    const int lane = F.lane, wid = F.wave, r32 = lane & 31, hi = lane >> 5, li = wid & 3;
    __syncthreads();
    stage_common(F, u, l, lds);
    __syncthreads(); TP(1);
    { const LAS float* cw = (const LAS float*)(lds + CW_OFF);
      hy::Raw3 r[8];
#pragma unroll
      for (int k = 0; k < 8; ++k) { const int e = F.tid + k * NTHREADS, q = e & 31; r[k] = xbc_load3(P, u, e >> 5, 512 + (q >> 4) * 128 + (q & 15) * 8); }
#pragma unroll
      for (int k = 0; k < 8; ++k) { const int e = F.tid + k * NTHREADS, i = e >> 5, q = e & 31, isc = q >> 4, ck = q & 15;
          *(LAS u32x4*)(lds + (isc ? XS_OFF : BM_OFF) + i * KROWB + ck * 16) = conv_silu_pack(r[k], 512 + isc * 128 + ck * 8, cw); } }
    if (F.tid < 256) ((LAS float*)(lds + SSQ_OFF))[F.tid] = 0.f;
    __syncthreads();
    f16x8 qr[8];
#pragma unroll
    for (int d0 = 0; d0 < 8; ++d0) qr[d0] = *(const LAS f16x8*)(lds + XS_OFF + (li * 32 + r32) * KROWB + (d0 * 16 + hi * 8) * 2);
    f32x16 gt[4];
#pragma unroll
    for (int st = 0; st < 4; ++st) { gt[st] = f32x16{};
#pragma unroll
        for (int d0 = 0; d0 < 8; ++d0) { const f16x8 bf = *(const LAS f16x8*)(lds + BM_OFF + (st * 32 + r32) * KROWB + (d0 * 16 + hi * 8) * 2);
            gt[st] = __builtin_amdgcn_mfma_f32_32x32x16_f16(bf, qr[d0], gt[st], 0, 0, 0); } }
    TP(2);
    const int lrow = li * 32 + r32;
    float ssacc[16];
#pragma unroll
    for (int r = 0; r < 16; ++r) ssacc[r] = 0.f;
    f16* GT = WSP(f16, WS_GATED);
    const f16* Sp = (const f16*)(F.ws + WS_SC);
#pragma unroll 1
    for (int hq = 0; hq < 2; ++hq) {
        __syncthreads();
        stage_x(F, u, hq, lds);
        __syncthreads(); TP(3);
#pragma unroll 1
        for (int e2 = 0; e2 < 2; ++e2) {
            const int hx = (wid >> 2) * 2 + e2, hh = hq * 4 + hx, h = u.g * 8 + hh;
            const LAS f32x4* tab = (const LAS f32x4*)(lds + TAB_OFF) + hh * 128;
            const int lane = lane_id_opaque(), r32 = lane & 31, hi = lane >> 5; const int lrow_ = li * 32 + r32;
            const f32x4 tl = tab[lrow_];
            f16x8 pa[8];
#define SSD_W(ST, R) ({ const int s_ = 32 * (ST) + (R & 3) + 8 * (R >> 2) + 4 * hi; const f32x4 ts_ = tab[s_]; \
                const float arg_ = s_ < lrow_ ? tl[0] - ts_[0] : (s_ > lrow_ ? tl[1] - ts_[1] : 0.f); \
                const float mul_ = s_ < lrow_ ? ts_[2] : (s_ > lrow_ ? ts_[3] : ts_[2] + ts_[3]); \
                gt[ST][R] * fast_exp(arg_) * mul_; })
#define SSD_PK4(ST, BASE, OUT) do { const unsigned a0 = pkh(SSD_W(ST, BASE + 0), SSD_W(ST, BASE + 1)), a1 = pkh(SSD_W(ST, BASE + 2), SSD_W(ST, BASE + 3)); \
                const unsigned b0 = pkh(SSD_W(ST, BASE + 4), SSD_W(ST, BASE + 5)), b1 = pkh(SSD_W(ST, BASE + 6), SSD_W(ST, BASE + 7)); \
                auto r0 = __builtin_amdgcn_permlane32_swap(a0, b0, false, false); auto r1 = __builtin_amdgcn_permlane32_swap(a1, b1, false, false); \
                u32x4 w = {r0[0], r1[0], r0[1], r1[1]}; OUT = __builtin_bit_cast(f16x8, w); } while (0)
#define SB_ __builtin_amdgcn_sched_barrier(0)
            SB_; SSD_PK4(0, 0, pa[0]); SB_; SSD_PK4(0, 8, pa[1]); SB_; SSD_PK4(1, 0, pa[2]); SB_; SSD_PK4(1, 8, pa[3]); SB_;
            SSD_PK4(2, 0, pa[4]); SB_; SSD_PK4(2, 8, pa[5]); SB_; SSD_PK4(3, 0, pa[6]); SB_; SSD_PK4(3, 8, pa[7]); SB_;
#undef SB_
#undef SSD_PK4
#undef SSD_W
            TP(4);
            f32x16 o[2] = {f32x16{}, f32x16{}};
            const int xb = (int)(unsigned)(uintptr_t)(lds + XS_OFF + hx * 16384) + v_rd_base(lane);
#define SSD_PV(KS) do { const s16x4 l0 = tr_read<(KS) * 2048>(xb), h0 = tr_read<(KS) * 2048 + 1024>(xb), l1 = tr_read<512 + (KS) * 2048>(xb), h1 = tr_read<512 + (KS) * 2048 + 1024>(xb); \
                asm volatile("s_waitcnt lgkmcnt(0)" ::: "memory"); __builtin_amdgcn_sched_barrier(0); \
                __builtin_amdgcn_s_setprio(1); o[0] = __builtin_amdgcn_mfma_f32_32x32x16_f16(pa[KS], SSD_FRAG(l0, h0), o[0], 0, 0, 0); o[1] = __builtin_amdgcn_mfma_f32_32x32x16_f16(pa[KS], SSD_FRAG(l1, h1), o[1], 0, 0, 0); __builtin_amdgcn_s_setprio(0); } while (0)
            SSD_PV(0); SSD_PV(1); SSD_PV(2); SSD_PV(3); SSD_PV(4); SSD_PV(5); SSD_PV(6); SSD_PV(7);
#undef SSD_PV
            TP(5);
            { const f16 ef = (f16)fast_exp(tl[0]), eb = (f16)fast_exp(tl[1]);
              const f16* sf = Sp + state_index(u.b, u.sc, h, 0) + (size_t)r32 * 128 + hi * 8; const f16* sb = sf + L_ELEMS;
#define SSD_LD(D0, S) do { S[0] = *(const f16x8*)(sf + (D0) * 16); S[1] = *(const f16x8*)(sf + 32 * 128 + (D0) * 16); S[2] = *(const f16x8*)(sb + (D0) * 16); S[3] = *(const f16x8*)(sb + 32 * 128 + (D0) * 16); } while (0)
#define SSD_ST(D0, S) do { const f16x8 af = qr[D0] * ef, ab = qr[D0] * eb; \
                  o[0] = __builtin_amdgcn_mfma_f32_32x32x16_f16(af, S[0], o[0], 0, 0, 0); o[1] = __builtin_amdgcn_mfma_f32_32x32x16_f16(af, S[1], o[1], 0, 0, 0); \
                  o[0] = __builtin_amdgcn_mfma_f32_32x32x16_f16(ab, S[2], o[0], 0, 0, 0); o[1] = __builtin_amdgcn_mfma_f32_32x32x16_f16(ab, S[3], o[1], 0, 0, 0); } while (0)
              f16x8 s0[4], s1[4];
              __builtin_amdgcn_sched_barrier(0);
              SSD_LD(0, s0); SSD_LD(1, s1); __builtin_amdgcn_sched_barrier(0);
              SSD_ST(0, s0); __builtin_amdgcn_sched_barrier(0); SSD_LD(2, s0); __builtin_amdgcn_sched_barrier(0);
              SSD_ST(1, s1); __builtin_amdgcn_sched_barrier(0); SSD_LD(3, s1); __builtin_amdgcn_sched_barrier(0);
              SSD_ST(2, s0); __builtin_amdgcn_sched_barrier(0); SSD_LD(4, s0); __builtin_amdgcn_sched_barrier(0);
              SSD_ST(3, s1); __builtin_amdgcn_sched_barrier(0); SSD_LD(5, s1); __builtin_amdgcn_sched_barrier(0);
              SSD_ST(4, s0); __builtin_amdgcn_sched_barrier(0); SSD_LD(6, s0); __builtin_amdgcn_sched_barrier(0);
              SSD_ST(5, s1); __builtin_amdgcn_sched_barrier(0); SSD_LD(7, s1); __builtin_amdgcn_sched_barrier(0);
              SSD_ST(6, s0); __builtin_amdgcn_sched_barrier(0); SSD_ST(7, s1); __builtin_amdgcn_sched_barrier(0);
#undef SSD_LD
#undef SSD_ST
            }
            TP(6);
            const float dsk = INP(I_SD, l, 16)[h];
            LAS char* tile = lds + BM_OFF + wid * 4096;
            { u32x4 zt[4];
#pragma unroll
              for (int k = 0; k < 4; ++k) { const int ck = lane >> 5, rw = lane & 31;
                  zt[k] = *(const u32x4*)hy::pcp(P, C_SZ + h * 64 + (2 * k + ck) * 8, u.row0 + u.i0 + li * 32 + rw); }
#pragma unroll
              for (int k = 0; k < 4; ++k) { const int ck = lane >> 5, rw = lane & 31; *(LAS u32x4*)(tile + rw * 128 + (2 * k + ck) * 16) = zt[k]; } }
            f16 zr_[16][2], xr_[16][2];
#pragma unroll
            for (int r = 0; r < 16; ++r)
#pragma unroll
                for (int pt = 0; pt < 2; ++pt) { const int p = 32 * pt + r32, lr = li * 32 + crow(r, hi);
                    zr_[r][pt] = *(const LAS f16*)(tile + crow(r, hi) * 128 + p * 2);
                    xr_[r][pt] = *(const LAS f16*)(lds + XS_OFF + hx * 16384 + v_st<2>(lr, p & ~7) + (p & 7) * 2); }
#pragma unroll
            for (int r = 0; r < 16; ++r)
#pragma unroll
                for (int pt = 0; pt < 2; ++pt) { const int p = 32 * pt + r32;
                    const float gv = (o[pt][r] + (float)xr_[r][pt] * dsk) * siluf_((float)zr_[r][pt]);
                    *(LAS unsigned short*)(tile + crow(r, hi) * 128 + p * 2) = (unsigned short)pkb(gv, 0.f); ssacc[r] += gv * gv; }
#pragma unroll
            for (int k = 0; k < 4; ++k) { const int pc = lane + 64 * k, rw = pc >> 3, ck = pc & 7;
                *(u32x4*)(GT + (size_t)(u.row0 + u.i0 + li * 32 + rw) * 1024 + h * 64 + ck * 8) = *(const LAS u32x4*)(tile + rw * 128 + ck * 16); }
            TP(7);
        }
    }
#pragma unroll
    for (int r = 0; r < 16; ++r) { float v = ssacc[r];
#pragma unroll
        for (int o = 1; o < 32; o <<= 1) v += __shfl_xor(v, o);
        if (r32 == 0) ((LAS float*)(lds + SSQ_OFF))[(wid >> 2) * 128 + li * 32 + crow(r, hi)] = v; }
    asm volatile("s_waitcnt vmcnt(0)" ::: "memory");
    __syncthreads();
    { const LAS float* sq = (const LAS float*)(lds + SSQ_OFF);
      u32x4 v[16];
#pragma unroll
      for (int k = 0; k < 16; ++k) { const int e = F.tid + k * NTHREADS; v[k] = *(const u32x4*)(GT + (size_t)(u.row0 + u.i0 + (e >> 6)) * 1024 + u.g * 512 + (e & 63) * 8); }
#pragma unroll
      for (int k = 0; k < 16; ++k) { const int e = F.tid + k * NTHREADS, i = e >> 6, ck = e & 63;
          const float rs = 1.0f / sqrtf((sq[i] + sq[128 + i]) * (1.f / 512.f) + LN_EPS);
          u32x4 w;
#pragma unroll
          for (int j = 0; j < 4; ++j) w[j] = pkb(bf_lo(v[k][j]) * rs, bf_hi(v[k][j]) * rs);
          *(u32x4*)(GT + (size_t)(u.row0 + u.i0 + i) * 1024 + u.g * 512 + ck * 8) = w; } }
    TP(8); TP_END();
}
__device__ __forceinline__ void s3_phase(Frame& F, int l) {
    const int nsc = l == 0 ? 18 : 16, sc0 = l == 0 ? 0 : 2;
    for (int it = F.bid; it < 4 * nsc * 2; it += F.G) { const int b = it / (nsc * 2), q = it % (nsc * 2); F.lane = lane_id_opaque(); F.tid = F.wave * 64 + F.lane; s3_unit(F, make_unit(b, sc0 + (q >> 1), q & 1), l); }
}
#undef SSD_FRAG
}

#ifndef USE_MFMA_GQA
#define USE_MFMA_GQA 1
#endif
#ifndef USE_MFMA_MLA
#define USE_MFMA_MLA 1
#endif
#ifndef USE_MFMA_HY
#define USE_MFMA_HY 1
#endif
#ifndef STAG_TICKS
#define STAG_TICKS 0
#endif
#ifndef STAG_IN
#define STAG_IN 0
#endif
#ifndef DUP
#define DUP 0
#endif
#define REP(k) for (int rep_ = 0; rep_ < ((DUP == (k)) ? 2 : 1); ++rep_)
#ifndef MK_ONE_LAUNCH
#define MK_ONE_LAUNCH 1
#endif
constexpr int PH_PER_LAYER = 7, N_PHASES = 2 + PH_PER_LAYER * DEPTH;
constexpr int CW_BAR = 4096;

__device__ __forceinline__ int opaque_zero() { int v = 0; asm volatile("" : "+v"(v)); return __builtin_amdgcn_readfirstlane(v); }
__device__ __forceinline__ unsigned long long opaque_u64(unsigned long long x) { unsigned lo = (unsigned)x, hi = (unsigned)(x >> 32); asm volatile("" : "+v"(lo), "+v"(hi));
    lo = __builtin_amdgcn_readfirstlane(lo); hi = __builtin_amdgcn_readfirstlane(hi); return ((unsigned long long)hi << 32) | lo; }
__device__ __forceinline__ int dq_next(Frame& F, int qid) {
    LAS int* slot = (LAS int*)(F.lds + MISC_OFF + 64);
    __syncthreads();
    if (F.tid == 0) *slot = (int)__hip_atomic_fetch_add((unsigned*)(F.ws + WS_CTL) + 8192 + 64 * qid, 1u, __ATOMIC_RELAXED, __HIP_MEMORY_SCOPE_AGENT);
    __syncthreads();
    return *slot;
}
__device__ __forceinline__ void mix2_phase(Frame& F, int l) {
    const int nh0 = F.G == 256 ? 112 : 0;
    const int nhl = 512 - nh0, ngl = 0, ngc = 0, nhc = l == 0 ? 512 : 0, ns2 = 256;
    const int total = nhl + ngl + ngc + nhc + ns2;
    for (;;) {
        int it = dq_next(F, l * 4 + 0); if (it >= total) break;
        F.lane = lane_id_opaque(); F.tid = F.wave * 64 + F.lane;
        if (it < nhl) { const int j = it + nh0; hy::hyena_unit(F, l, j >> 7, 0, j & 127); continue; } it -= nhl;
        if (it < ngl) { att::UnitDesc u; u.b = it >> 7; u.h = (it >> 6) & 1; u.qb = (it >> 2) & 15; u.hp = it & 3; u.isctx = 0; att::attn_unit<false>(F, u, l, (LAS char*)F.lds); continue; } it -= ngl;
        if (it < ngc) { att::UnitDesc u; u.b = it >> 4; u.h = (it >> 3) & 1; u.qb = (it >> 2) & 1; u.hp = it & 3; u.isctx = 1; att::attn_unit<false>(F, u, l, (LAS char*)F.lds); continue; } it -= ngc;
        if (it < nhc) { hy::hyena_unit(F, l, it >> 7, 1, it & 127); continue; } it -= nhc;
        ssd::s2_piece(F, it);
    }
}
__device__ __forceinline__ void mix3_phase(Frame& F, int l) {
    const int nsc = l == 0 ? 18 : 16, sc0 = l == 0 ? 0 : 2, n3 = 4 * nsc * 2, nml = 256, nmc = l == 0 ? 32 : 0, ngl = 512, ngc = l == 0 ? 64 : 0;
    const int total = n3 + nml + nmc + ngl + ngc;
    for (;;) {
        int it = dq_next(F, l * 4 + 1); if (it >= total) break;
        F.lane = lane_id_opaque(); F.tid = F.wave * 64 + F.lane;
        if (it < n3) { const int b = it / (nsc * 2), q = it % (nsc * 2); ssd::s3_unit(F, ssd::make_unit(b, sc0 + (q >> 1), q & 1), l); continue; } it -= n3;
        att::UnitDesc u; u.hp = 0;
        if (it < nml + nmc) {
            if (it < nml) { u.b = it >> 6; u.h = (it >> 3) & 7; u.qb = it & 7; u.isctx = 0; } else { const int q = it - nml; u.b = q >> 3; u.h = q & 7; u.qb = 0; u.isctx = 1; }
            att::attn_unit<true>(F, u, l, (LAS char*)F.lds); continue; }
        it -= nml + nmc;
        if (it < ngl) { u.b = it >> 7; u.h = (it >> 6) & 1; u.qb = (it >> 2) & 15; u.hp = it & 3; u.isctx = 0; }
        else { const int q = it - ngl; u.b = q >> 4; u.h = (q >> 3) & 1; u.qb = (q >> 2) & 1; u.hp = q & 3; u.isctx = 1; }
        att::attn_unit<false>(F, u, l, (LAS char*)F.lds);
    }
}
__global__ void __launch_bounds__(NTHREADS, 2) fwd_kernel(Args args) {
    extern __shared__ __attribute__((aligned(16))) unsigned char lds_raw[];
    Frame F;
    F.lds = (LAS unsigned char*)lds_raw; F.ws = args.ws; F.in = args.in; F.out = args.out;
    F.wave = __builtin_amdgcn_readfirstlane((int)threadIdx.x >> 6); F.lane = lane_id_opaque(); F.tid = F.wave * 64 + F.lane;
    F.G = gridDim.x; F.bid = blockIdx.x; F.gw = F.bid * NWAVES + F.wave; F.NGW = F.G * NWAVES; F.zin = 0;
    volatile LAS unsigned* MISC = (volatile LAS unsigned*)(F.lds + MISC_OFF);
    for (int u = F.tid; u < (LDS_BYTES - LDSCTL_OFF) / 4; u += NTHREADS) ((LAS unsigned*)(F.lds + LDSCTL_OFF))[u] = 0u;
    __syncthreads();
    XcdBarrier bar; bar.bar = (unsigned*)(F.ws + WS_CTL) + CW_BAR; bar.x = 0; bar.st = nullptr;
    if (MK_ONE_LAUNCH) bar = xcd_barrier_post((unsigned*)(F.ws + WS_CTL) + CW_BAR, MISC + 8);
    const int lo = args.ph_lo, hi = args.ph_hi;
#define IN_PH(k) (lo <= (k) && (k) < hi)
#define FENCE() do { const int z_ = opaque_zero(); F.lane = lane_id_opaque(); F.tid = F.wave * 64 + F.lane; F.ws += z_; F.zin = z_; } while (0)
#ifdef PHPROBE
    unsigned long long tph_prev = __builtin_amdgcn_s_memrealtime(), tph_val = 0;
#define SEAM(k) do { if (IN_PH(k) && IN_PH((k) + 1)) xcd_barrier(bar); { const unsigned long long n_ = __builtin_amdgcn_s_memrealtime(); if ((k) == PHPROBE) tph_val = n_ - tph_prev; tph_prev = n_; } } while (0)
#else
#define SEAM(k) do { if (IN_PH(k) && IN_PH((k) + 1)) xcd_barrier(bar); } while (0)
#endif

    if (IN_PH(0)) { FENCE(); pa_weights(F); if (DUP == 20) { FENCE(); pa_weights(F); } FENCE(); pa_mod(F); FENCE(); pa_rope(F); FENCE(); pa_filters(F); __syncthreads(); } SEAM(0);
    if (IN_PH(1)) { FENCE(); pb_w8(F); FENCE(); filter_gemm(F); FENCE(); prologue_b(F); } SEAM(1);
#define LAYER_BODY(LL) { constexpr int l = LL; constexpr int base = 2 + PH_PER_LAYER * l; constexpr int mrows = (l == DEPTH - 1) ? NLAT : MROWS; \
        if (IN_PH(base + 0)) { FENCE(); \
            if (STAG_IN > 0) { const int grp = (F.bid >> 3) & 3; \
                if (grp) { const unsigned long long t0 = __builtin_amdgcn_s_memrealtime(); while (__builtin_amdgcn_s_memrealtime() - t0 < (unsigned long long)(grp * STAG_IN)) __builtin_amdgcn_s_sleep(16); } } \
            { typedef pg8::Shape<NGATE, DM / 2, DM / 2, DM / 2, 1, 0, 0, 2> SH8;       \
              pg8::Gemm g8{(const f16*)(F.ws + WS_H8), (const f16*)(F.ws + ws_w8(l))}; \
              pg8::GateOrderL0 S8; S8.init(mrows, F.G, F.bid); \
              EpiGate E8{F.ws + WS_G, WSP(float, WS_HS), WSP(float, WS_CS) + (size_t)l * NGATE}; \
              pg8::gemm_phase<SH8, EpiGate>(F.lds, g8, S8, E8, F.wave); } \
            FENCE(); \
            typedef pg8::Shape<NPAD, DM, DM, DM, 1, 0, 0, IN_BF16 ? 1 : 0> SH; \
            pg8::Gemm g{WSP(f16, WS_H), WSP(f16, WS_WTIN) + (size_t)l * NTOT * DM}; \
            EpiInProj E{WSP(f16, WS_P), WSP(f16, WS_G), WSP(f16, WS_PC)}; \
            if (l == DEPTH - 1) { pg8::POrderL1 S; S.init(NLAT, F.G, F.bid); pg8::gemm_phase<SH, EpiInProj>(F.lds, g, S, E, F.wave); } \
            else { pg8::StaticOrder<NPAD / 256, 1> S; S.init(MROWS, F.G, (F.bid + F.G / 2) % F.G);   \
                   pg8::gemm_phase<SH, EpiInProj>(F.lds, g, S, E, F.wave); } } \
        SEAM(base + 0); \
        if (IN_PH(base + 1)) { FENCE(); prep_naive(F, l); FENCE(); ssd::s1_phase(F, l); \
            if (F.G == 256 && F.bid >= 144) { FENCE(); hy::hyena_unit(F, l, (F.bid - 144) >> 7, 0, (F.bid - 144) & 127); } }   \
        SEAM(base + 1); \
        if (IN_PH(base + 2)) { FENCE(); \
            { typedef pg8::Shape<1536, 512, NPAD, 512, 1, 0, 0> SH; \
              pg8::Gemm g{WSP(f16, WS_P) + C_CQ, WSP(f16, WS_WTUQ) + (size_t)l * 1536 * 512}; \
                \
              pg8::StaticOrder<6, 1> S; if (F.G == 256) S.init(mrows, 112, F.bid - 144); else S.init(mrows, F.G, F.bid); \
              EpiRowScale E{WSP(f16, WS_QM), 1536, WSP(float, WS_RS)}; \
              if (F.G != 256 || F.bid >= 144) pg8::gemm_phase<SH, EpiRowScale>(F.lds, g, S, E, F.wave); } \
            FENCE(); \
            { typedef pg8::Shape<2048, 256, NPAD, 256, 1, 0, 0> SH; \
              pg8::Gemm g{WSP(f16, WS_P) + C_CKV, WSP(f16, WS_WTUKV) + (size_t)l * 2048 * 256}; \
              pg8::StaticOrder<8, 1> S; if (F.G == 256) S.init(MROWS, 112, (F.bid - 144 + 56) % 112); else S.init(MROWS, F.G, (F.bid + 128) % F.G); \
              EpiRowScale E{WSP(f16, WS_KVM), 2048, WSP(float, WS_RS) + MROWS}; \
              if (F.G != 256 || F.bid >= 144) pg8::gemm_phase<SH, EpiRowScale>(F.lds, g, S, E, F.wave); } \
            FENCE(); mix2_phase(F, l); } \
        SEAM(base + 2); \
        if (IN_PH(base + 3)) { FENCE(); mix3_phase(F, l); } \
        SEAM(base + 3); \
        if (IN_PH(base + 4)) { FENCE(); \
            if (STAG_TICKS > 0) { const int grp = (F.bid >> 3) & 3;        \
                if (grp) { const unsigned long long t0 = __builtin_amdgcn_s_memrealtime(); while (__builtin_amdgcn_s_memrealtime() - t0 < (unsigned long long)(grp * STAG_TICKS)) __builtin_amdgcn_s_sleep(16); } } \
            typedef pg8::Shape<DM, 1024, 1024, 1024, 4, (long)MROWS * 1024, (long)DM * 1024, 1> SH;     \
            pg8::Gemm g{WSP(f16, WS_GATED), WSP(f16, WS_WTBR) + (size_t)l * 4 * DM * 1024}; \
            pg8::StaticOrder<8, 4> S; S.init(NLAT, F.G, F.bid); \
            EpiMerge E{F.ws + WS_G, WSP(f16, WS_MIX)}; \
            pg8::gemm_phase<SH, EpiMerge>(F.lds, g, S, E, F.wave); \
            if (l == 0) { FENCE(); pg8::TailOrder T; T.init(F.G, F.bid, 0, 128); \
                EpiMergeSlab EA{F.ws + WS_G, (f16*)(F.ws + WS_SA)}; \
                pg8::gemm_phase<SH, EpiMergeSlab>(F.lds, g, T, EA, F.wave); \
                if (MK_ONE_LAUNCH) xcd_barrier(bar);               \
                FENCE(); merge_ctx_reduce(F); } } \
        SEAM(base + 4); \
        if (IN_PH(base + 5)) { FENCE(); \
            typedef pg8::Shape<DM, DM, DM, DM, 1, 0, 0, 1> SH;     \
            pg8::Gemm g{WSP(f16, WS_MIX), WSP(f16, WS_WTOUT) + (size_t)l * DM * DM}; \
            pg8::StaticOrder<8, 1> S; S.init(NLAT, F.G, F.bid); \
            EpiOut<(l > 0)> E{l == 0 ? (const void*)F.in[F.zin + I_X] : (const void*)WSP(f16, WS_X1), l == 0 ? (const void*)F.in[F.zin + I_CTX] : (const void*)(WSP(f16, WS_X1) + (size_t)NLAT * DM), WSP(float, WS_MOD) + (size_t)l * 5 * 6144, WSP(f16, WS_Y) + (size_t)MROWS * DM}; \
            pg8::gemm_phase<SH, EpiOut<(l > 0)> >(F.lds, g, S, E, F.wave); \
            if (l == 0) { FENCE(); typedef pg8::Shape<DM, 512, DM, DM, 4, 512, 512, 1> SHQ; pg8::TailOrder T; T.init(F.G, F.bid, 128, 128); \
                EpiOutSlab EA{WSP(float, WS_MOD) + (size_t)l * 5 * 6144, (f16*)(F.ws + WS_SA) + (size_t)4 * NCTX * DM}; \
                pg8::gemm_phase<SHQ, EpiOutSlab>(F.lds, g, T, EA, F.wave); } } \
        SEAM(base + 5); \
        if (IN_PH(base + 6)) { FENCE(); ln_phase(F, l); if (DUP == 9) { FENCE(); ln_phase(F, l); } } \
        SEAM(base + 6); }
    LAYER_BODY(0)
    LAYER_BODY(1)
#undef LAYER_BODY
#ifdef PHPROBE
    xcd_barrier(bar);
    if (F.bid == 0 && F.tid == 0) F.out[0] += ((float)tph_val * 0.01f - (float)PHBASE) * 0.125f;
#endif
#ifdef TPROBE
    xcd_barrier(bar);
    if (F.bid == 0 && F.tid == 0) { const unsigned* tm = (const unsigned*)(F.ws + WS_CTL) + 32768; const float us = (float)__hip_atomic_load(tm, __ATOMIC_RELAXED, __HIP_MEMORY_SCOPE_AGENT) * 0.01f / (float)__hip_atomic_load(tm + 15, __ATOMIC_RELAXED, __HIP_MEMORY_SCOPE_AGENT); F.out[0] += us * 0.125f; }
#endif
#undef IN_PH
#undef SEAM
}

extern "C" void kernel_launch(void* const* d_in, const int* in_sizes, int n_in, void* d_out, int out_size, void* d_ws, size_t ws_size, hipStream_t stream) {
    static int grid = 0;
    if (grid == 0) {
        if (n_in != N_IN || out_size != NLAT * DM || ws_size < WS_END) { fprintf(stderr, "kernel_launch: unexpected shapes: n_in %d out %d ws %zu (need %zu)\n", n_in, out_size, ws_size, (size_t)WS_END); grid = -1; return; }
        int dev = 0, cus = 0, per_cu = 0;
        if (hipGetDevice(&dev) != hipSuccess || hipDeviceGetAttribute(&cus, hipDeviceAttributeMultiprocessorCount, dev) != hipSuccess) { grid = -1; return; }
        if (hipFuncSetAttribute((const void*)fwd_kernel, hipFuncAttributeMaxDynamicSharedMemorySize, LDS_BYTES) != hipSuccess) { fprintf(stderr, "kernel_launch: hipFuncSetAttribute failed\n"); grid = -1; return; }
        if (hipOccupancyMaxActiveBlocksPerMultiprocessor(&per_cu, (const void*)fwd_kernel, NTHREADS, LDS_BYTES) != hipSuccess || per_cu < 1) { fprintf(stderr, "kernel_launch: occupancy query says %d blocks per CU\n", per_cu); (void)hipGetLastError(); grid = -1; return; }
        grid = cus;
    }
    if (grid < 0) return;
    (void)hipMemsetAsync((char*)d_ws + WS_CTL, 0, CTL_BYTES, stream);
    Args a{};
    for (int i = 0; i < N_IN; ++i) a.in[i] = (const float*)d_in[i];
    a.out = (float*)d_out; a.ws = (unsigned char*)d_ws;
#if MK_ONE_LAUNCH
    a.ph_lo = 0; a.ph_hi = N_PHASES;
    hipLaunchKernelGGL(fwd_kernel, dim3(grid), dim3(NTHREADS), LDS_BYTES, stream, a);
#else
    for (int ph = 0; ph < N_PHASES; ++ph) { a.ph_lo = ph; a.ph_hi = ph + 1; hipLaunchKernelGGL(fwd_kernel, dim3(grid), dim3(NTHREADS), LDS_BYTES, stream, a); }
#endif
}
```

```cpp
#ifndef USE_MFMA_GQA
#define USE_MFMA_GQA 1
#endif
#ifndef USE_MFMA_MLA
#define USE_MFMA_MLA 1
#endif
#ifndef USE_MFMA_HY
#define USE_MFMA_HY 1
#endif
#ifndef USE_MFMA_SSD
#define USE_MFMA_SSD 1
#endif
#ifndef IN_BF16
#define IN_BF16 1
#endif
#include <hip/hip_runtime.h>
#include <cstdio>
#include <cstdint>
#include <cmath>

constexpr int DM = 2048, NB = 4, SEQ = 2048, CTXL = 256, DEPTH = 2;
constexpr int NLAT = NB * SEQ;
constexpr int NCTX = NB * CTXL;
constexpr int MROWS = NLAT + NCTX;
constexpr int INW = 19040;
constexpr int NPAD = 11008;
constexpr int NGATE = 8192;
constexpr int NTOT = NPAD + NGATE;
constexpr int NPT = NPAD / 256;
constexpr int C_SZ = 0, C_XBC = 1024, C_DT = 2560, C_CQ = 2592, C_CKV = 3104, C_KPE = 3360, C_MZ = 3424, C_GQ = 4448,
              C_GK = 5472, C_GV = 5600, C_GZ = 5728, C_HXV = 6752, C_HZ = 9824, C_MERGE = 10848;
constexpr float LN_EPS = 1e-6f;
constexpr float DN_ALPHA = 1.4142135623730951f;

enum { I_X = 0, I_C, I_CTX, I_CCTX, I_WADA, I_BADA, I_WIN, I_SCW, I_SCB, I_SDTB, I_SALOG, I_SD, I_SNW, I_MQN, I_MWUQ, I_MKVN, I_MWUKV,
       I_GSINK, I_HCW, I_HCB, I_HW1, I_HB1, I_HW2, I_HB2, I_HW3, I_HFREQ, I_HD, I_WBR, I_WOUT, I_LNG, I_LNB, N_IN };

constexpr size_t al256(size_t x) { return (x + 255) & ~(size_t)255; }
constexpr size_t WS_CTL = 0, CTL_BYTES = 1u << 20;
constexpr size_t WS_WTIN = CTL_BYTES;
constexpr size_t WS_WTUQ = WS_WTIN + (size_t)2 * NTOT * DM * 2;
constexpr size_t WS_WTUKV = WS_WTUQ + (size_t)2 * 1536 * 512 * 2;
constexpr size_t WS_WTBR = WS_WTUKV + (size_t)2 * 2048 * 256 * 2;
constexpr size_t WS_WTOUT = WS_WTBR + (size_t)2 * 4 * 2048 * 1024 * 2;
constexpr size_t WS_MOD = WS_WTOUT + (size_t)2 * 2048 * 2048 * 2;
constexpr size_t WS_ROPE = al256(WS_MOD + (size_t)2 * 5 * 6144 * 4);
constexpr size_t WS_HF = al256(WS_ROPE + (size_t)2 * 2048 * 32 * 4);
constexpr size_t HF_LAT = (size_t)4096 * 1024 * 2, HF_CTX = (size_t)512 * 1024 * 2, HF_LAYER = HF_LAT + HF_CTX;
constexpr size_t WS_HD2 = al256(WS_HF + 2 * HF_LAYER);
constexpr size_t WS_H = al256(WS_HD2 + (size_t)2 * 2304 * 64 * 2);
constexpr size_t WS_P = WS_H + (size_t)MROWS * DM * 2;
constexpr size_t WS_G = WS_P + (size_t)MROWS * NPAD * 2;
constexpr size_t WS_RS = WS_G + (size_t)MROWS * NGATE * 2;
constexpr size_t WS_DEC = WS_RS + (size_t)2 * MROWS * 4;
constexpr size_t WS_QM = al256(WS_DEC + (size_t)4 * 18 * 16 * 2 * 4);
constexpr size_t WS_KVM = WS_QM + (size_t)MROWS * 1536 * 2;
constexpr size_t WS_GATED = WS_KVM + (size_t)MROWS * 2048 * 2;
constexpr size_t WS_MIX = WS_GATED + (size_t)4 * MROWS * 1024 * 2;
constexpr size_t WS_Y = WS_MIX + (size_t)MROWS * DM * 2;
constexpr size_t WS_X1 = WS_Y + (size_t)MROWS * DM * 4;
constexpr size_t WS_SA = WS_X1 + (size_t)MROWS * DM * 4;
constexpr size_t SA_BYTES = (size_t)MROWS * 2048 * 4;
constexpr size_t WS_SC = WS_SA + SA_BYTES;
constexpr size_t SC_BYTES = (size_t)MROWS * 1024 * 4;
constexpr int PC_SPLIT = 2592, PC_CHUNKS = PC_SPLIT / 8 + 4096 / 8;
constexpr size_t WS_PC = WS_SC + SC_BYTES;
constexpr size_t WS_SB = WS_PC;
constexpr size_t WS_H8 = WS_PC + (size_t)PC_CHUNKS * MROWS * 16;
constexpr size_t WS_HS = WS_H8 + (size_t)MROWS * DM;
constexpr size_t WS_CS = al256(WS_HS + (size_t)MROWS * 4);
constexpr size_t WS_END = al256(WS_CS + (size_t)2 * NGATE * 4);
constexpr size_t CTL_CMAX = 512 * 1024;
__host__ __device__ constexpr size_t ws_w8(int l) { return WS_WTIN + ((size_t)l * NTOT + NPAD) * DM * 2; }
__host__ __device__ constexpr int pc_chunk(int col) { return col < PC_SPLIT ? (col >> 3) : PC_SPLIT / 8 + ((col - C_HXV) >> 3); }

#define GAS __attribute__((address_space(1)))
#define LAS __attribute__((address_space(3)))
typedef _Float16 f16;
typedef _Float16 f16x2 __attribute__((ext_vector_type(2)));
typedef _Float16 f16x4 __attribute__((ext_vector_type(4)));
typedef _Float16 f16x8 __attribute__((ext_vector_type(8)));
typedef float f32x2 __attribute__((ext_vector_type(2)));
typedef float f32x4 __attribute__((ext_vector_type(4)));
typedef float f32x16 __attribute__((ext_vector_type(16)));
typedef unsigned u32x2 __attribute__((ext_vector_type(2)));
typedef unsigned u32x4 __attribute__((ext_vector_type(4)));
typedef GAS unsigned gu32;
#define RLX_AGENT __ATOMIC_RELAXED, __HIP_MEMORY_SCOPE_AGENT
#define LDS_WAIT() asm volatile("s_waitcnt lgkmcnt(0)" ::: "memory")
#define VM_WAIT() asm volatile("s_waitcnt vmcnt(0)" ::: "memory")

typedef __bf16 bf16x2_t __attribute__((ext_vector_type(2)));
typedef __bf16 bf16x8_t __attribute__((ext_vector_type(8)));
__device__ __forceinline__ unsigned pkb(float lo, float hi) { f32x2 v = {lo, hi}; bf16x2_t b = __builtin_convertvector(v, bf16x2_t); return __builtin_bit_cast(unsigned, b); }
__device__ __forceinline__ u32x4 pkb8(f32x4 a, f32x4 b) { u32x4 w; w.x = pkb(a[0], a[1]); w.y = pkb(a[2], a[3]); w.z = pkb(b[0], b[1]); w.w = pkb(b[2], b[3]); return w; }
__device__ __forceinline__ float bf_lo(unsigned w) { return __builtin_bit_cast(float, w << 16); }
__device__ __forceinline__ float bf_hi(unsigned w) { return __builtin_bit_cast(float, w & 0xffff0000u); }
__device__ __forceinline__ unsigned pkh(float lo, float hi) { f16x2 v = {(f16)lo, (f16)hi}; return __builtin_bit_cast(unsigned, v); }
__device__ __forceinline__ u32x4 pkh8(f32x4 a, f32x4 b) { u32x4 w; w.x = pkh(a[0], a[1]); w.y = pkh(a[2], a[3]); w.z = pkh(b[0], b[1]); w.w = pkh(b[2], b[3]); return w; }
__device__ __forceinline__ float fast_exp(float x) { return __builtin_amdgcn_exp2f(x * 1.4426950408889634f); }
__device__ __forceinline__ float sigmoidf_(float x) { return __builtin_amdgcn_rcpf(1.0f + fast_exp(-x)); }
__device__ __forceinline__ float siluf_(float x) { return x * sigmoidf_(x); }
__device__ __forceinline__ float softplusf_(float x) { return x > 20.f ? x : log1pf(expf(x)); }
__device__ __forceinline__ int lane_id_opaque() { int l; asm volatile("v_mbcnt_lo_u32_b32 %0, -1, 0\n\tv_mbcnt_hi_u32_b32 %0, -1, %0" : "=v"(l)); return l; }
#define WAVE_RED_(OP) \
    { int t; \
      t = __builtin_amdgcn_update_dpp(0, __builtin_bit_cast(int, v), 0xB1, 0xF, 0xF, true);  v = OP(v, __builtin_bit_cast(float, t)); \
      t = __builtin_amdgcn_update_dpp(0, __builtin_bit_cast(int, v), 0x4E, 0xF, 0xF, true);  v = OP(v, __builtin_bit_cast(float, t)); \
      t = __builtin_amdgcn_update_dpp(0, __builtin_bit_cast(int, v), 0x141, 0xF, 0xF, true); v = OP(v, __builtin_bit_cast(float, t)); \
      t = __builtin_amdgcn_update_dpp(0, __builtin_bit_cast(int, v), 0x140, 0xF, 0xF, true); v = OP(v, __builtin_bit_cast(float, t)); \
      { const unsigned u = __builtin_bit_cast(unsigned, v); auto p = __builtin_amdgcn_permlane16_swap(u, u, false, false); v = OP(__builtin_bit_cast(float, (unsigned)p[0]), __builtin_bit_cast(float, (unsigned)p[1])); } \
      { const unsigned u = __builtin_bit_cast(unsigned, v); auto p = __builtin_amdgcn_permlane32_swap(u, u, false, false); v = OP(__builtin_bit_cast(float, (unsigned)p[0]), __builtin_bit_cast(float, (unsigned)p[1])); } }
__device__ __forceinline__ float wr_add_(float a, float b) { return a + b; }
__device__ __forceinline__ float wave_sum(float v) { WAVE_RED_(wr_add_) return v; }
__device__ __forceinline__ float wave_max(float v) { WAVE_RED_(fmaxf) return v; }
#undef WAVE_RED_

#ifdef TPROBE
#define TP_BEGIN(U) unsigned tsum_ = 0; unsigned long long tlast_ = __builtin_amdgcn_s_memrealtime(); const unsigned long long tstart_ = tlast_; constexpr bool tpon_ = ((U) == TPUNIT)
#define TP(k) do { if (tpon_) { const unsigned long long n_ = __builtin_amdgcn_s_memrealtime(); if ((k) == TPROBE) tsum_ += (unsigned)(n_ - tlast_); tlast_ = n_; } } while (0)
#define TP_END() do { if (tpon_) { TP(99); if (TPROBE == 0) tsum_ = (unsigned)(tlast_ - tstart_); if (F.tid == 0) { unsigned* tm_ = (unsigned*)(F.ws + WS_CTL) + 32768; atomicAdd(tm_, tsum_); atomicAdd(tm_ + 15, 1u); } } } while (0)
#else
#define TP_BEGIN(U) do {} while (0)
#define TP(k) do {} while (0)
#define TP_END() do {} while (0)
#endif
namespace pg8 {
constexpr int BM = 256, BK = 64, HALF = 128, HTB = HALF * BK * 2, STAGE_BYTES = 8 * HTB, NXCD = 8, WGM = 8;
__host__ __device__ __forceinline__ int lds_byte(int r, int c) { const int st = (r >> 4) * 2 + (c >> 5), rr = r & 15, cc = c & 31, ob = rr * 64 + cc * 2; return st * 1024 + (ob ^ (((ob >> 9) & 1) << 5)); }
__host__ __device__ __forceinline__ void stage_rc(int b, int& R, int& C) { const int st = b / 1024, sb = b % 1024, swz = sb ^ (((sb >> 9) & 1) << 5); R = (st >> 1) * 16 + swz / 64; C = (st & 1) * 32 + (swz % 64) / 2; }
__host__ __device__ __forceinline__ int perm32(int rho) { const int n = rho >> 4, i = rho & 15; return 8 * (i >> 2) + 4 * n + (i & 3); }

struct Unit { int pm, pn, kz; };
constexpr int NGATE_TILES = 32;
struct Gemm { const f16* A; const f16* Bt; };
template <int N_, int K_, int LDA_, int LDB_, int NZ_, long AZS_, long BZS_, int DT_ = 0> struct Shape { static constexpr int N = N_, K = K_, LDA = LDA_, LDB = LDB_, NZ = NZ_; static constexpr long AZS = AZS_, BZS = BZS_; static constexpr int DT = DT_; };
typedef int i32x4 __attribute__((ext_vector_type(4)));

template <int NN, int NZ> struct StaticOrder {
    int nM, nwg, G, c, ntail;
    __device__ __forceinline__ void init(int M, int G_, int c_, int ntail_ = 0) { nM = M / BM; nwg = nM * NN; G = G_; c = c_; ntail = ntail_; }
    __device__ __forceinline__ bool next(int i, Unit& u) const {
        const int j = i / NZ; u.kz = i - j * NZ;
        const int L = j * G + c; if (L >= nwg) { const int q = L - nwg; if (q >= ntail) return false; const int t = q % 12; u.pm = nM + q / 12; u.pn = t < 10 ? 4 + t : 11 + t; return true; }
        map(L, u); return true;
    }
    __device__ __forceinline__ void map(int L, Unit& u) const {
        int wgid = L; { const int q = nwg / NXCD, r = nwg % NXCD, xcd = wgid % NXCD, off = wgid / NXCD; wgid = (xcd < r ? xcd * (q + 1) : r * (q + 1) + (xcd - r) * q) + off; }
        constexpr int nig = WGM * NN; const int gid = wgid / nig, fm = gid * WGM, gsz = (nM - fm) < WGM ? (nM - fm) : WGM;
        u.pm = fm + ((wgid % nig) % gsz); u.pn = (wgid % nig) / gsz;
    }
};
struct GateOrderL0 {
    StaticOrder<NGATE_TILES, 1> S; int c;
    __device__ __forceinline__ void init(int M, int G_, int c_) { S.init(M, G_, c_); c = c_; }
    __device__ __forceinline__ bool next(int i, Unit& u) const {
        u.kz = 0; int L;
        if (S.G == 256 && S.nwg == 1024) {
            if (i < 2) L = i * 256 + c;
            else if (i == 2) { if (c < 32) return false; L = 512 + (c - 32); }
            else if (i == 3 || i == 4) { if (c < 112) return false; L = (i == 3 ? 736 : 880) + (c - 112); }
            else return false;
            S.map(L, u); return true; }
        if (S.G != 256 || S.nwg != 1152) return S.next(i, u);
        if (i < 3) L = i * 256 + c;
        else { if (c >= 128 && c < 144) return false; const int idx = c < 128 ? c : c - 16; if (i == 3) L = 768 + idx; else if (i == 4 && idx < 144) L = 1008 + idx; else return false; }
        S.map(L, u); return true;
    }
};
struct POrderL1 {
    StaticOrder<NPAD / 256, 1> S; int c;
    __device__ __forceinline__ void init(int M, int G_, int c_) { S.init(M, G_, c_, 48); c = c_; }
    __device__ __forceinline__ bool next(int i, Unit& u) const {
        if (S.G != 256) return S.next(i, u);
        u.kz = 0; int L;
        if (i < 5) L = i * 256 + c;
        else if (i == 5) { if (c >= 112) return false; L = 1280 + c; }
        else if (i == 6) { if (c >= 32) return false; L = 1392 + c; }
        else return false;
        if (L >= S.nwg) { const int q = L - S.nwg; if (q >= S.ntail) return false; const int t = q % 12; u.pm = S.nM + q / 12; u.pn = t < 10 ? 4 + t : 11 + t; return true; }
        S.map(L, u); return true;
    }
};

struct TailOrder {
    int G, c, nq;
    __device__ __forceinline__ void init(int G_, int c_, int shift, int nq_) { G = G_; c = (c_ + G_ - shift % G_) % G_; nq = nq_; }
    __device__ __forceinline__ bool next(int i, Unit& u) const { const int q = i * G + c; if (q >= nq) return false; const int t = q >> 2; u.kz = q & 3; u.pm = 32 + (t >> 3); u.pn = t & 7; return true; }
};
template <class SH, class Epi, class Sched>
__device__ __forceinline__ void gemm_phase(LAS unsigned char* lds, const Gemm g, const Sched& S, const Epi& E, const int wid) {
    const int lane = lane_id_opaque(), tid = wid * 64 + lane,
               wr = wid >> 2, wc = wid & 3, fr = lane & 15, fq = lane >> 4;
    constexpr int K = SH::K, nt = K / BK;
    unsigned voffA[2], voffB[2];
#pragma unroll
    for (int i = 0; i < 2; ++i) { int R, C; stage_rc(tid * 16 + i * 8192, R, C); const int Rb = Epi::PERM ? ((R & ~31) + perm32(R & 31)) : R;
        voffA[i] = (unsigned)(R * SH::LDA + C) * 2u; voffB[i] = (unsigned)(Rb * SH::LDB + C) * 2u; }
    constexpr size_t kstep = (size_t)(BK * 2);
    constexpr size_t hstepA = (size_t)HALF * SH::LDA * 2, hstepB = (size_t)HALF * SH::LDB * 2;
    constexpr size_t tstepA = 2 * hstepA, tstepB = 2 * hstepB;
    const unsigned ldsw = (unsigned)wid * 1024u;
    const int aoff = lds_byte(wr * 64 + fr, fq * 8), boff = lds_byte(wc * 32 + fr, fq * 8);
#define PG8_SA(b, h) (((b) * 2 + (h)) * HTB)
#define PG8_SB(b, h) ((4 + (b) * 2 + (h)) * HTB)
#define PG8_STAGE(bufoff, gbase, voff) do { _Pragma("unroll") for (int _i = 0; _i < 2; ++_i) \
        __builtin_amdgcn_global_load_lds((const unsigned*)((const char*)(gbase) + (voff)[_i]), (LAS unsigned*)(lds + (bufoff) + ldsw + _i * 8192), 16, 0, 0); } while (0)
#define PG8_LDA(dst, b, h) do { _Pragma("unroll") for (int m = 0; m < 4; ++m) _Pragma("unroll") for (int k = 0; k < 2; ++k) dst[m][k] = *(const LAS f16x8*)(lds + PG8_SA(b, h) + aoff + m * 2048 + k * 1024); } while (0)
#define PG8_LDB(dst, b, h) do { _Pragma("unroll") for (int n = 0; n < 2; ++n) _Pragma("unroll") for (int k = 0; k < 2; ++k) dst[n][k] = *(const LAS f16x8*)(lds + PG8_SB(b, h) + boff + n * 2048 + k * 1024); } while (0)
#define PG8_MMA(ai, bj, At, Bt) do { __builtin_amdgcn_s_setprio(1); _Pragma("unroll") for (int m = 0; m < 4; ++m) _Pragma("unroll") for (int n = 0; n < 2; ++n) _Pragma("unroll") for (int k = 0; k < 2; ++k) \
        { if constexpr (SH::DT == 2) acc[ai][bj][m][n] = __builtin_bit_cast(f32x4, __builtin_amdgcn_mfma_i32_16x16x64_i8(__builtin_bit_cast(i32x4, Bt[n][k]), __builtin_bit_cast(i32x4, At[m][k]), __builtin_bit_cast(i32x4, acc[ai][bj][m][n]), 0, 0, 0)); \
          else if constexpr (SH::DT == 1) acc[ai][bj][m][n] = __builtin_amdgcn_mfma_f32_16x16x32_bf16(__builtin_bit_cast(bf16x8_t, Bt[n][k]), __builtin_bit_cast(bf16x8_t, At[m][k]), acc[ai][bj][m][n], 0, 0, 0); \
          else acc[ai][bj][m][n] = __builtin_amdgcn_mfma_f32_16x16x32_f16(Bt[n][k], At[m][k], acc[ai][bj][m][n], 0, 0, 0); } __builtin_amdgcn_s_setprio(0); } while (0)
#define PG8_WAIT_V(n) asm volatile("s_waitcnt vmcnt(" #n ")" ::: "memory")
#define PG8_WAIT_L(n) asm volatile("s_waitcnt lgkmcnt(" #n ")" ::: "memory")
#define PG8_BAR __builtin_amdgcn_s_barrier()
#define PG8_SCHED __builtin_amdgcn_sched_barrier(0)
    Unit cur, nxt; int ui = 0;
    if (!S.next(0, cur)) return;
    f32x4 acc[2][2][4][2];
#pragma unroll
    for (int a = 0; a < 2; ++a)
#pragma unroll
        for (int b = 0; b < 2; ++b)
#pragma unroll
            for (int m = 0; m < 4; ++m)
#pragma unroll
                for (int n = 0; n < 2; ++n) acc[a][b][m][n] = (f32x4){0.f, 0.f, 0.f, 0.f};
    f16x8 At[4][2], B0[2][2], B1[2][2];
    const char* cA = (const char*)(g.A + (size_t)cur.kz * SH::AZS) + (size_t)cur.pm * tstepA;
    const char* cB = (const char*)(g.Bt + (size_t)cur.kz * SH::BZS) + (size_t)cur.pn * tstepB;
    PG8_STAGE(PG8_SB(0, 0), cB, voffB); PG8_STAGE(PG8_SB(0, 1), cB + hstepB, voffB); PG8_STAGE(PG8_SA(0, 0), cA, voffA); PG8_STAGE(PG8_SA(0, 1), cA + hstepA, voffA);
    if (wr == 1) PG8_BAR;
    PG8_WAIT_V(2); PG8_BAR;
    PG8_STAGE(PG8_SB(1, 0), cB + kstep, voffB); PG8_STAGE(PG8_SA(1, 0), cA + kstep, voffA); PG8_STAGE(PG8_SB(1, 1), cB + hstepB + kstep, voffB);
    PG8_WAIT_V(6); PG8_BAR;
    for (;;) {
        const bool has_next = S.next(ui + 1, nxt);
        const char* nA = has_next ? (const char*)(g.A + (size_t)nxt.kz * SH::AZS) + (size_t)nxt.pm * tstepA : cA;
        const char* nB = has_next ? (const char*)(g.Bt + (size_t)nxt.kz * SH::BZS) + (size_t)nxt.pn * tstepB : cB;
        for (int t = 0; t < nt; t += 2) {
            const bool last = (t == nt - 2);
            const char* a1 = cA + (size_t)(t + 1) * kstep;
            const char* a2 = last ? nA : cA + (size_t)(t + 2) * kstep; const char* b2 = last ? nB : cB + (size_t)(t + 2) * kstep;
            const char* a3 = a2 + kstep; const char* b3 = b2 + kstep;
            PG8_LDB(B0, 0, 0); PG8_LDB(B1, 0, 1); PG8_SCHED; PG8_LDA(At, 0, 0); PG8_STAGE(PG8_SA(1, 1), a1 + hstepA, voffA);
            PG8_WAIT_V(8); PG8_WAIT_L(0); PG8_BAR; PG8_MMA(0, 0, At, B0); PG8_MMA(0, 1, At, B1); PG8_BAR; PG8_SCHED;
            PG8_LDA(At, 0, 1); PG8_STAGE(PG8_SB(0, 0), b2, voffB); PG8_STAGE(PG8_SB(0, 1), b2 + hstepB, voffB); PG8_STAGE(PG8_SA(0, 0), a2, voffA);
            PG8_WAIT_V(8); PG8_WAIT_L(0); PG8_BAR; PG8_MMA(1, 0, At, B0); PG8_MMA(1, 1, At, B1); PG8_BAR; PG8_SCHED;
            PG8_LDB(B0, 1, 0); PG8_LDB(B1, 1, 1); PG8_SCHED; PG8_LDA(At, 1, 0); PG8_STAGE(PG8_SA(0, 1), a2 + hstepA, voffA);
            PG8_WAIT_V(8); PG8_WAIT_L(0); PG8_BAR; PG8_MMA(0, 0, At, B0); PG8_MMA(0, 1, At, B1); PG8_BAR; PG8_SCHED;
            PG8_LDA(At, 1, 1); PG8_STAGE(PG8_SB(1, 0), b3, voffB); PG8_STAGE(PG8_SB(1, 1), b3 + hstepB, voffB); PG8_STAGE(PG8_SA(1, 0), a3, voffA);
            PG8_WAIT_V(8); PG8_WAIT_L(0); PG8_BAR; PG8_MMA(1, 0, At, B0); PG8_MMA(1, 1, At, B1); PG8_BAR; PG8_SCHED;
        }
        if (wr == 0) PG8_BAR;
        E(acc, cur, wr, wc, fr, fq);
        if (!has_next) break;
        if (!Epi::KEEP || nxt.kz == 0)
#pragma unroll
        for (int a = 0; a < 2; ++a)
#pragma unroll
            for (int b = 0; b < 2; ++b)
#pragma unroll
                for (int m = 0; m < 4; ++m)
#pragma unroll
                    for (int n = 0; n < 2; ++n) acc[a][b][m][n] = (f32x4){0.f, 0.f, 0.f, 0.f};
        cur = nxt; cA = nA; cB = nB; ++ui;
        if (wr == 1) PG8_BAR;
    }
    PG8_WAIT_V(0);
    PG8_BAR;
#undef PG8_SA
#undef PG8_SB
#undef PG8_STAGE
#undef PG8_LDA
#undef PG8_LDB
#undef PG8_MMA
#undef PG8_WAIT_V
#undef PG8_WAIT_L
#undef PG8_BAR
#undef PG8_SCHED
}
}

constexpr int RING_BYTES = 131072;
constexpr int LDSCTL_OFF = RING_BYTES, MISC_OFF = LDSCTL_OFF + 320;
constexpr int LDS_BYTES = 147456;
constexpr int NWAVES = 8, NTHREADS = 512;

#define XB_TMO      128
#define XB_XCNT(j)  (256  + 64 * (j))
#define XB_XSUB(j)  (1280 + 64 * (j))
#define XB_XGEN(j)  (2304 + 64 * (j))
#define XB_TOP      3328
#define XB_TOPGEN   3392
#define XCD_BAR_WORDS 3456
#define XB_SPIN_CAP (1u << 24)
__device__ __forceinline__ unsigned xb_ld(unsigned* p)              { return __hip_atomic_load(p, __ATOMIC_RELAXED, __HIP_MEMORY_SCOPE_AGENT); }
__device__ __forceinline__ unsigned xb_add(unsigned* p, unsigned v) { return __hip_atomic_fetch_add(p, v, __ATOMIC_RELAXED, __HIP_MEMORY_SCOPE_AGENT); }
__device__ __forceinline__ unsigned xb_xcc_id() { return (unsigned)__builtin_amdgcn_s_getreg((3 << 11) | 20) & 0xFu; }
#define XB_SPIN(cond, bar) do { unsigned _sp = 0; while (cond) { __builtin_amdgcn_s_sleep(1); \
    if ((++_sp & 255u) == 0u) { if (xb_ld(&(bar)[XB_TMO])) break; if (_sp > XB_SPIN_CAP) { atomicAdd(&(bar)[XB_TMO], 1u); break; } } } } while (0)
struct XcdBarrier { unsigned* bar; unsigned x; volatile LAS unsigned* st; };
__device__ __forceinline__ XcdBarrier xcd_barrier_post(unsigned* bar, volatile LAS unsigned* st) {
    XcdBarrier b; b.bar = bar; b.x = xb_xcc_id(); b.st = st;
    if (threadIdx.x == 0) (void)xb_add(&bar[XB_XCNT(b.x)], 1u);
    return b;
}
__device__ __forceinline__ void xcd_barrier_complete(unsigned* bar, unsigned x, unsigned& nloc, unsigned& nx) {
    const unsigned G = gridDim.x * gridDim.y * gridDim.z;
    unsigned sum, cnt, mine, sp = 0u;
    for (;;) {
        sum = 0u; cnt = 0u; mine = 0u;
#pragma unroll
        for (unsigned j = 0; j < 16; ++j) { const unsigned c = xb_ld(&bar[XB_XCNT(j)]); sum += c; cnt += (c > 0u) ? 1u : 0u; mine = (j == x) ? c : mine; }
        if (sum == G) break;
        __builtin_amdgcn_s_sleep(1);
        if ((++sp & 255u) == 0u) { if (xb_ld(&bar[XB_TMO])) break; if (sp > XB_SPIN_CAP) { atomicAdd(&bar[XB_TMO], 1u); break; } }
    }
    nloc = mine > 0u ? mine : 1u; nx = cnt > 0u ? cnt : 1u;
}
__device__ __forceinline__ void xcd_barrier(const XcdBarrier& b) {
    asm volatile("s_waitcnt vmcnt(0)" ::: "memory");
    __syncthreads();
    if (threadIdx.x == 0) {
        unsigned* bar = b.bar;
        __builtin_amdgcn_s_waitcnt(0);
        unsigned nloc = b.st[0], nx = b.st[1];
        if (nloc == 0u) { xcd_barrier_complete(bar, b.x, nloc, nx); b.st[0] = nloc; b.st[1] = nx; }
        const unsigned old = xb_add(&bar[XB_XSUB(b.x)], 1u);
        const unsigned gen = old / nloc;
        if (old + 1u == (gen + 1u) * nloc) {
            __builtin_amdgcn_fence(__ATOMIC_RELEASE, "agent");
            asm volatile("s_waitcnt vmcnt(0)" ::: "memory");
            const unsigned og = xb_add(&bar[XB_TOP], 1u);
            const unsigned tg = og / nx;
            if (og + 1u == (tg + 1u) * nx) xb_add(&bar[XB_TOPGEN], 1u);
            else XB_SPIN(xb_ld(&bar[XB_TOPGEN]) == tg, bar);
            __builtin_amdgcn_fence(__ATOMIC_ACQUIRE, "agent");
            xb_add(&bar[XB_XGEN(b.x)], 1u);
            asm volatile("s_waitcnt vmcnt(0)" ::: "memory");
        } else {
            XB_SPIN(xb_ld(&bar[XB_XGEN(b.x)]) == gen, bar);
            __builtin_amdgcn_fence(__ATOMIC_ACQUIRE, "agent");
            asm volatile("s_waitcnt vmcnt(0)" ::: "memory");
        }
    }
    __syncthreads();
}

struct Args { const float* in[N_IN]; float* out; unsigned char* ws; int ph_lo, ph_hi; };
struct Frame {
    LAS unsigned char* lds;
    unsigned char* ws;
    const float* const* in;
    float* out;
    int tid, lane, wave, G, gw, NGW, bid, zin;
};
#define WSP(T, off) ((T*)(F.ws + (off)))
#define INP(i, l, per) (F.in[(i) + F.zin] + (size_t)(l) * (per))

struct TTile { const float* W; f16* WT; const float* kscale; int K, N, k0, n0, dfrom, dshift, bf, bf8l; };
__device__ __forceinline__ bool ttile_get(Frame& F, int it, TTile& t) {
    constexpr int T_IN = 32 * 75, T_BR = 16 * 8, T_OUT = 32 * 8, T_UQ = 8 * 6, T_UKV = 4 * 8;
    constexpr int T_LAYER = T_IN + 4 * T_BR + T_OUT + T_UQ + T_UKV;
    if (it >= 2 * T_LAYER) return false;
    const int l = it / T_LAYER; int r = it % T_LAYER;
    t.dfrom = 1 << 30; t.dshift = 0; t.kscale = nullptr; t.bf = 0; t.bf8l = l;
    if (r < T_IN) { t.W = INP(I_WIN, l, (size_t)DM * INW); t.K = DM; t.N = INW; t.WT = WSP(f16, WS_WTIN) + (size_t)l * NTOT * DM; t.k0 = (r % 32) * 64; t.n0 = (r / 32) * 256; t.dfrom = C_MERGE; t.dshift = NPAD - C_MERGE; t.bf = IN_BF16; return true; }
    r -= T_IN;
    if (r < 4 * T_BR) { const int kz = r / T_BR, q = r % T_BR; t.W = INP(I_WBR, l, (size_t)4 * 1024 * DM) + (size_t)kz * 1024 * DM; t.K = 1024; t.N = DM; t.WT = WSP(f16, WS_WTBR) + ((size_t)l * 4 + kz) * DM * 1024;
        t.k0 = (q % 16) * 64; t.n0 = (q / 16) * 256; t.kscale = kz == 0 ? INP(I_SNW, l, 1024) : nullptr; t.bf = 1; return true; }
    r -= 4 * T_BR;
    if (r < T_OUT) { t.W = INP(I_WOUT, l, (size_t)DM * DM); t.K = DM; t.N = DM; t.WT = WSP(f16, WS_WTOUT) + (size_t)l * DM * DM; t.k0 = (r % 32) * 64; t.n0 = (r / 32) * 256; t.bf = 1; return true; }
    r -= T_OUT;
    if (r < T_UQ) { t.W = INP(I_MWUQ, l, (size_t)512 * 1536); t.K = 512; t.N = 1536; t.WT = WSP(f16, WS_WTUQ) + (size_t)l * 1536 * 512; t.k0 = (r % 8) * 64; t.n0 = (r / 8) * 256; t.kscale = INP(I_MQN, l, 512); return true; }
    r -= T_UQ;
    t.W = INP(I_MWUKV, l, (size_t)256 * 2048); t.K = 256; t.N = 2048; t.WT = WSP(f16, WS_WTUKV) + (size_t)l * 2048 * 256; t.k0 = (r % 4) * 64; t.n0 = (r / 4) * 256; t.kscale = INP(I_MKVN, l, 256); return true;
}
__device__ __forceinline__ void ttile_load(Frame& F, const TTile& t, float (&v)[4][4][2]) {
#pragma unroll
    for (int rp = 0; rp < 4; ++rp) { const int k = t.k0 + 2 * (F.wave * 4 + rp);
#pragma unroll
        for (int cc = 0; cc < 4; ++cc) { const int n = t.n0 + cc * 64 + F.lane;
            v[rp][cc][0] = n < t.N ? __builtin_nontemporal_load(t.W + (size_t)k * t.N + n) : 0.f; v[rp][cc][1] = n < t.N ? __builtin_nontemporal_load(t.W + (size_t)(k + 1) * t.N + n) : 0.f; } }
}
__device__ __forceinline__ void pa_weights(Frame& F) {
    TTile ta, tb, done; float va[4][4][2], vb[4][4][2];
    int it = F.bid; bool have_a = ttile_get(F, it, ta);
    if (have_a) ttile_load(F, ta, va);
    it += F.G; bool have_b = ttile_get(F, it, tb);
    if (have_b) ttile_load(F, tb, vb);
#define PA_STEP(cur, v, have, IMGOFF) do { LAS unsigned* img = (LAS unsigned*)(F.lds + (IMGOFF)); \
        if (cur.dfrom < (1 << 30) && cur.n0 + 256 > cur.dfrom) {        \
            _Pragma("unroll") for (int cc = 0; cc < 4; ++cc) { const int n = cur.n0 + cc * 64 + F.lane; float mx = 0.f; \
                _Pragma("unroll") for (int rp = 0; rp < 4; ++rp) mx = fmaxf(mx, fmaxf(fabsf(v[rp][cc][0]), fabsf(v[rp][cc][1]))); \
                if (n >= cur.dfrom && n < cur.N) atomicMax((unsigned*)(F.ws + WS_CTL + CTL_CMAX) + (size_t)cur.bf8l * NGATE + (n - cur.dfrom), __float_as_uint(mx)); } } \
        _Pragma("unroll") for (int rp = 0; rp < 4; ++rp) { const int k = cur.k0 + 2 * (F.wave * 4 + rp); \
            const float s0 = cur.kscale ? cur.kscale[k] : 1.f, s1 = cur.kscale ? cur.kscale[k + 1] : 1.f; \
            _Pragma("unroll") for (int cc = 0; cc < 4; ++cc) img[(cc * 64 + F.lane) * 33 + F.wave * 4 + rp] = cur.bf ? pkb(v[rp][cc][0] * s0, v[rp][cc][1] * s1) : pkh(v[rp][cc][0] * s0, v[rp][cc][1] * s1); } \
        __syncthreads(); \
        done = cur; it += F.G; have = ttile_get(F, it, cur); \
        if (have) ttile_load(F, cur, v);                                \
        { const int q = F.tid & 7; \
          _Pragma("unroll") for (int i = 0; i < 4; ++i) { const int c = (F.tid >> 3) + 64 * i, n = done.n0 + c; \
            if (n < done.N && n < done.dfrom) { const LAS unsigned* r = img + c * 33 + 4 * q; u32x4 o; o.x = r[0]; o.y = r[1]; o.z = r[2]; o.w = r[3];     \
                *(u32x4*)(done.WT + (size_t)(n + (n >= done.dfrom ? done.dshift : 0)) * done.K + done.k0 + 8 * q) = o; } } } } while (0)
    for (;;) {
        if (!have_a) break;
        PA_STEP(ta, va, have_a, 0);
        if (!have_b) break;
        PA_STEP(tb, vb, have_b, 256 * 33 * 4 + 256);
    }
#undef PA_STEP
    __syncthreads();
    const int lane = F.lane;
    for (int i = F.gw * 64 + lane; i < 2 * 40960; i += F.NGW * 64) { const int l = i / 40960, q = i % 40960;
        *(u32x4*)(WSP(f16, WS_WTIN) + ((size_t)l * NTOT + C_MERGE) * DM + (size_t)q * 8) = (u32x4){0u, 0u, 0u, 0u}; }
}
__device__ __forceinline__ void pa_mod(Frame& F) {
    const int lane = F.lane;
    {
        LAS float* sl = (LAS float*)F.lds;
        LAS float* part = (LAS float*)(F.lds + 5 * 2048 * 4);
        if (F.bid < 2 * 96) {
            __syncthreads();
            for (int i = F.tid; i < 5 * DM; i += NTHREADS) { const int j = i / DM, k = i % DM; sl[i] = siluf_(j < 4 ? F.in[F.zin + I_C][j * DM + k] : F.in[F.zin + I_CCTX][k]); }
            __syncthreads();
        }
        for (int it = F.bid; it < 2 * 96; it += F.G) {
            const int l = it / 96, n = (it % 96) * 64 + lane;
            const float* wa = INP(I_WADA, l, (size_t)DM * 6144) + n + (size_t)(F.wave * 256) * 6144;
            const LAS float* s0 = sl + F.wave * 256;
            float a0 = 0.f, a1 = 0.f, a2 = 0.f, a3 = 0.f, a4 = 0.f;
#pragma unroll 64
            for (int k = 0; k < 256; ++k) { const float w = wa[(size_t)k * 6144];
                a0 += s0[k] * w; a1 += s0[DM + k] * w; a2 += s0[2 * DM + k] * w; a3 += s0[3 * DM + k] * w; a4 += s0[4 * DM + k] * w; }
            LAS float* pw = part + F.wave * 320 + lane;
            pw[0] = a0; pw[64] = a1; pw[128] = a2; pw[192] = a3; pw[256] = a4;
            __syncthreads();
            if (F.tid < 320) { float t = 0.f;
#pragma unroll
                for (int w = 0; w < 8; ++w) t += part[w * 320 + F.tid];
                const int j = F.tid >> 6, nn = (it % 96) * 64 + (F.tid & 63);
                WSP(float, WS_MOD)[((size_t)l * 5 + j) * 6144 + nn] = t + INP(I_BADA, l, 6144)[nn]; }
            __syncthreads();
        }
        __syncthreads();
    }
}
__device__ __forceinline__ void pa_rope(Frame& F) {
    const int lane = F.lane;
    for (int i = F.gw * 64 + lane; i < 2048 * 32; i += F.NGW * 64) {
        const int p = i >> 5, f = i & 31;
        const float invf = powf(10000.0f, -(float)(f & 15) / 16.0f);
        const float ang = (float)(f < 16 ? (p >> 6) : (p & 63)) * invf;
        WSP(float, WS_ROPE)[i] = cosf(ang); WSP(float, WS_ROPE)[2048 * 32 + i] = sinf(ang);
    }
}
__device__ __forceinline__ void pa_filters(Frame& F) {
    const int lane = F.lane;
    for (int it = F.gw; it < 2 * 2304; it += F.NGW) {
        const int l = it / 2304, q = it % 2304, isctx = q >= 2048, m = isctx ? q - 2048 : q, n = isctx ? 256 : 2048;
        const float* w1 = INP(I_HW1, l, 33 * 64); const float* w2 = INP(I_HW2, l, 64 * 64);
        const float t = (float)m / (float)(n - 1), wang = (6.283185307179586f / (float)n) * (float)m;
        float pre = INP(I_HB1, l, 64)[lane] + t * w1[lane];
#pragma unroll
        for (int i = 0; i < 16; ++i) { const float band = 1e-4f + (float)i * ((15.0f - 1e-4f) / 15.0f); const float a = band * wang;
            pre += cosf(a) * w1[(1 + i) * 64 + lane] - sinf(a) * w1[(17 + i) * 64 + lane]; }
        const float hd1 = sinf(INP(I_HFREQ, l, 128)[lane] * pre);
        float pre2 = INP(I_HB2, l, 64)[lane];
#pragma unroll 8
        for (int k = 0; k < 64; ++k) pre2 += __shfl(hd1, k) * w2[k * 64 + lane];
        WSP(f16, WS_HD2)[((size_t)l * 2304 + q) * 64 + lane] = (f16)sinf(INP(I_HFREQ, l, 128)[64 + lane] * pre2);
    }
}
__device__ __forceinline__ void pb_w8(Frame& F) {
    constexpr int NT8 = 2 * 32 * 32;
    float va[4][4][2], vb[4][4][2]; unsigned ca[4], cb[4];
#define PB_LOAD(IT, v, cmv) do { const int l_ = (IT) >> 10, nb_ = ((IT) >> 5) & 31, kb_ = (IT) & 31, k0_ = kb_ * 64, n0_ = nb_ * 256; \
        const float* W_ = INP(I_WIN, l_, (size_t)DM * INW) + C_MERGE; const unsigned* cm_ = (const unsigned*)(F.ws + WS_CTL + CTL_CMAX) + (size_t)l_ * NGATE; \
        _Pragma("unroll") for (int rp = 0; rp < 4; ++rp) { const int k = k0_ + 2 * (F.wave * 4 + rp); \
            _Pragma("unroll") for (int cc = 0; cc < 4; ++cc) { const int n = n0_ + cc * 64 + F.lane; v[rp][cc][0] = __builtin_nontemporal_load(W_ + (size_t)k * INW + n); v[rp][cc][1] = __builtin_nontemporal_load(W_ + (size_t)(k + 1) * INW + n); } } \
        _Pragma("unroll") for (int cc = 0; cc < 4; ++cc) cmv[cc] = __hip_atomic_load(cm_ + n0_ + cc * 64 + F.lane, __ATOMIC_RELAXED, __HIP_MEMORY_SCOPE_AGENT); } while (0)
#define PB_STEP(IT, v, cmv, IMGOFF) do { LAS unsigned* img = (LAS unsigned*)(F.lds + (IMGOFF)); \
        const int l = (IT) >> 10, nb = ((IT) >> 5) & 31, kb = (IT) & 31, k0 = kb * 64, n0 = nb * 256; \
        _Pragma("unroll") for (int cc = 0; cc < 4; ++cc) { const int n = n0 + cc * 64 + F.lane; \
            const float mx = fmaxf(__uint_as_float(cmv[cc]), 1e-30f), qs = 127.0f / mx; \
            if (kb == 0 && F.wave == 0) WSP(float, WS_CS)[(size_t)l * NGATE + n] = mx * (1.0f / 127.0f); \
            _Pragma("unroll") for (int h2 = 0; h2 < 2; ++h2) { unsigned w = 0; \
                _Pragma("unroll") for (int e = 0; e < 4; ++e) { const int qv = (int)rintf(v[2 * h2 + (e >> 1)][cc][e & 1] * qs); w |= ((unsigned)qv & 0xffu) << (8 * e); } \
                img[(cc * 64 + F.lane) * 17 + F.wave * 2 + h2] = w; } } \
        __syncthreads(); \
        { const int nx_ = (IT) + 2 * F.G; if (nx_ < NT8) PB_LOAD(nx_, v, cmv); }          \
        { char* W8 = (char*)F.ws + ws_w8(l); \
          _Pragma("unroll") for (int i = 0; i < 2; ++i) { const int c = (F.tid >> 2) + 128 * i, q = F.tid & 3; const LAS unsigned* r = img + c * 17 + 4 * q; \
            u32x4 o; o.x = r[0]; o.y = r[1]; o.z = r[2]; o.w = r[3]; \
            *(u32x4*)(W8 + (size_t)(n0 + c) * DM + k0 + 16 * q) = o; } } } while (0)
    int it = F.bid;
    if (it < NT8) PB_LOAD(it, va, ca);
    if (it + F.G < NT8) PB_LOAD(it + F.G, vb, cb);
    for (;;) {
        if (it >= NT8) break;
        PB_STEP(it, va, ca, 0); it += F.G;
        if (it >= NT8) break;
        PB_STEP(it, vb, cb, 256 * 17 * 4 + 256); it += F.G;
    }
#undef PB_LOAD
#undef PB_STEP
    __syncthreads();
}
__device__ __forceinline__ void filter_gemm(Frame& F) {
    for (int it = F.gw; it < 2 * 72 * 8; it += F.NGW) {
        const int lane = lane_id_opaque(), r32 = lane & 31, hi = lane >> 5;
        const int l = it / 576, q = it % 576, pt = q >> 3, cc = q & 7, isctx = pt >= 64, n = isctx ? 256 : 2048;
        const int m0 = isctx ? (pt - 64) * 32 : pt * 32, posbase = isctx ? 2048 + m0 : m0, c0 = cc * 256;
        const f16* hd = WSP(f16, WS_HD2) + ((size_t)l * 2304 + posbase + r32) * 64 + hi * 8;
        f16x8 A[4];
#pragma unroll
        for (int ks = 0; ks < 4; ++ks) A[ks] = *(const f16x8*)(hd + ks * 16);
        const float* w3u = INP(I_HW3, l, 64 * 2048);
        const unsigned loff = (unsigned)(8 * hi * 2048 + c0 + r32);
        f16* hf = (f16*)(F.ws + WS_HF + (size_t)l * HF_LAYER + (isctx ? HF_LAT : 0));
#pragma unroll 1
        for (int half4 = 0; half4 < 2; ++half4) {
            f32x16 acc[4];
#pragma unroll
            for (int ct = 0; ct < 4; ++ct) { acc[ct] = f32x16{};
#pragma unroll
                for (int ks = 0; ks < 4; ++ks) { float wv[8];
#pragma unroll
                    for (int j = 0; j < 8; ++j) wv[j] = (w3u + (size_t)(16 * ks + j) * 2048 + (half4 * 4 + ct) * 32)[loff];
                    f32x4 w0 = {wv[0], wv[1], wv[2], wv[3]}, w1 = {wv[4], wv[5], wv[6], wv[7]};
                    acc[ct] = __builtin_amdgcn_mfma_f32_32x32x16_f16(A[ks], __builtin_bit_cast(f16x8, pkh8(w0, w1)), acc[ct], 0, 0, 0); } }
#pragma unroll
            for (int ct = 0; ct < 4; ++ct) { const int c = c0 + (half4 * 4 + ct) * 32 + r32, ch = c & 1023;
                const float delta = fabsf(-15.350567286626973f + (float)ch * ((-3.0701134573253945f + 15.350567286626973f) / 1023.0f));
#pragma unroll
                for (int r = 0; r < 16; ++r) { const int m = m0 + (r & 3) + 8 * (r >> 2) + 4 * hi;
                    const float o = acc[ct][r] * expf(-((float)m / (float)(n - 1)) * delta);
                    f16* hg = hf + (size_t)(ch >> 3) * (2 * n) * 8 + (ch & 7);
                    if (c < 1024) hg[(size_t)(n - m) * 8] = (f16)o;
                    else if (m >= 1) hg[(size_t)(n + m) * 8] = (f16)o;
                    if (m == 0 && c < 1024) hg[0] = (f16)0.f; } }
        }
    }
}

__device__ __forceinline__ void row_stats(const f32x4 (&v)[8], float& mean, float& rstd) {
    float s = 0.f;
#pragma unroll
    for (int j = 0; j < 8; ++j) s += (v[j][0] + v[j][1]) + (v[j][2] + v[j][3]);
    mean = wave_sum(s) * (1.f / DM); float s2 = 0.f;
#pragma unroll
    for (int j = 0; j < 8; ++j) { const f32x4 d = v[j] - mean; s2 += (d[0] * d[0] + d[1] * d[1]) + (d[2] * d[2] + d[3] * d[3]); }
    rstd = 1.0f / sqrtf(wave_sum(s2) * (1.f / DM) + LN_EPS);
}
__device__ __forceinline__ void write_h_row(Frame& F, const f32x4 (&v)[8], int row, int l) {
    const int bidx = row < NLAT ? row / SEQ : 4;
    const float* mo = WSP(float, WS_MOD) + ((size_t)l * 5 + bidx) * 6144;
    f32x4 shv[8], scv[8];
#pragma unroll
    for (int j = 0; j < 8; ++j) { const int col = 4 * F.lane + 256 * j; shv[j] = *(const f32x4*)(mo + col); scv[j] = *(const f32x4*)(mo + 2048 + col); }
    float mean, rstd; row_stats(v, mean, rstd);
    f16* hr = WSP(f16, WS_H) + (size_t)row * DM;
    f32x4 hq[8]; float mx = 0.f;
#pragma unroll
    for (int j = 0; j < 8; ++j) { const int col = 4 * F.lane + 256 * j;
        const f32x4 sh = shv[j], sc = scv[j];
        const f32x4 h = (v[j] - mean) * rstd * (sc + 1.0f) + sh; hq[j] = h;
        mx = fmaxf(mx, fmaxf(fmaxf(fabsf(h[0]), fabsf(h[1])), fmaxf(fabsf(h[2]), fabsf(h[3]))));
        u32x2 w; if (IN_BF16) { w.x = pkb(h[0], h[1]); w.y = pkb(h[2], h[3]); } else { w.x = pkh(h[0], h[1]); w.y = pkh(h[2], h[3]); } *(u32x2*)(hr + col) = w; }
    mx = wave_max(mx);
    mx = fmaxf(mx, 1e-30f); const float qs = 127.0f / mx;
    unsigned* h8 = (unsigned*)(F.ws + WS_H8 + (size_t)row * DM);
#pragma unroll
    for (int j = 0; j < 8; ++j) { unsigned w = 0;
#pragma unroll
        for (int e = 0; e < 4; ++e) w |= ((unsigned)(int)rintf(hq[j][e] * qs) & 0xffu) << (8 * e);
        h8[F.lane + 64 * j] = w; }
    if (F.lane == 0) WSP(float, WS_HS)[row] = mx * (1.0f / 127.0f);
}
__device__ __forceinline__ void prologue_b(Frame& F) {
    f32x4 nv[8];
    { const int row = F.gw; const float* xr = row < NLAT ? F.in[F.zin + I_X] + (size_t)row * DM : F.in[F.zin + I_CTX] + (size_t)(row - NLAT) * DM;
#pragma unroll
      for (int j = 0; j < 8; ++j) nv[j] = __builtin_nontemporal_load((const f32x4*)(xr + 4 * F.lane + 256 * j)); }
    for (int row = F.gw; row < MROWS; row += F.NGW) {
        f32x4 v[8];
#pragma unroll
        for (int j = 0; j < 8; ++j) v[j] = nv[j];
        const int nrow = row + F.NGW;
        if (nrow < MROWS) { const float* xr = nrow < NLAT ? F.in[F.zin + I_X] + (size_t)nrow * DM : F.in[F.zin + I_CTX] + (size_t)(nrow - NLAT) * DM;
#pragma unroll
            for (int j = 0; j < 8; ++j) nv[j] = __builtin_nontemporal_load((const f32x4*)(xr + 4 * F.lane + 256 * j)); }
        write_h_row(F, v, row, 0);
    }
}
__device__ __forceinline__ void ln_phase(Frame& F, int l) {
    const int nrows = (l == DEPTH - 1) ? NLAT : MROWS;
    const float* lg = INP(I_LNG, l, DM); const float* lb = INP(I_LNB, l, DM);
    u32x2 raw[8];
    const f16* ybase = WSP(f16, WS_Y) + (size_t)MROWS * DM;
    const bool bal = (l == 0 && F.NGW == 2048), clsA = F.gw < 1024;
    const int nk = bal ? (clsA ? 4 : 5) : (F.gw < nrows ? (nrows - 1 - F.gw) / F.NGW + 1 : 0);
#define LN_ROWOF(k) (!bal ? F.gw + (k) * F.NGW : (clsA ? ((k) < 3 ? F.gw + 1024 * (k) : NLAT + F.gw) : 3072 + (F.gw - 1024) + 1024 * (k)))
    if (nk > 0) { const int row0 = LN_ROWOF(0);
      if (!(l == 0 && row0 >= NLAT)) {
#pragma unroll
        for (int j = 0; j < 8; ++j) raw[j] = __builtin_nontemporal_load((const u32x2*)(ybase + (size_t)row0 * DM + 4 * F.lane + 256 * j)); } }
    for (int kk = 0; kk < nk; ++kk) { const int row = LN_ROWOF(kk);
        f32x4 v[8];
        if (l == 0 && row >= NLAT) {
            const float* rr = F.in[F.zin + I_CTX] + (size_t)(row - NLAT) * DM; const f16* sl = (const f16*)(F.ws + WS_SA) + (size_t)4 * NCTX * DM + (size_t)(row - NLAT) * DM;
#pragma unroll
            for (int j = 0; j < 8; ++j) { const int col = 4 * F.lane + 256 * j; f32x4 a = *(const f32x4*)(rr + col) * DN_ALPHA;
#pragma unroll
                for (int k = 0; k < 4; ++k) { const f16x4 t = *(const f16x4*)(sl + (size_t)k * NCTX * DM + col); a += (f32x4){(float)t[0], (float)t[1], (float)t[2], (float)t[3]}; }
                v[j] = a; }
        } else {
#pragma unroll
        for (int j = 0; j < 8; ++j) { const f16x4 t = __builtin_bit_cast(f16x4, raw[j]); v[j] = (f32x4){(float)t[0], (float)t[1], (float)t[2], (float)t[3]}; } }
        { const int nrow = LN_ROWOF(kk + 1);
          if (kk + 1 < nk && !(l == 0 && nrow >= NLAT)) {
#pragma unroll
              for (int j = 0; j < 8; ++j) raw[j] = __builtin_nontemporal_load((const u32x2*)(ybase + (size_t)nrow * DM + 4 * F.lane + 256 * j)); } }
        f32x4 lgv[8], lbv[8];
#pragma unroll
        for (int j = 0; j < 8; ++j) { lgv[j] = *(const f32x4*)(lg + 4 * F.lane + 256 * j); lbv[j] = *(const f32x4*)(lb + 4 * F.lane + 256 * j); }
        float mean, rstd; row_stats(v, mean, rstd);
        float* xo = F.out + (size_t)row * DM; f16* x1 = WSP(f16, WS_X1) + (size_t)row * DM;
#pragma unroll
        for (int j = 0; j < 8; ++j) { const int col = 4 * F.lane + 256 * j;
            v[j] = (v[j] - mean) * rstd * lgv[j] + lbv[j];
            if (l == DEPTH - 1) __builtin_nontemporal_store(v[j], (f32x4*)(xo + col));
            else { u32x2 w; w.x = pkh(v[j][0], v[j][1]); w.y = pkh(v[j][2], v[j][3]); __builtin_nontemporal_store(w, (u32x2*)(x1 + col)); } }
        if (l < DEPTH - 1) write_h_row(F, v, row, l + 1);
    }
#undef LN_ROWOF
}

struct EpiInProj {
    static constexpr bool PERM = true, KEEP = false;
    f16* P; f16* G; f16* PC;
    __device__ __forceinline__ void operator()(const f32x4 (&acc)[2][2][4][2], const pg8::Unit& u, int wr, int wc, int fr, int fq) const {
        const int row0 = u.pm * 256 + wr * 64 + fr;
        const bool sig = u.pn >= NPT;
        f16* base = sig ? G : P; const int ld = sig ? NGATE : NPAD;
        const int col0 = (sig ? u.pn - NPT : u.pn) * 256 + wc * 32 + 8 * fq;
        const bool cm0 = !sig && (col0 < PC_SPLIT || (col0 >= C_HXV && col0 < C_MERGE)), cm1 = !sig && (col0 + 128 < PC_SPLIT || (col0 + 128 >= C_HXV && col0 + 128 < C_MERGE));
        f16* pc0 = PC + (size_t)pc_chunk(cm0 ? col0 : 0) * MROWS * 8; f16* pc1 = PC + (size_t)pc_chunk(cm1 ? col0 + 128 : 0) * MROWS * 8;
#pragma unroll
        for (int ai = 0; ai < 2; ++ai)
#pragma unroll
            for (int m = 0; m < 4; ++m) { f16* rowp = base + (size_t)(row0 + ai * 128 + m * 16) * ld + col0;
#pragma unroll
                for (int bj = 0; bj < 2; ++bj) { f32x4 v0 = acc[ai][bj][m][0], v1 = acc[ai][bj][m][1];
                    const int row = row0 + ai * 128 + m * 16;
                    if (bj == 0 ? cm0 : cm1) *(u32x4*)((bj == 0 ? pc0 : pc1) + (size_t)row * 8) = pkh8(v0, v1);
                    else if (sig) __builtin_nontemporal_store(pkh8(v0, v1), (u32x4*)(rowp + bj * 128));
                    else *(u32x4*)(rowp + bj * 128) = pkh8(v0, v1); } }
    }
};
struct EpiGate {
    static constexpr bool PERM = true, KEEP = false;
    unsigned char* G; const float* hs; const float* cs;
    __device__ __forceinline__ void operator()(const f32x4 (&acc)[2][2][4][2], const pg8::Unit& u, int wr, int wc, int fr, int fq) const {
        const int row0 = u.pm * 256 + wr * 64 + fr, col0 = u.pn * 256 + wc * 32 + 8 * fq;
        f32x4 c4[2][2];
#pragma unroll
        for (int bj = 0; bj < 2; ++bj)
#pragma unroll
            for (int n = 0; n < 2; ++n) c4[bj][n] = *(const f32x4*)(cs + col0 + bj * 128 + n * 4);
        float rsv[2][4];
#pragma unroll
        for (int ai = 0; ai < 2; ++ai)
#pragma unroll
            for (int m = 0; m < 4; ++m) rsv[ai][m] = hs[row0 + ai * 128 + m * 16];
#pragma unroll
        for (int ai = 0; ai < 2; ++ai)
#pragma unroll
            for (int m = 0; m < 4; ++m) { const int row = row0 + ai * 128 + m * 16; const float rs = rsv[ai][m];
#pragma unroll
                for (int bj = 0; bj < 2; ++bj) { const pg8::i32x4 a0 = __builtin_bit_cast(pg8::i32x4, acc[ai][bj][m][0]), a1 = __builtin_bit_cast(pg8::i32x4, acc[ai][bj][m][1]);
                    unsigned w0 = 0u, w1 = 0u;
#pragma unroll
                    for (int e = 0; e < 4; ++e) {
                        const unsigned q0 = (unsigned)__builtin_rintf(sigmoidf_((float)a0[e] * rs * c4[bj][0][e]) * 255.0f), q1 = (unsigned)__builtin_rintf(sigmoidf_((float)a1[e] * rs * c4[bj][1][e]) * 255.0f);
                        w0 |= (q0 < 1u ? 1u : q0) << (8 * e); w1 |= (q1 < 1u ? 1u : q1) << (8 * e); }
                    u32x2 w; w.x = w0; w.y = w1;
                    *(u32x2*)(G + (size_t)row * NGATE + col0 + bj * 128) = w; } }
    }
};
struct EpiRowScale {
    static constexpr bool PERM = true, KEEP = false;
    f16* O; int ldc; const float* rs;
    __device__ __forceinline__ void operator()(const f32x4 (&acc)[2][2][4][2], const pg8::Unit& u, int wr, int wc, int fr, int fq) const {
        const int row0 = u.pm * 256 + wr * 64 + fr, col0 = u.pn * 256 + wc * 32 + 8 * fq;
        float rsv[2][4];
#pragma unroll
        for (int ai = 0; ai < 2; ++ai)
#pragma unroll
            for (int m = 0; m < 4; ++m) rsv[ai][m] = rs[row0 + ai * 128 + m * 16];
#pragma unroll
        for (int ai = 0; ai < 2; ++ai)
#pragma unroll
            for (int m = 0; m < 4; ++m) { const int row = row0 + ai * 128 + m * 16; const float s = rsv[ai][m]; f16* rowp = O + (size_t)row * ldc + col0;
#pragma unroll
                for (int bj = 0; bj < 2; ++bj) *(u32x4*)(rowp + bj * 128) = pkh8(acc[ai][bj][m][0] * s, acc[ai][bj][m][1] * s); }
    }
};
struct EpiMerge {
    static constexpr bool PERM = true, KEEP = true;
    const unsigned char* G; f16* MIX;
    __device__ __forceinline__ void operator()(f32x4 (&acc)[2][2][4][2], const pg8::Unit& u, int wr, int wc, int fr, int fq) const {
        const int row0 = u.pm * 256 + wr * 64 + fr, col0 = u.pn * 256 + wc * 32 + 8 * fq;
        const unsigned char* gp = G + (size_t)row0 * NGATE + u.kz * 2048 + col0;
        f16* op = MIX + (size_t)row0 * DM + col0;
        const bool last = u.kz == 3;
#pragma unroll
        for (int ai = 0; ai < 2; ++ai) { u32x2 gk[4][2], gn[4][2];
#pragma unroll
            for (int m = 0; m < 4; ++m)
#pragma unroll
                for (int bj = 0; bj < 2; ++bj) gk[m][bj] = *(const u32x2*)(gp + (size_t)(ai * 128 + m * 16) * NGATE + bj * 128);
            if (!last) {
#pragma unroll
                for (int m = 0; m < 4; ++m)
#pragma unroll
                    for (int bj = 0; bj < 2; ++bj) gn[m][bj] = *(const u32x2*)(gp + (size_t)(ai * 128 + m * 16) * NGATE + bj * 128 + 2048);
            } else {
#pragma unroll
                for (int m = 0; m < 4; ++m)
#pragma unroll
                    for (int bj = 0; bj < 2; ++bj) gn[m][bj] = (u32x2){0xffffffffu, 0xffffffffu};
            }
#pragma unroll
            for (int m = 0; m < 4; ++m)
#pragma unroll
                for (int bj = 0; bj < 2; ++bj)
#pragma unroll
                    for (int e = 0; e < 4; ++e) {
                        acc[ai][bj][m][0][e] *= (float)((gk[m][bj].x >> (8 * e)) & 255u) * __builtin_amdgcn_rcpf((float)((gn[m][bj].x >> (8 * e)) & 255u));
                        acc[ai][bj][m][1][e] *= (float)((gk[m][bj].y >> (8 * e)) & 255u) * __builtin_amdgcn_rcpf((float)((gn[m][bj].y >> (8 * e)) & 255u)); }
            if (last) {
#pragma unroll
                for (int m = 0; m < 4; ++m)
#pragma unroll
                    for (int bj = 0; bj < 2; ++bj) *(u32x4*)(op + (size_t)(ai * 128 + m * 16) * DM + bj * 128) = pkb8(acc[ai][bj][m][0], acc[ai][bj][m][1]);
            }
        }
    }
};
template <bool RES16>
struct EpiOut {
    static constexpr bool PERM = true, KEEP = false;
    const void* res_lat; const void* res_ctx; const float* mod; f16* Y;
    __device__ __forceinline__ void operator()(const f32x4 (&acc)[2][2][4][2], const pg8::Unit& u, int wr, int wc, int fr, int fq) const {
        const int row0 = u.pm * 256 + wr * 64 + fr, col0 = u.pn * 256 + wc * 32 + 8 * fq;
        const bool lat = u.pm < NLAT / 256;
        const float* res = lat ? (const float*)res_lat : (const float*)res_ctx - (size_t)NLAT * DM;
        const f16* res16 = lat ? (const f16*)res_lat : (const f16*)res_ctx - (size_t)NLAT * DM;
        const float* gv = mod + (size_t)(lat ? u.pm / 8 : 4) * 6144 + 4096;
        f32x4 g4[2][2];
#pragma unroll
        for (int bj = 0; bj < 2; ++bj)
#pragma unroll
            for (int n = 0; n < 2; ++n) g4[bj][n] = *(const f32x4*)(gv + col0 + bj * 128 + n * 4);
#pragma unroll
        for (int ai = 0; ai < 2; ++ai) { f32x4 rv[4][2][2];
#pragma unroll
            for (int m = 0; m < 4; ++m) { const size_t off = (size_t)(row0 + ai * 128 + m * 16) * DM + col0;
#pragma unroll
                for (int bj = 0; bj < 2; ++bj) {
                    if constexpr (RES16) { const f16x8 t = __builtin_bit_cast(f16x8, __builtin_nontemporal_load((const u32x4*)(res16 + off + bj * 128)));
                        rv[m][bj][0] = (f32x4){(float)t[0], (float)t[1], (float)t[2], (float)t[3]}; rv[m][bj][1] = (f32x4){(float)t[4], (float)t[5], (float)t[6], (float)t[7]}; }
                    else { rv[m][bj][0] = __builtin_nontemporal_load((const f32x4*)(res + off + bj * 128)); rv[m][bj][1] = __builtin_nontemporal_load((const f32x4*)(res + off + bj * 128 + 4)); } } }
#pragma unroll
            for (int m = 0; m < 4; ++m) { const size_t off = (size_t)(row0 + ai * 128 + m * 16) * DM + col0;
#pragma unroll
                for (int bj = 0; bj < 2; ++bj)
                    *(u32x4*)(Y + off + bj * 128) = pkh8(rv[m][bj][0] * DN_ALPHA + g4[bj][0] * acc[ai][bj][m][0], rv[m][bj][1] * DN_ALPHA + g4[bj][1] * acc[ai][bj][m][1]); } }
    }
};
struct EpiMergeSlab {
    static constexpr bool PERM = true, KEEP = false;
    const unsigned char* G; f16* slab;
    __device__ __forceinline__ void operator()(const f32x4 (&acc)[2][2][4][2], const pg8::Unit& u, int wr, int wc, int fr, int fq) const {
        const int row0 = u.pm * 256 + wr * 64 + fr, col0 = u.pn * 256 + wc * 32 + 8 * fq;
#pragma unroll
        for (int ai = 0; ai < 2; ++ai) { u32x2 gtv[4][2];
#pragma unroll
            for (int m = 0; m < 4; ++m)
#pragma unroll
                for (int bj = 0; bj < 2; ++bj) gtv[m][bj] = *(const u32x2*)(G + (size_t)(row0 + ai * 128 + m * 16) * NGATE + u.kz * 2048 + col0 + bj * 128);
#pragma unroll
            for (int m = 0; m < 4; ++m) { const int row = row0 + ai * 128 + m * 16;
#pragma unroll
                for (int bj = 0; bj < 2; ++bj) { const int col = col0 + bj * 128;
                    const unsigned g0 = gtv[m][bj].x, g1 = gtv[m][bj].y;
                    f32x4 v0 = acc[ai][bj][m][0], v1 = acc[ai][bj][m][1];
#pragma unroll
                    for (int e = 0; e < 4; ++e) { v0[e] *= (float)((g0 >> (8 * e)) & 255u) * (1.0f / 255.0f); v1[e] *= (float)((g1 >> (8 * e)) & 255u) * (1.0f / 255.0f); }
                    *(u32x4*)(slab + ((size_t)u.kz * NCTX + (row - NLAT)) * DM + col) = pkh8(v0, v1); } } }
    }
};
__device__ __forceinline__ void merge_ctx_reduce(Frame& F) {
    const f16* slab = (const f16*)(F.ws + WS_SA); f16* MIX = WSP(f16, WS_MIX) + (size_t)NLAT * DM;
    const int gt = F.gw * 64 + F.lane, NT = F.NGW * 64;
    for (int p0 = gt; p0 < NCTX * DM / 8; p0 += 2 * NT) {
        u32x4 a[2][4];
#pragma unroll
        for (int u = 0; u < 2; ++u) { const int p = p0 + u * NT;
#pragma unroll
            for (int k = 0; k < 4; ++k) { a[u][k] = (u32x4){0u, 0u, 0u, 0u};
                if (p < NCTX * DM / 8) a[u][k] = __builtin_nontemporal_load((const u32x4*)(slab + (size_t)k * NCTX * DM + (size_t)p * 8)); } }
#pragma unroll
        for (int u = 0; u < 2; ++u) { const int p = p0 + u * NT;
            if (p < NCTX * DM / 8) { f32x4 s0 = {0.f, 0.f, 0.f, 0.f}, s1 = s0;
#pragma unroll
                for (int k = 0; k < 4; ++k) { const f16x8 h = __builtin_bit_cast(f16x8, a[u][k]);
#pragma unroll
                    for (int e = 0; e < 4; ++e) { s0[e] += (float)h[e]; s1[e] += (float)h[4 + e]; } }
                *(u32x4*)(MIX + (size_t)p * 8) = pkb8(s0, s1); } }
    }
}
struct EpiOutSlab {
    static constexpr bool PERM = false, KEEP = false;
    const float* mod; f16* slab;
    __device__ __forceinline__ void operator()(const f32x4 (&acc)[2][2][4][2], const pg8::Unit& u, int wr, int wc, int fr, int fq) const {
        const int row0 = u.pm * 256 + wr * 64 + fr, col0 = u.pn * 256 + wc * 32 + 4 * fq;
        const float* gv = mod + (size_t)4 * 6144 + 4096;
        f32x4 g4v[2][2];
#pragma unroll
        for (int bj = 0; bj < 2; ++bj)
#pragma unroll
            for (int n = 0; n < 2; ++n) g4v[bj][n] = *(const f32x4*)(gv + col0 + bj * 128 + n * 16);
#pragma unroll
        for (int bj = 0; bj < 2; ++bj)
#pragma unroll
            for (int n = 0; n < 2; ++n) { const f32x4 g4 = g4v[bj][n];
#pragma unroll
                for (int ai = 0; ai < 2; ++ai)
#pragma unroll
                    for (int m = 0; m < 4; ++m) { const f32x4 v = g4 * acc[ai][bj][m][n]; u32x2 w; w.x = pkh(v[0], v[1]); w.y = pkh(v[2], v[3]);
                        *(u32x2*)(slab + ((size_t)u.kz * NCTX + (row0 + ai * 128 + m * 16 - NLAT)) * DM + col0 + bj * 128 + n * 16) = w; } }
    }
};

constexpr size_t SA_U = 0, SA_DT = (size_t)MROWS * 1536 * 4, SA_KPE = SA_DT + (size_t)MROWS * 32 * 4, SA_GK = SA_KPE + (size_t)MROWS * 64 * 4;
static_assert(SA_GK + (size_t)MROWS * 128 * 4 <= SA_BYTES, "scratch A");

__device__ __forceinline__ bool has_prev(int row) { return row < NLAT ? (row & (SEQ - 1)) != 0 : ((row - NLAT) & (CTXL - 1)) != 0; }
__device__ __forceinline__ bool has_next(int row) { return row < NLAT ? (row & (SEQ - 1)) != SEQ - 1 : ((row - NLAT) & (CTXL - 1)) != CTXL - 1; }
__device__ __forceinline__ float conv3(const f16* P, int row, int col, const float* w, int wc, int nch, float bias) {
    float a = w[nch + wc] * (float)P[(size_t)row * NPAD + col] + bias;
    if (has_prev(row)) a += w[wc] * (float)P[(size_t)(row - 1) * NPAD + col];
    if (has_next(row)) a += w[2 * nch + wc] * (float)P[(size_t)(row + 1) * NPAD + col];
    return a;
}
__device__ __forceinline__ void prep_naive(Frame& F, int l) {
    f16* Pw = WSP(f16, WS_P);
    const int gt = F.gw * 64 + F.lane, NT = F.NGW * 64;
    const float* cosT = WSP(float, WS_ROPE); const float* sinT = cosT + 2048 * 32;
    for (int row0 = F.gw; row0 < MROWS; row0 += 5 * F.NGW) {
        f16x8 vq[5], vk[5];
#pragma unroll
        for (int k = 0; k < 5; ++k) { const int row = row0 + k * F.NGW; vq[k] = f16x8{}; vk[k] = f16x8{};
            if (row < MROWS) { const f16* pr = Pw + (size_t)row * NPAD + C_CQ;
                vq[k] = *(const f16x8*)(pr + F.lane * 8); if (F.lane < 32) vk[k] = *(const f16x8*)(pr + 512 + F.lane * 8); } }
#pragma unroll
        for (int k = 0; k < 5; ++k) { const int row = row0 + k * F.NGW;
            if (row < MROWS) { float sq = 0.f, sk = 0.f;
#pragma unroll
                for (int j = 0; j < 8; ++j) { sq += (float)vq[k][j] * (float)vq[k][j]; sk += (float)vk[k][j] * (float)vk[k][j]; }
                sq = wave_sum(sq); sk = wave_sum(sk);
                if (F.lane == 0) { WSP(float, WS_RS)[row] = 1.0f / sqrtf(sq * (1.f / 512.f) + LN_EPS); WSP(float, WS_RS)[MROWS + row] = 1.0f / sqrtf(sk * (1.f / 256.f) + LN_EPS); } } }
    }
    for (int i = gt; i < NLAT * 12; i += NT) { const int row = i / 12, s = i % 12, p = row & (SEQ - 1);
        f16* a = Pw + (size_t)row * NPAD + (s < 4 ? C_KPE + s * 8 : C_GK + ((s - 4) >> 2) * 64 + ((s - 4) & 3) * 8);
        const int f0 = (s < 4 ? s : (s - 4) & 3) * 8;
        const f16x8 t1 = *(const f16x8*)a, t2 = *(const f16x8*)(a + 32);
        const f32x4 c0 = *(const f32x4*)(cosT + p * 32 + f0), c1 = *(const f32x4*)(cosT + p * 32 + f0 + 4), s0 = *(const f32x4*)(sinT + p * 32 + f0), s1 = *(const f32x4*)(sinT + p * 32 + f0 + 4);
        f16x8 o1, o2;
#pragma unroll
        for (int j = 0; j < 8; ++j) { const float cc = j < 4 ? c0[j] : c1[j - 4], ss = j < 4 ? s0[j] : s1[j - 4], x = (float)t1[j], y = (float)t2[j];
            o1[j] = (f16)(x * cc - y * ss); o2[j] = (f16)(x * ss + y * cc); }
        *(f16x8*)a = o1; *(f16x8*)(a + 32) = o2; }
}

__device__ __forceinline__ void ssd_naive(Frame& F, int l) {
    const float* U = (const float*)(F.ws + WS_SA + SA_U); const float* DT = (const float*)(F.ws + WS_SA + SA_DT);
    float* YD = WSP(float, WS_Y);
    LAS float* tile = (LAS float*)F.lds;
    for (int item = F.bid; item < 256; item += F.G) {
        const int b = item >> 6, h = (item >> 2) & 15, dir = (item >> 1) & 1, ph = item & 1, g = h >> 3;
        const float a = -expf(INP(I_SALOG, l, 32)[dir * 16 + h]);
        const int pl = F.tid >> 4, nc = F.tid & 15;
        float st[8];
#pragma unroll
        for (int j = 0; j < 8; ++j) st[j] = 0.f;
        for (int s0 = 0; s0 < CTXL + SEQ; s0 += 16) {
            __syncthreads();
            for (int e = F.tid; e < 16 * 290; e += NTHREADS) { const int k = e / 290, q = e % 290, s = s0 + k;
                int row; if (s < CTXL) row = NLAT + b * CTXL + (dir ? CTXL - 1 - s : s); else row = b * SEQ + (dir ? SEQ - 1 - (s - CTXL) : (s - CTXL));
                float v;
                if (q < 32) v = U[(size_t)row * 1536 + h * 64 + ph * 32 + q];
                else if (q < 160) v = U[(size_t)row * 1536 + 1024 + g * 128 + (q - 32)];
                else if (q < 288) v = U[(size_t)row * 1536 + 1280 + g * 128 + (q - 160)];
                else if (q == 288) v = DT[(size_t)row * 32 + dir * 16 + h];
                else v = __int_as_float(row);
                tile[k * 292 + q] = v; }
            __syncthreads();
            for (int k = 0; k < 16; ++k) {
                const LAS float* tk = tile + k * 292;
                const float dtv = tk[288], dec = expf(dtv * a), xv = tk[pl] * dtv;
                float yp = 0.f;
#pragma unroll
                for (int j = 0; j < 8; ++j) { st[j] = dec * st[j] + xv * tk[32 + nc * 8 + j]; yp += st[j] * tk[160 + nc * 8 + j]; }
                yp += __shfl_xor(yp, 1); yp += __shfl_xor(yp, 2); yp += __shfl_xor(yp, 4); yp += __shfl_xor(yp, 8);
                if (nc == 0) { const int row = __float_as_int(tk[289]); YD[((size_t)dir * MROWS + row) * 1024 + h * 64 + ph * 32 + pl] = yp; }
            }
        }
        __syncthreads();
    }
}
__device__ __forceinline__ void ssd_gate_naive(Frame& F, int l) {
    const f16* P = WSP(f16, WS_P); const float* U = (const float*)(F.ws + WS_SA + SA_U); const float* YD = WSP(float, WS_Y);
    f16* GT = WSP(f16, WS_GATED);
    const int nrows = l == 0 ? MROWS : NLAT;
    for (int row = F.gw; row < nrows; row += F.NGW) {
        float gv[16]; float ss = 0.f;
#pragma unroll
        for (int j = 0; j < 16; ++j) { const int c = F.lane * 16 + j;
            const float y = YD[(size_t)row * 1024 + c] + YD[((size_t)MROWS + row) * 1024 + c] + U[(size_t)row * 1536 + c] * INP(I_SD, l, 16)[c >> 6];
            const float g = y * siluf_((float)P[(size_t)row * NPAD + C_SZ + c]); gv[j] = g; ss += g * g; }
#pragma unroll
        for (int o = 1; o < 32; o <<= 1) ss += __shfl_xor(ss, o);
        const float r = 1.0f / sqrtf(ss * (1.f / 512.f) + LN_EPS);
#pragma unroll
        for (int j = 0; j < 16; ++j) GT[(size_t)row * 1024 + F.lane * 16 + j] = (f16)(gv[j] * r);
    }
}
__device__ __forceinline__ void gqa_naive(Frame& F, int l) {
    const f16* P = WSP(f16, WS_P);
    const float* cosT = WSP(float, WS_ROPE); const float* sinT = cosT + 2048 * 32;
    f16* GT = WSP(f16, WS_GATED) + (size_t)2 * MROWS * 1024;
    const int nrows = l == 0 ? MROWS : NLAT;
    const int d = F.lane, f = d & 31;
    for (int it = F.gw; it < nrows * 16; it += F.NGW) {
        const int row = it >> 4, hq = it & 15, kv = hq >> 3;
        const bool lat = row < NLAT; const int b = lat ? row / SEQ : (row - NLAT) / CTXL, p = row & (SEQ - 1);
        const float t1 = (float)P[(size_t)row * NPAD + C_GQ + hq * 64 + f], t2 = (float)P[(size_t)row * NPAD + C_GQ + hq * 64 + 32 + f];
        float q;
        if (lat) { const float c = cosT[p * 32 + f], s = sinT[p * 32 + f]; q = d < 32 ? t1 * c - t2 * s : t1 * s + t2 * c; } else q = d < 32 ? t1 : t2;
        q *= 0.125f;
        float m = INP(I_GSINK, l, 16)[hq], lsum = 1.0f, acc = 0.f;
        const int nkeys = CTXL + (lat ? (min(p + 128, SEQ - 1) - max(p - 128, 0) + 1) : 0);
        for (int j = 0; j < nkeys; ++j) {
            const int krow = j < CTXL ? NLAT + b * CTXL + j : b * SEQ + max(p - 128, 0) + (j - CTXL);
            const float s = wave_sum(q * (float)P[(size_t)krow * NPAD + C_GK + kv * 64 + d]);
            const float v = (float)P[(size_t)krow * NPAD + C_GV + kv * 64 + d];
            const float mn = fmaxf(m, s), corr = fast_exp(m - mn), pe = fast_exp(s - mn);
            lsum = lsum * corr + pe; acc = acc * corr + pe * v; m = mn;
        }
        const float y = acc / lsum;
        GT[(size_t)row * 1024 + hq * 64 + d] = (f16)(y * siluf_((float)P[(size_t)row * NPAD + C_GZ + hq * 64 + d]));
    }
}
__device__ __forceinline__ void mla_naive(Frame& F, int l) {
    const f16* P = WSP(f16, WS_P); const f16* QM = WSP(f16, WS_QM); const f16* KVM = WSP(f16, WS_KVM);
    const float* cosT = WSP(float, WS_ROPE); const float* sinT = cosT + 2048 * 32;
    f16* GT = WSP(f16, WS_GATED) + (size_t)1 * MROWS * 1024;
    const int nrows = l == 0 ? MROWS : NLAT;
    const int d = F.lane, f = d & 31;
    const float scale = 0.07216878364870322f;
    for (int it = F.gw; it < nrows * 8; it += F.NGW) {
        const int row = it >> 3, h = it & 7;
        const bool lat = row < NLAT; const int b = lat ? row / SEQ : (row - NLAT) / CTXL, p = row & (SEQ - 1);
        const f16* qr = QM + (size_t)row * 1536 + h * 192;
        const float q0 = (float)qr[d] * scale, q1 = (float)qr[64 + d] * scale;
        const float t1 = (float)qr[128 + f], t2 = (float)qr[128 + 32 + f];
        float qp;
        if (lat) { const float c = cosT[p * 32 + f], s = sinT[p * 32 + f]; qp = d < 32 ? t1 * c - t2 * s : t1 * s + t2 * c; } else qp = d < 32 ? t1 : t2;
        qp *= scale;
        float m = -1e30f, lsum = 0.f, a0 = 0.f, a1 = 0.f;
        const int nkeys = CTXL + (lat ? SEQ : 0);
        for (int j = 0; j < nkeys; ++j) {
            const int krow = j < CTXL ? NLAT + b * CTXL + j : b * SEQ + (j - CTXL);
            const f16* kr = KVM + (size_t)krow * 2048 + h * 256;
            const float s = wave_sum(q0 * (float)kr[d] + q1 * (float)kr[64 + d] + qp * (float)P[(size_t)krow * NPAD + C_KPE + d]);
            const float v0 = (float)kr[128 + d], v1 = (float)kr[192 + d];
            const float mn = fmaxf(m, s), corr = fast_exp(m - mn), pe = fast_exp(s - mn);
            lsum = lsum * corr + pe; a0 = a0 * corr + pe * v0; a1 = a1 * corr + pe * v1; m = mn;
        }
        const float inv = 1.0f / lsum;
        const f16* zr = P + (size_t)row * NPAD + C_MZ + h * 128;
        GT[(size_t)row * 1024 + h * 128 + d] = (f16)(a0 * inv * siluf_((float)zr[d]));
        GT[(size_t)row * 1024 + h * 128 + 64 + d] = (f16)(a1 * inv * siluf_((float)zr[64 + d]));
    }
}
__device__ __forceinline__ void hyena_naive(Frame& F, int l) {
    const float* HW = (const float*)(F.ws + WS_SB); const float* HM = HW + (size_t)MROWS * 1024;
    f16* GT = WSP(f16, WS_GATED) + (size_t)3 * MROWS * 1024;
    const int nlat_items = NB * (SEQ / 8) * 16, nctx_items = (l == 0) ? NB * (CTXL / 8) * 16 : 0;
    for (int it = F.bid; it < nlat_items + nctx_items; it += F.G) {
        const bool isctx = it >= nlat_items; const int q = isctx ? it - nlat_items : it;
        const int n = isctx ? CTXL : SEQ, cg = q & 15, pb = (q >> 4) % (n / 8), b = (q >> 4) / (n / 8);
        const int i = pb * 8 + F.wave, c = cg * 64 + F.lane;
        const int row0 = isctx ? NLAT + b * CTXL : b * SEQ;
        const f16* hf = (const f16*)(F.ws + WS_HF + (size_t)l * HF_LAYER + (isctx ? HF_LAT : 0));
        float acc = 0.f;
#pragma unroll 4
        for (int j = 0; j < n; ++j) acc += (float)hf[(size_t)(n - (i - j)) * 1024 + c] * HW[(size_t)(row0 + j) * 1024 + c];
        const size_t o = (size_t)(row0 + i) * 1024 + c;
        GT[o] = (f16)(HM[o] * (acc + HW[o] * INP(I_HD, l, 1024)[c]));
    }
}

namespace att {
typedef short s16x4 __attribute__((ext_vector_type(4)));
__device__ __forceinline__ int crow(int r, int hi) { return (r & 3) + 8 * (r >> 2) + 4 * hi; }
#define ATT_SBAR() __builtin_amdgcn_sched_barrier(0)
__device__ __forceinline__ int v_rd_base(int lane) { return ((lane & 3) << 3) | (((lane >> 2) & 3) << 6) | (((lane >> 4) & 1) << 5) | (((lane >> 5) & 1) << 8); }
template <int OFF> __device__ __forceinline__ s16x4 tr_read(int vb) { s16x4 r; asm volatile("ds_read_b64_tr_b16 %0, %1 offset:%2" : "=&v"(r) : "v"(vb), "i"(OFF) : "memory"); return r; }

template <bool MLA> struct Cfg {
    static constexpr int DQK = MLA ? 192 : 64, DV = MLA ? 128 : 64, NCB = DV / 32, ND0 = DQK / 16;
    static constexpr int KROWB = DQK * 2 + 16, SHM_K = 64 * KROWB, SHM_V = 64 * DV * 2;
    static constexpr int OFF_V = 0, OFF_K = 2 * SHM_V, OFF_WS = 2 * SHM_V + 2 * SHM_K, OFF_Q = OFF_WS + 8 * 64 * 4, LDS_TOTAL = OFF_Q + (MLA ? 8 * 32 * 144 : 0);
    static constexpr int NREG = MLA ? 8 : 4;
};
template <int NCB> __device__ __forceinline__ int v_st(int k, int c) { const int kk = (k & ~0xC) | ((k & 4) << 1) | ((k & 8) >> 1); return ((kk >> 3) * NCB + (c >> 5)) * 512 + ((kk & 7) * 32 + (c & 31)) * 2; }

__device__ __forceinline__ void partialSM(f32x16& p0, f32x16& p1, float& m_reg, float& alpha, const float C, const float thr_raw) {
    float pmax = p0[0];
#pragma unroll
    for (int r = 1; r < 16; ++r) pmax = fmaxf(pmax, p0[r]);
#pragma unroll
    for (int r = 0; r < 16; ++r) pmax = fmaxf(pmax, p1[r]);
    { auto rr = __builtin_amdgcn_permlane32_swap(__float_as_uint(pmax), __float_as_uint(pmax), false, false); pmax = fmaxf(__uint_as_float(rr[0]), __uint_as_float(rr[1])); }
    float mn;
    if (__builtin_expect(__all(pmax - m_reg <= thr_raw), 1)) { mn = m_reg; alpha = 1.f; }
    else { mn = fmaxf(m_reg, pmax); alpha = __builtin_amdgcn_exp2f((m_reg - mn) * C); m_reg = mn; }
    const float mnC = -mn * C;
#pragma unroll
    for (int r = 0; r < 16; ++r) p0[r] = fmaf(p0[r], C, mnC);
#pragma unroll
    for (int r = 0; r < 16; ++r) p1[r] = fmaf(p1[r], C, mnC);
#pragma unroll
    for (int r = 0; r < 16; ++r) p0[r] = __builtin_amdgcn_exp2f(p0[r]);
}
__device__ __forceinline__ void finishSM(f32x16& p0, f32x16& p1, float alpha, float& l_reg, f16x8& pa0, f16x8& pa1, f16x8& pa2, f16x8& pa3) {
#pragma unroll
    for (int r = 0; r < 16; ++r) p1[r] = __builtin_amdgcn_exp2f(p1[r]);
    float ps = 0;
#pragma unroll
    for (int r = 0; r < 16; ++r) ps += p0[r];
#pragma unroll
    for (int r = 0; r < 16; ++r) ps += p1[r];
    { auto rr = __builtin_amdgcn_permlane32_swap(__float_as_uint(ps), __float_as_uint(ps), false, false); ps = __uint_as_float(rr[0]) + __uint_as_float(rr[1]); }
    l_reg = l_reg * alpha + ps;
#define ATT_PK4(P, BASE, OUT) do { unsigned a0 = pkh(P[BASE + 0], P[BASE + 1]), a1 = pkh(P[BASE + 2], P[BASE + 3]); \
    unsigned b0 = pkh(P[BASE + 4], P[BASE + 5]), b1 = pkh(P[BASE + 6], P[BASE + 7]); \
    auto r0 = __builtin_amdgcn_permlane32_swap(a0, b0, false, false); auto r1 = __builtin_amdgcn_permlane32_swap(a1, b1, false, false); \
    u32x4 w = {r0[0], r1[0], r0[1], r1[1]}; OUT = __builtin_bit_cast(f16x8, w); } while (0)
    ATT_PK4(p0, 0, pa0); ATT_PK4(p0, 8, pa1); ATT_PK4(p1, 0, pa2); ATT_PK4(p1, 8, pa3);
#undef ATT_PK4
}
template <int ND0, int NREG, int KROWB> __device__ __forceinline__ void qkt(f32x16& p0, f32x16& p1, const LAS char* Ks, const f16x8* qr, const LAS char* ql, int r32, int hi) {
    p0 = f32x16{}; p1 = f32x16{};
#pragma unroll
    for (int d0 = 0; d0 < ND0; ++d0) { const int cb = (d0 * 16 + hi * 8) * 2;
        const f16x8 b0 = *(const LAS f16x8*)(Ks + r32 * KROWB + cb);
        const f16x8 b1 = *(const LAS f16x8*)(Ks + (32 + r32) * KROWB + cb);
        f16x8 qf; if (d0 < NREG) qf = qr[d0 < NREG ? d0 : 0]; else qf = *(const LAS f16x8*)(ql + (d0 - NREG) * 32);
        p0 = __builtin_amdgcn_mfma_f32_32x32x16_f16(b0, qf, p0, 0, 0, 0);
        p1 = __builtin_amdgcn_mfma_f32_32x32x16_f16(b1, qf, p1, 0, 0, 0); }
}
template <int NCB, int D0> __device__ __forceinline__ void pv_one(f32x16& od, int vb, f16x8 pa0, f16x8 pa1, f16x8 pa2, f16x8 pa3) {
    constexpr int KS = 2 * NCB * 512, HF = NCB * 512, B0 = D0 * 512;
    const s16x4 l0 = tr_read<B0 + 0 * KS>(vb), h0 = tr_read<B0 + 0 * KS + HF>(vb), l1 = tr_read<B0 + 1 * KS>(vb), h1 = tr_read<B0 + 1 * KS + HF>(vb);
    const s16x4 l2 = tr_read<B0 + 2 * KS>(vb), h2 = tr_read<B0 + 2 * KS + HF>(vb), l3 = tr_read<B0 + 3 * KS>(vb), h3 = tr_read<B0 + 3 * KS + HF>(vb);
    asm volatile("s_waitcnt lgkmcnt(0)" ::: "memory"); ATT_SBAR();
#define ATT_PK(L, H) __builtin_bit_cast(f16x8, (short __attribute__((ext_vector_type(8)))){L[0], L[1], L[2], L[3], H[0], H[1], H[2], H[3]})
    od = __builtin_amdgcn_mfma_f32_32x32x16_f16(pa0, ATT_PK(l0, h0), od, 0, 0, 0);
    od = __builtin_amdgcn_mfma_f32_32x32x16_f16(pa1, ATT_PK(l1, h1), od, 0, 0, 0);
    od = __builtin_amdgcn_mfma_f32_32x32x16_f16(pa2, ATT_PK(l2, h2), od, 0, 0, 0);
    od = __builtin_amdgcn_mfma_f32_32x32x16_f16(pa3, ATT_PK(l3, h3), od, 0, 0, 0);
#undef ATT_PK
}
template <int NCB> __device__ __forceinline__ void pv_all(f32x16* o, int vb, f16x8 pa0, f16x8 pa1, f16x8 pa2, f16x8 pa3) {
    pv_one<NCB, 0>(o[0], vb, pa0, pa1, pa2, pa3); pv_one<NCB, 1>(o[1], vb, pa0, pa1, pa2, pa3);
    if constexpr (NCB == 4) { pv_one<NCB, 2>(o[2], vb, pa0, pa1, pa2, pa3); pv_one<NCB, 3>(o[3], vb, pa0, pa1, pa2, pa3); }
}

struct UnitDesc { int b, h, qb, isctx, hp; };
template <bool MLA>
__device__ __forceinline__ void attn_unit(Frame& F, const UnitDesc u, int l, LAS char* lds) {
    typedef Cfg<MLA> C_;
    constexpr int DQK = C_::DQK, DV = C_::DV, NCB = C_::NCB, ND0 = C_::ND0, KROWB = C_::KROWB, NREG = C_::NREG;
    const int tid = F.tid, wid = F.wave, lane = F.lane, r32 = lane & 31, hi = lane >> 5;
    TP_BEGIN(MLA ? 3 : 4);
    LAS char* V_lds = lds + C_::OFF_V; LAS char* K_lds = lds + C_::OFF_K;
    LAS float* ws = (LAS float*)(lds + C_::OFF_WS) + wid * 64; LAS float* li_l = ws; LAS float* al_l = ws + 32;
    const f16* P = WSP(f16, WS_P); const f16* KVM = WSP(f16, WS_KVM);
    const float scale = MLA ? 0.07216878364870322f : 0.125f, Cc = scale * 1.4426950408889634f, thr_raw = 8.0f / scale;
    int qrow0, qpos0, hq;
    if constexpr (MLA) { hq = u.h; qpos0 = u.qb * 256 + wid * 32; qrow0 = (u.isctx ? NLAT + u.b * CTXL : u.b * SEQ) + qpos0; }
    else { hq = u.h * 8 + u.hp * 2 + (wid >> 2); qpos0 = u.qb * 128 + (wid & 3) * 32; qrow0 = (u.isctx ? NLAT + u.b * CTXL : u.b * SEQ) + qpos0; }
    f16x8 qr[ND0];
    { const f16* Qw = MLA ? WSP(f16, WS_QM) + (size_t)(qrow0 + r32) * 1536 + hq * 192 + hi * 8 : P + (size_t)(qrow0 + r32) * NPAD + C_GQ + hq * 64 + hi * 8;
#pragma unroll
      for (int d0 = 0; d0 < ND0; ++d0) qr[d0] = *reinterpret_cast<const f16x8*>(Qw + d0 * 16);
      if (!u.isctx) {
          constexpr int R0 = ND0 - 4;
          const float* cosT = WSP(float, WS_ROPE) + (size_t)(qpos0 + r32) * 32; const float* sinT = cosT + 2048 * 32;
#pragma unroll
          for (int i = 0; i < 2; ++i) {
              const f32x4 c0 = *(const f32x4*)(cosT + 16 * i + 8 * hi), c1 = *(const f32x4*)(cosT + 16 * i + 8 * hi + 4);
              const f32x4 s0 = *(const f32x4*)(sinT + 16 * i + 8 * hi), s1 = *(const f32x4*)(sinT + 16 * i + 8 * hi + 4);
              f16x8 a = qr[R0 + i], b2 = qr[R0 + i + 2], oa, ob;
#pragma unroll
              for (int j = 0; j < 8; ++j) { const float cc = j < 4 ? c0[j] : c1[j - 4], ss = j < 4 ? s0[j] : s1[j - 4]; const float t1 = (float)a[j], t2 = (float)b2[j];
                  oa[j] = (f16)(t1 * cc - t2 * ss); ob[j] = (f16)(t1 * ss + t2 * cc); }
              qr[R0 + i] = oa; qr[R0 + i + 2] = ob; }
      } }
    const LAS char* ql = lds + C_::OFF_Q + wid * (32 * 144) + r32 * 144 + hi * 16;
    f16x8 qreg[NREG];
#pragma unroll
    for (int d0 = 0; d0 < NREG; ++d0) qreg[d0] = qr[d0];
    if constexpr (ND0 > NREG) { __syncthreads();
#pragma unroll
        for (int d0 = NREG; d0 < ND0; ++d0) *(LAS f16x8*)(lds + C_::OFF_Q + wid * (32 * 144) + r32 * 144 + hi * 16 + (d0 - NREG) * 32) = qr[d0]; }
    const int kstart = MLA ? 0 : max(0, 128 * (u.qb - 1));
    const int nlat_tiles = u.isctx ? 0 : (MLA ? 32 : ((u.qb == 0 || u.qb == 15) ? 4 : 6));
    const int NT = 4 + nlat_tiles;
    const int sk = tid >> 3, sj = tid & 7;
    const int ctxrow0 = NLAT + u.b * CTXL, latrow0 = u.b * SEQ + kstart;
#define ATT_KROW(t) ((t) < 4 ? ctxrow0 + 64 * (t) : latrow0 + 64 * ((t) - 4))
    u32x4 aK0, aK1, aK2, aV0, aV1, bK0, bK1, bK2, bV0, bV1;
#define ATT_LOAD(S, t) do { const int kr_ = ATT_KROW(t) + sk; \
      if constexpr (MLA) { const f16* kp_ = KVM + (size_t)kr_ * 2048 + u.h * 256 + sj * 8; \
          S##K0 = *(const u32x4*)kp_; S##K1 = *(const u32x4*)(kp_ + 64); S##K2 = *(const u32x4*)(P + (size_t)kr_ * NPAD + C_KPE + sj * 8); \
          S##V0 = *(const u32x4*)(kp_ + 128); S##V1 = *(const u32x4*)(kp_ + 192); } \
      else { S##K0 = *(const u32x4*)(P + (size_t)kr_ * NPAD + C_GK + u.h * 64 + sj * 8); S##V0 = *(const u32x4*)(P + (size_t)kr_ * NPAD + C_GV + u.h * 64 + sj * 8); } } while (0)
#define ATT_KWRITE(S, bf) do { LAS char* kb_ = K_lds + (bf) * C_::SHM_K + sk * KROWB + sj * 16; *(LAS u32x4*)kb_ = S##K0; \
      if constexpr (MLA) { *(LAS u32x4*)(kb_ + 128) = S##K1; *(LAS u32x4*)(kb_ + 256) = S##K2; } } while (0)
#define ATT_VWRITE(S, bf) do { LAS char* vb_ = V_lds + (bf) * C_::SHM_V; *(LAS u32x4*)(vb_ + v_st<NCB>(sk, sj * 8)) = S##V0; \
      if constexpr (MLA) { *(LAS u32x4*)(vb_ + v_st<NCB>(sk, 64 + sj * 8)) = S##V1; } } while (0)
#define ATT_RESC(a) do { if (__any((a) < 1.f)) { if (hi == 0) al_l[r32] = (a); asm volatile("s_waitcnt lgkmcnt(0)" ::: "memory"); \
      _Pragma("unroll") for (int d = 0; d < NCB; ++d) _Pragma("unroll") for (int r = 0; r < 16; ++r) o[d][r] *= al_l[crow(r, hi)]; } } while (0)
#define ATT_MASK(p0, p1, t) do { if constexpr (!MLA) { if ((t) >= 4) { const int kb_ = kstart + 64 * ((t) - 4) + 4 * hi - (qpos0 + r32); \
      if (kb_ < -128 || kb_ + 63 > 128) { _Pragma("unroll") for (int r = 0; r < 16; ++r) { const int dk = kb_ + (r & 3) + 8 * (r >> 2); \
          if (dk < -128 || dk > 128) p0[r] = -1e30f; if (dk + 32 < -128 || dk + 32 > 128) p1[r] = -1e30f; } } } } } while (0)
    const int vb0 = (int)(unsigned)(uintptr_t)V_lds + v_rd_base(lane);
    float m_reg = -1e30f, l_reg = 0.f, alA; f32x16 o[NCB];
#pragma unroll
    for (int d = 0; d < NCB; ++d) o[d] = f32x16{};
    f32x16 pA0, pA1; f16x8 pa0, pa1, pa2, pa3;
    __syncthreads();
    TP(1);
    ATT_LOAD(a, 0); ATT_KWRITE(a, 0); ATT_VWRITE(a, 0); __syncthreads();
    ATT_LOAD(a, 1); if (2 < NT) ATT_LOAD(b, 2);
#define ATT_STEP(t, bf, S) do { \
        TP(2); qkt<ND0, NREG, KROWB>(pA0, pA1, K_lds + (bf) * C_::SHM_K, qreg, ql, r32, hi); ATT_MASK(pA0, pA1, t); TP(3); \
        partialSM(pA0, pA1, m_reg, alA, Cc, thr_raw); \
        ATT_RESC(alA); \
        finishSM(pA0, pA1, alA, l_reg, pa0, pa1, pa2, pa3); ATT_SBAR(); TP(4); \
        if ((t) + 1 < NT) { ATT_KWRITE(S, (bf) ^ 1); } ATT_SBAR(); \
        pv_all<NCB>(o, vb0 + (bf) * C_::SHM_V, pa0, pa1, pa2, pa3); TP(5); \
        if ((t) + 1 < NT) { ATT_VWRITE(S, (bf) ^ 1); } \
        if ((t) + 3 < NT) { ATT_LOAD(S, (t) + 3); } \
        __syncthreads(); TP(6); } while (0)
#pragma unroll 1
    for (int t = 0; t < NT; t += 2) { ATT_STEP(t, 0, a); ATT_STEP(t + 1, 1, b); }
#undef ATT_STEP
    if constexpr (!MLA) l_reg += __builtin_amdgcn_exp2f(INP(I_GSINK, l, 16)[hq] * 1.4426950408889634f - m_reg * Cc);
    if (hi == 0) li_l[r32] = l_reg; asm volatile("s_waitcnt lgkmcnt(0)" ::: "memory");
    f16* GT = WSP(f16, WS_GATED) + (size_t)(MLA ? 1 : 2) * MROWS * 1024;
    const int zc = MLA ? C_MZ + hq * 128 : C_GZ + hq * 64, oc = MLA ? hq * 128 : hq * 64;
    LAS char* tile = lds + wid * (32 * DV * 2);
    constexpr int PPR = DV / 8;
    { u32x4 zt[DV / 16];
#pragma unroll
      for (int k = 0; k < DV / 16; ++k) { const int pc = lane + 64 * k, rw = pc / PPR, ck = pc % PPR; zt[k] = *(const u32x4*)(P + (size_t)(qrow0 + rw) * NPAD + zc + ck * 8); }
#pragma unroll
      for (int k = 0; k < DV / 16; ++k) { const int pc = lane + 64 * k, rw = pc / PPR, ck = pc % PPR; *(LAS u32x4*)(tile + rw * (DV * 2) + ck * 16) = zt[k]; } }
    f16 zr_[16][NCB];
#pragma unroll
    for (int r = 0; r < 16; ++r)
#pragma unroll
        for (int d0 = 0; d0 < NCB; ++d0) zr_[r][d0] = *(const LAS f16*)(tile + crow(r, hi) * (DV * 2) + (d0 * 32 + r32) * 2);
#pragma unroll
    for (int r = 0; r < 16; ++r) { const float rl = __builtin_amdgcn_rcpf(li_l[crow(r, hi)]);
#pragma unroll
        for (int d0 = 0; d0 < NCB; ++d0) *(LAS unsigned short*)(tile + crow(r, hi) * (DV * 2) + (d0 * 32 + r32) * 2) = (unsigned short)pkb(o[d0][r] * rl * siluf_((float)zr_[r][d0]), 0.f); }
#pragma unroll
    for (int k = 0; k < DV / 16; ++k) { const int pc = lane + 64 * k, rw = pc / PPR, ck = pc % PPR;
        *(u32x4*)(GT + (size_t)(qrow0 + rw) * 1024 + oc + ck * 8) = *(const LAS u32x4*)(tile + rw * (DV * 2) + ck * 16); }
    TP(7); if (!u.isctx) TP_END();
#undef ATT_KROW
#undef ATT_LOAD
#undef ATT_KWRITE
#undef ATT_VWRITE
#undef ATT_RESC
#undef ATT_MASK
}
#undef ATT_SBAR
}

__device__ __forceinline__ void mla_phase(Frame& F, int l) {
    const int nunits = 256 + (l == 0 ? 32 : 0);
    for (int it = F.bid; it < nunits; it += F.G) {
        att::UnitDesc u;
        if (it < 256) { u.b = it >> 6; u.h = (it >> 3) & 7; u.qb = it & 7; u.isctx = 0; } else { const int q = it - 256; u.b = q >> 3; u.h = q & 7; u.qb = 0; u.isctx = 1; }
        u.hp = 0;
        att::attn_unit<true>(F, u, l, (LAS char*)F.lds);
    }
}
__device__ __forceinline__ void gqa_phase(Frame& F, int l) {
    const int nunits = 512 + (l == 0 ? 64 : 0);
    for (int it = F.bid; it < nunits; it += F.G) {
        att::UnitDesc u;
        if (it < 512) { u.b = it >> 7; u.h = (it >> 6) & 1; u.qb = (it >> 2) & 15; u.hp = it & 3; u.isctx = 0; }
        else { const int q = it - 512; u.b = q >> 4; u.h = (q >> 3) & 1; u.qb = (q >> 2) & 1; u.hp = q & 3; u.isctx = 1; }
        att::attn_unit<false>(F, u, l, (LAS char*)F.lds);
    }
}

#ifndef HY_PROBE
#define HY_PROBE 0
#endif
namespace hy {
constexpr int FREG = 8448;
constexpr int WBLK = 80;
constexpr int WREG = 65 * WBLK;
constexpr int OFF_F = 0, OFF_W = 8 * FREG, OFF_CW = OFF_W + 8 * WREG, LDS_TOTAL = OFF_CW + 512;
static_assert(LDS_TOTAL <= RING_BYTES, "hyena LDS");

__device__ __forceinline__ const f16* pcp(const f16* PC, int col, int row) { return PC + ((size_t)pc_chunk(col) * MROWS + row) * 8; }
__device__ __forceinline__ void load8(const f16* p, float (&o)[8]) { const f16x8 v = *(const f16x8*)p;
#pragma unroll
    for (int j = 0; j < 8; ++j) o[j] = (float)v[j]; }

__device__ __forceinline__ void conv8(const f16* P, int row0, int i, int n, int col, const LAS float* cw, int t, float (&o)[8]) {
    float a[8], b[8], c[8];
    load8(pcp(P, col, row0 + i), b);
    if (i > 0) load8(pcp(P, col, row0 + i - 1), a); else {
#pragma unroll
        for (int j = 0; j < 8; ++j) a[j] = 0.f; }
    if (i < n - 1) load8(pcp(P, col, row0 + i + 1), c); else {
#pragma unroll
        for (int j = 0; j < 8; ++j) c[j] = 0.f; }
#pragma unroll
    for (int j = 0; j < 8; ++j) o[j] = cw[(t * 4 + 0) * 8 + j] * a[j] + cw[(t * 4 + 1) * 8 + j] * b[j] + cw[(t * 4 + 2) * 8 + j] * c[j] + cw[(t * 4 + 3) * 8 + j];
}

struct Raw3 { f16x8 a, b, c; };
__device__ __forceinline__ Raw3 load3(const f16* P, int row0, int i, int n, int col) {
    Raw3 r; const f16x8 z = {0, 0, 0, 0, 0, 0, 0, 0};
    const f16* p = pcp(P, col, row0 + i);
    r.b = *(const f16x8*)p;
    r.a = i > 0 ? *(const f16x8*)(p - 8) : z;
    r.c = i < n - 1 ? *(const f16x8*)(p + 8) : z;
    return r;
}
__device__ __forceinline__ void conv3x8(const Raw3& r, const LAS float* cw, int t, float (&o)[8]) {
#pragma unroll
    for (int j = 0; j < 8; ++j) o[j] = cw[(t * 4 + 0) * 8 + j] * (float)r.a[j] + cw[(t * 4 + 1) * 8 + j] * (float)r.b[j] + cw[(t * 4 + 2) * 8 + j] * (float)r.c[j] + cw[(t * 4 + 3) * 8 + j];
}
__device__ __forceinline__ void hyena_unit(Frame& F, int l, int b, int isctx, int cg) {
    const int tid = F.tid, lane = F.lane, wid = F.wave;
    const int n = isctx ? CTXL : SEQ, nblk = n / 32, c0 = cg * 8;
    const int row0 = isctx ? NLAT + b * CTXL : b * SEQ;
    const f16* P = WSP(f16, WS_PC);
    LAS char* lds = (LAS char*)F.lds;
    LAS float* cw = (LAS float*)(lds + OFF_CW);
    TP_BEGIN(2);
    for (int rp_ = 0; rp_ < (HY_PROBE == 1 ? 2 : 1); ++rp_) {
    __syncthreads();
    if (tid < 96) { const int t = tid / 32, q = (tid % 32) / 8, j = tid & 7; const int ch = t * 1024 + c0 + j;
        cw[(t * 4 + q) * 8 + j] = q < 3 ? INP(I_HCW, l, 3 * 3072)[q * 3072 + ch] : INP(I_HCB, l, 3072)[ch]; }
    { const f16* hf = (const f16*)(F.ws + WS_HF + (size_t)l * HF_LAYER + (isctx ? HF_LAT : 0)) + (size_t)cg * (2 * n) * 8;
      if (!isctx) { f16x8 v[8];
#pragma unroll
          for (int q = 0; q < 8; ++q) v[q] = *(const f16x8*)(hf + (size_t)(tid + q * NTHREADS) * 8);
#pragma unroll
          for (int q = 0; q < 8; ++q)
#pragma unroll
              for (int j = 0; j < 8; ++j) *(LAS f16*)(lds + OFF_F + j * FREG + (tid + q * NTHREADS) * 2) = v[q][j]; }
      else { const f16x8 v = *(const f16x8*)(hf + (size_t)tid * 8);
#pragma unroll
          for (int j = 0; j < 8; ++j) *(LAS f16*)(lds + OFF_F + j * FREG + tid * 2) = v[j]; } }
    if (tid < 8 * 5) { const int j = tid / 5, q = tid % 5; *(LAS u32x4*)(lds + OFF_W + j * WREG + nblk * WBLK + q * 16) = (u32x4){0u, 0u, 0u, 0u}; }
    __syncthreads();
    TP(1);
    if (!isctx) { Raw3 r1[4], r2[4];
#pragma unroll
        for (int q = 0; q < 4; ++q) { r1[q] = load3(P, row0, tid + q * NTHREADS, n, C_HXV + 1024 + c0); r2[q] = load3(P, row0, tid + q * NTHREADS, n, C_HXV + 2048 + c0); }
#pragma unroll
        for (int q = 0; q < 4; ++q) { const int i = tid + q * NTHREADS; float x1[8], vv[8]; conv3x8(r1[q], cw, 1, x1); conv3x8(r2[q], cw, 2, vv);
#pragma unroll
            for (int j = 0; j < 8; ++j) *(LAS f16*)(lds + OFF_W + j * WREG + (i >> 5) * WBLK + (i & 31) * 2) = (f16)(x1[j] * vv[j]); } }
    else if (tid < n) { const int i = tid; float x1[8], vv[8];
        conv8(P, row0, i, n, C_HXV + 1024 + c0, cw, 1, x1); conv8(P, row0, i, n, C_HXV + 2048 + c0, cw, 2, vv);
#pragma unroll
        for (int j = 0; j < 8; ++j) *(LAS f16*)(lds + OFF_W + j * WREG + (i >> 5) * WBLK + (i & 31) * 2) = (f16)(x1[j] * vv[j]); }
    __syncthreads();
    }
    TP(2);
    f32x16 acc0 = f32x16{}, acc1 = f32x16{};
    for (int rp_ = 0; rp_ < (HY_PROBE == 2 ? 2 : 1); ++rp_) {
        if (rp_) { acc0 = f32x16{}; acc1 = f32x16{}; asm volatile("" : "+v"(acc0), "+v"(acc1)); }
        const int r = lane & 31, half = lane >> 5;
        const LAS char* fb = lds + OFF_F + wid * FREG; const LAS char* wb = lds + OFF_W + wid * WREG;
        struct Fr { unsigned d0, d1, d2, d3, d4, e0, e1, e2, e3, e4, sh; f16x8 b00, b01, b10, b11; };
#define HY_LOAD(FR, dd, T0, T1) do { const int y0_ = n - 32 * (dd) - r + 8 * half; FR.sh = (unsigned)(y0_ & 1) << 4; \
            const LAS unsigned* fp_ = (const LAS unsigned*)(fb + ((y0_ >> 1) << 2)); \
            FR.d0 = fp_[0]; FR.d1 = fp_[1]; FR.d2 = fp_[2]; FR.d3 = fp_[3]; FR.d4 = fp_[4]; FR.e0 = fp_[8]; FR.e1 = fp_[9]; FR.e2 = fp_[10]; FR.e3 = fp_[11]; FR.e4 = fp_[12]; \
            if (T0) { int blk_ = r - (dd); blk_ = (blk_ >= 0 && blk_ < nblk) ? blk_ : nblk; const LAS char* bp_ = wb + blk_ * WBLK + 16 * half; FR.b00 = *(const LAS f16x8*)bp_; FR.b01 = *(const LAS f16x8*)(bp_ + 32); } \
            if (T1) { int blk_ = 32 + r - (dd); blk_ = (blk_ >= 0 && blk_ < nblk) ? blk_ : nblk; const LAS char* bp_ = wb + blk_ * WBLK + 16 * half; FR.b10 = *(const LAS f16x8*)bp_; FR.b11 = *(const LAS f16x8*)(bp_ + 32); } } while (0)
#define HY_MMA(FR, T0, T1) do { u32x4 a0w_, a1w_; \
            a0w_[0] = __builtin_amdgcn_alignbit(FR.d1, FR.d0, FR.sh); a0w_[1] = __builtin_amdgcn_alignbit(FR.d2, FR.d1, FR.sh); a0w_[2] = __builtin_amdgcn_alignbit(FR.d3, FR.d2, FR.sh); a0w_[3] = __builtin_amdgcn_alignbit(FR.d4, FR.d3, FR.sh); \
            a1w_[0] = __builtin_amdgcn_alignbit(FR.e1, FR.e0, FR.sh); a1w_[1] = __builtin_amdgcn_alignbit(FR.e2, FR.e1, FR.sh); a1w_[2] = __builtin_amdgcn_alignbit(FR.e3, FR.e2, FR.sh); a1w_[3] = __builtin_amdgcn_alignbit(FR.e4, FR.e3, FR.sh); \
            const f16x8 A0_ = __builtin_bit_cast(f16x8, a0w_), A1_ = __builtin_bit_cast(f16x8, a1w_); \
            if (T0) { acc0 = __builtin_amdgcn_mfma_f32_32x32x16_f16(A0_, FR.b00, acc0, 0, 0, 0); acc0 = __builtin_amdgcn_mfma_f32_32x32x16_f16(A1_, FR.b01, acc0, 0, 0, 0); } \
            if (T1) { acc1 = __builtin_amdgcn_mfma_f32_32x32x16_f16(A0_, FR.b10, acc1, 0, 0, 0); acc1 = __builtin_amdgcn_mfma_f32_32x32x16_f16(A1_, FR.b11, acc1, 0, 0, 0); } } while (0)
#define HY_RANGE(lo, hi, T0, T1) do { if ((lo) <= (hi)) { Fr fa_, fb2_, fc_; HY_LOAD(fa_, (lo), T0, T1); if ((lo) + 1 <= (hi)) HY_LOAD(fb2_, (lo) + 1, T0, T1); \
            _Pragma("unroll 1") for (int dd = (lo); dd <= (hi); dd += 3) { \
                if (dd + 2 <= (hi)) HY_LOAD(fc_, dd + 2, T0, T1); \
                HY_MMA(fa_, T0, T1); \
                if (dd + 1 <= (hi)) { if (dd + 3 <= (hi)) HY_LOAD(fa_, dd + 3, T0, T1); HY_MMA(fb2_, T0, T1); \
                    if (dd + 2 <= (hi)) { if (dd + 4 <= (hi)) HY_LOAD(fb2_, dd + 4, T0, T1); HY_MMA(fc_, T0, T1); } } } } } while (0)
        const int ntile = nblk > 32 ? 2 : 1;
        if (ntile == 2) { HY_RANGE(-(nblk - 1), -32, true, false); HY_RANGE(-31, 31, true, true); HY_RANGE(32, nblk - 1, false, true); }
        else { HY_RANGE(-(nblk - 1), nblk - 1, true, false); }
#undef HY_LOAD
#undef HY_MMA
#undef HY_RANGE
        TP(3);
        asm volatile("s_waitcnt lgkmcnt(0)" ::: "memory");
        LAS float* yo = (LAS float*)(lds + OFF_F + wid * FREG);
#pragma unroll
        for (int q = 0; q < 16; ++q) { const int rr = (q & 3) + 8 * (q >> 2) + 4 * half;
            if (r < nblk) yo[(32 * r + rr) + r] = acc0[q];
            if (ntile == 2) yo[(32 * (32 + r) + rr) + (32 + r)] = acc1[q]; }
    }
    __syncthreads();
    TP(4);
    for (int rp_ = 0; rp_ < (HY_PROBE == 3 ? 2 : 1); ++rp_) {
        f16* GT = WSP(f16, WS_GATED) + (size_t)3 * MROWS * 1024;
        const float* dsk = INP(I_HD, l, 1024) + c0;
        const int nq = isctx ? 1 : 4;
        Raw3 r0[4]; f16x8 zr[4];
        const f32x4 dk0 = *(const f32x4*)dsk, dk1 = *(const f32x4*)(dsk + 4);
#pragma unroll
        for (int q = 0; q < 4; ++q) if (q < nq && tid + q * NTHREADS < n) { r0[q] = load3(P, row0, tid + q * NTHREADS, n, C_HXV + c0); zr[q] = *(const f16x8*)pcp(P, C_HZ + c0, row0 + tid + q * NTHREADS); }
#pragma unroll
        for (int q = 0; q < 4; ++q) if (q < nq && tid + q * NTHREADS < n) { const int i = tid + q * NTHREADS;
            float x0[8]; conv3x8(r0[q], cw, 0, x0);
            f32x4 o0, o1;
#pragma unroll
            for (int j = 0; j < 8; ++j) {
                const float y = *(const LAS float*)(lds + OFF_F + j * FREG + (i + (i >> 5)) * 4);
                const float w = (float)*(const LAS f16*)(lds + OFF_W + j * WREG + (i >> 5) * WBLK + (i & 31) * 2);
                const float o = x0[j] * siluf_((float)zr[q][j]) * (y + w * (j < 4 ? dk0[j & 3] : dk1[j & 3]));
                if (j < 4) o0[j] = o; else o1[j - 4] = o; }
            *(u32x4*)(GT + (size_t)(row0 + i) * 1024 + c0) = pkb8(o0, o1);
        }
    }
    TP(5); if (!isctx) TP_END();
}
}
__device__ __forceinline__ void hyena_phase(Frame& F, int l) {
    const int nunits = 512 + (l == 0 ? 512 : 0);
    for (int it = F.bid; it < nunits; it += F.G) {
        const int isctx = it >= 512, q = it & 511;
        hy::hyena_unit(F, l, q >> 7, isctx, q & 127);
    }
}

namespace ssd {
using att::s16x4; using att::tr_read; using att::v_st; using att::v_rd_base; using att::crow;
constexpr size_t L_ELEMS = (size_t)64 * 128;
__device__ __forceinline__ size_t state_index(int b, int sc, int h, int dir) { return ((((size_t)b * 18 + sc) * 16 + h) * 2 + dir) * L_ELEMS; }
constexpr int TAB_OFF = 0;
constexpr int CW_OFF = 16384;
constexpr int END_OFF = CW_OFF + 12288;
constexpr int SSQ_OFF = END_OFF + 64;
constexpr int BM_OFF = 29824;
constexpr int XS_OFF = BM_OFF + 34816;
constexpr int LDS_TOTAL = XS_OFF + 65536;
static_assert(LDS_TOTAL <= RING_BYTES, "ssd LDS");
constexpr int KROWB = 272;

struct Unit { int b, sc, g, row0, n, i0; };
__device__ __forceinline__ Unit make_unit(int b, int sc, int g) { Unit u; u.b = b; u.sc = sc; u.g = g;
    if (sc < 2) { u.row0 = NLAT + b * CTXL; u.n = CTXL; u.i0 = sc * 128; } else { u.row0 = b * SEQ; u.n = SEQ; u.i0 = (sc - 2) * 128; } return u; }

__device__ __forceinline__ void stage_common(Frame& F, const Unit& u, int l, LAS char* lds) {
    const f16* P = WSP(f16, WS_PC);
    LAS float* cw = (LAS float*)(lds + CW_OFF);
    { const float* scw = INP(I_SCW, l, 3 * 1536); const float* scb = INP(I_SCB, l, 1536);
      float cv[6];
#pragma unroll
      for (int k = 0; k < 6; ++k) { const int i = F.tid + k * NTHREADS, q = i / 768, c = i % 768;
          const int ch = c < 512 ? u.g * 512 + c : (c < 640 ? 1024 + u.g * 128 + (c - 512) : 1280 + u.g * 128 + (c - 640));
          const float* src = q < 3 ? scw + q * 1536 + ch : scb + ch; cv[k] = *src; }
#pragma unroll
      for (int k = 0; k < 6; ++k) cw[F.tid + k * NTHREADS] = cv[k]; }
    { const int h = u.g * 8 + F.wave, lane = F.lane;
      const float af = -expf(INP(I_SALOG, l, 32)[h]), ab = -expf(INP(I_SALOG, l, 32)[16 + h]);
      const float bf = INP(I_SDTB, l, 32)[h], bb = INP(I_SDTB, l, 32)[16 + h];
      const f16* pf = hy::pcp(P, C_DT + (h & ~7), u.row0 + u.i0 + 2 * lane) + (h & 7); const f16* pb = hy::pcp(P, C_DT + 16 + (h & ~7), u.row0 + u.i0 + 2 * lane) + (h & 7);
      unsigned rf0 = *(const unsigned short*)pf, rf1 = *(const unsigned short*)(pf + 8), rb0 = *(const unsigned short*)pb, rb1 = *(const unsigned short*)(pb + 8);
      asm volatile("" : "+v"(rf0), "+v"(rf1), "+v"(rb0), "+v"(rb1));
      const float xf0 = (float)__builtin_bit_cast(f16, (unsigned short)rf0), xf1 = (float)__builtin_bit_cast(f16, (unsigned short)rf1), xb0 = (float)__builtin_bit_cast(f16, (unsigned short)rb0), xb1 = (float)__builtin_bit_cast(f16, (unsigned short)rb1);
      const float dtf0 = softplusf_(xf0 + bf), dtf1 = softplusf_(xf1 + bf);
      const float dtb0 = softplusf_(xb0 + bb), dtb1 = softplusf_(xb1 + bb);
      const float laf0 = dtf0 * af, laf1 = dtf1 * af, lab0 = dtb0 * ab, lab1 = dtb1 * ab;
      float sf = laf0 + laf1, sb = lab0 + lab1;
#pragma unroll
      for (int o = 1; o < 64; o <<= 1) { const float tf = __shfl_up(sf, o), tb = __shfl_up(sb, o); if (lane >= o) { sf += tf; sb += tb; } }
      const float totb = __shfl(sb, 63), totf = __shfl(sf, 63);
      const float exf = sf - (laf0 + laf1), exb = sb - (lab0 + lab1);
      LAS f32x4* tab = (LAS f32x4*)(lds + TAB_OFF) + F.wave * 128;
      tab[2 * lane] = (f32x4){exf + laf0, totb - exb, dtf0, dtb0};
      tab[2 * lane + 1] = (f32x4){sf, totb - sb + lab1, dtf1, dtb1};
      if (lane == 0) { LAS float* en = (LAS float*)(lds + END_OFF) + F.wave * 2; en[0] = totf; en[1] = totb; } }
}
__device__ __forceinline__ hy::Raw3 xbc_load3(const f16* P, const Unit& u, int i, int cl) {
    const int col = C_XBC + (cl < 512 ? u.g * 512 + cl : (cl < 640 ? 1024 + u.g * 128 + (cl - 512) : 1280 + u.g * 128 + (cl - 640)));
    return hy::load3(P, u.row0, u.i0 + i, u.n, col);
}
__device__ __forceinline__ u32x4 conv_silu_pack(const hy::Raw3& r, int cl, const LAS float* cw) {
    float o[8];
#pragma unroll
    for (int j = 0; j < 8; ++j) o[j] = siluf_(cw[cl + j] * (float)r.a[j] + cw[768 + cl + j] * (float)r.b[j] + cw[1536 + cl + j] * (float)r.c[j] + cw[2304 + cl + j]);
    u32x4 w; w.x = pkh(o[0], o[1]); w.y = pkh(o[2], o[3]); w.z = pkh(o[4], o[5]); w.w = pkh(o[6], o[7]); return w;
}
__device__ __forceinline__ u32x4 pack8(const float (&o)[8]) { u32x4 w; w.x = pkh(o[0], o[1]); w.y = pkh(o[2], o[3]); w.z = pkh(o[4], o[5]); w.w = pkh(o[6], o[7]); return w; }
__device__ __forceinline__ void stage_x(Frame& F, const Unit& u, int hq, LAS char* lds) {
    const f16* P = WSP(f16, WS_PC); const LAS float* cw = (const LAS float*)(lds + CW_OFF);
#pragma unroll 1
    for (int k0 = 0; k0 < 8; k0 += 4) {
        hy::Raw3 r[4];
#pragma unroll
        for (int k = 0; k < 4; ++k) { const int e = F.tid + (k0 + k) * NTHREADS, i = e >> 5, q = e & 31; r[k] = xbc_load3(P, u, i, (hq * 4 + (q >> 3)) * 64 + (q & 7) * 8); }
#pragma unroll
        for (int k = 0; k < 4; ++k) { const int e = F.tid + (k0 + k) * NTHREADS, i = e >> 5, q = e & 31, hh = q >> 3, ck = q & 7;
            *(LAS u32x4*)(lds + XS_OFF + hh * 16384 + v_st<2>(i, ck * 8)) = conv_silu_pack(r[k], (hq * 4 + hh) * 64 + ck * 8, cw); } }
}
#define SSD_FRAG(L, H) __builtin_bit_cast(f16x8, (short __attribute__((ext_vector_type(8)))){L[0], L[1], L[2], L[3], H[0], H[1], H[2], H[3]})

__device__ __forceinline__ void s1_unit(Frame& F, const Unit u, int l) {
    LAS char* lds = (LAS char*)F.lds; const f16* P = WSP(f16, WS_PC);
    const int lane = F.lane, wid = F.wave, r32 = lane & 31, hi = lane >> 5;
    __syncthreads();
    stage_common(F, u, l, lds);
    __syncthreads();
    { const LAS float* cw = (const LAS float*)(lds + CW_OFF);
      hy::Raw3 r[4];
#pragma unroll
      for (int k = 0; k < 4; ++k) { const int e = F.tid + k * NTHREADS; r[k] = xbc_load3(P, u, e >> 4, 512 + (e & 15) * 8); }
#pragma unroll
      for (int k = 0; k < 4; ++k) { const int e = F.tid + k * NTHREADS, i = e >> 4, ck = e & 15;
          *(LAS u32x4*)(lds + BM_OFF + v_st<4>(i, ck * 8)) = conv_silu_pack(r[k], 512 + ck * 8, cw); } }
    if (F.tid < 16) { const int hh = F.tid >> 1, dir = F.tid & 1; const LAS float* en = (const LAS float*)(lds + END_OFF) + hh * 2;
        WSP(float, WS_DEC)[(((size_t)u.b * 18 + u.sc) * 16 + u.g * 8 + hh) * 2 + dir] = expf(en[dir]); }
#pragma unroll 1
    for (int hq = 0; hq < 2; ++hq) {
        __syncthreads();
        stage_x(F, u, hq, lds);
        __syncthreads();
        const int hh = hq * 4 + (wid >> 1), dir = wid & 1;
        const LAS f32x4* tab = (const LAS f32x4*)(lds + TAB_OFF) + hh * 128;
        const float cend = ((const LAS float*)(lds + END_OFF))[hh * 2 + dir];
        const int xb = (int)(unsigned)(uintptr_t)(lds + XS_OFF + (wid >> 1) * 16384) + v_rd_base(lane);
        const int bb = (int)(unsigned)(uintptr_t)(lds + BM_OFF) + v_rd_base(lane);
        f32x16 acc[2][4];
#pragma unroll
        for (int a = 0; a < 2; ++a)
#pragma unroll
            for (int c = 0; c < 4; ++c) acc[a][c] = f32x16{};
#define SSD_S1_STEP(KS) do { \
            f16x8 wv; { _Pragma("unroll") for (int j = 0; j < 8; ++j) { const f32x4 t = tab[(KS) * 16 + 8 * hi + j]; wv[j] = (f16)(fast_exp(cend - (dir ? t[1] : t[0])) * (dir ? t[3] : t[2])); } } \
            const s16x4 xl0 = tr_read<0 * 512 + (KS) * 2048>(xb), xh0 = tr_read<0 * 512 + (KS) * 2048 + 1024>(xb), xl1 = tr_read<1 * 512 + (KS) * 2048>(xb), xh1 = tr_read<1 * 512 + (KS) * 2048 + 1024>(xb); \
            const s16x4 bl0 = tr_read<0 * 512 + (KS) * 4096>(bb), bh0 = tr_read<0 * 512 + (KS) * 4096 + 2048>(bb), bl1 = tr_read<1 * 512 + (KS) * 4096>(bb), bh1 = tr_read<1 * 512 + (KS) * 4096 + 2048>(bb); \
            const s16x4 bl2 = tr_read<2 * 512 + (KS) * 4096>(bb), bh2 = tr_read<2 * 512 + (KS) * 4096 + 2048>(bb), bl3 = tr_read<3 * 512 + (KS) * 4096>(bb), bh3 = tr_read<3 * 512 + (KS) * 4096 + 2048>(bb); \
            asm volatile("s_waitcnt lgkmcnt(0)" ::: "memory"); __builtin_amdgcn_sched_barrier(0); \
            const f16x8 A0 = SSD_FRAG(xl0, xh0) * wv, A1 = SSD_FRAG(xl1, xh1) * wv; \
            const f16x8 B0 = SSD_FRAG(bl0, bh0), B1 = SSD_FRAG(bl1, bh1), B2 = SSD_FRAG(bl2, bh2), B3 = SSD_FRAG(bl3, bh3); \
            acc[0][0] = __builtin_amdgcn_mfma_f32_32x32x16_f16(A0, B0, acc[0][0], 0, 0, 0); acc[0][1] = __builtin_amdgcn_mfma_f32_32x32x16_f16(A0, B1, acc[0][1], 0, 0, 0); \
            acc[0][2] = __builtin_amdgcn_mfma_f32_32x32x16_f16(A0, B2, acc[0][2], 0, 0, 0); acc[0][3] = __builtin_amdgcn_mfma_f32_32x32x16_f16(A0, B3, acc[0][3], 0, 0, 0); \
            acc[1][0] = __builtin_amdgcn_mfma_f32_32x32x16_f16(A1, B0, acc[1][0], 0, 0, 0); acc[1][1] = __builtin_amdgcn_mfma_f32_32x32x16_f16(A1, B1, acc[1][1], 0, 0, 0); \
            acc[1][2] = __builtin_amdgcn_mfma_f32_32x32x16_f16(A1, B2, acc[1][2], 0, 0, 0); acc[1][3] = __builtin_amdgcn_mfma_f32_32x32x16_f16(A1, B3, acc[1][3], 0, 0, 0); } while (0)
        SSD_S1_STEP(0); SSD_S1_STEP(1); SSD_S1_STEP(2); SSD_S1_STEP(3); SSD_S1_STEP(4); SSD_S1_STEP(5); SSD_S1_STEP(6); SSD_S1_STEP(7);
#undef SSD_S1_STEP
        f16* Lo = (f16*)(F.ws + WS_SA) + state_index(u.b, u.sc, u.g * 8 + hh, dir);
#pragma unroll
        for (int a = 0; a < 2; ++a)
#pragma unroll
            for (int r = 0; r < 16; ++r) { const int p = 32 * a + crow(r, hi);
#pragma unroll
                for (int c = 0; c < 4; ++c) Lo[(size_t)p * 128 + 32 * c + r32] = (f16)acc[a][c][r]; }
    }
}
__device__ __forceinline__ void s1_phase(Frame& F, int l) {
    for (int it = F.bid; it < 4 * 18 * 2; it += F.G) { const int b = it / 36, q = it % 36; F.lane = lane_id_opaque(); F.tid = F.wave * 64 + F.lane; s1_unit(F, make_unit(b, q >> 1, q & 1), l); }
}
__device__ __forceinline__ void s2_piece(Frame& F, int piece) {
    const f16* Lb = (const f16*)(F.ws + WS_SA); f16* Sp = (f16*)(F.ws + WS_SC); const float* DEC = WSP(float, WS_DEC);
    { const int e = piece * NTHREADS + F.tid;
        const int q8 = e & 1023, dir = (e >> 10) & 1, h = (e >> 11) & 15, b = e >> 15;
        f32x4 s0 = {0.f, 0.f, 0.f, 0.f}, s1 = {0.f, 0.f, 0.f, 0.f};
#pragma unroll 1
        for (int k0 = 0; k0 < 18; k0 += 6) {
            u32x4 lr[6]; float dd[6];
#pragma unroll
            for (int j = 0; j < 6; ++j) { const int k = k0 + j, sc = dir == 0 ? k : (k < 2 ? 1 - k : 19 - k);
                const size_t off = state_index(b, sc, h, dir) + (size_t)q8 * 8;
                dd[j] = DEC[(((size_t)b * 18 + sc) * 16 + h) * 2 + dir]; lr[j] = *(const u32x4*)(Lb + off); }
#pragma unroll
            for (int j = 0; j < 6; ++j) { const int k = k0 + j, sc = dir == 0 ? k : (k < 2 ? 1 - k : 19 - k);
                const size_t off = state_index(b, sc, h, dir) + (size_t)q8 * 8;
                *(u32x4*)(Sp + off) = pkh8(s0, s1);
                const f16x8 lh = __builtin_bit_cast(f16x8, lr[j]);
                s0 = s0 * dd[j] + (f32x4){(float)lh[0], (float)lh[1], (float)lh[2], (float)lh[3]}; s1 = s1 * dd[j] + (f32x4){(float)lh[4], (float)lh[5], (float)lh[6], (float)lh[7]}; }
        }
    }
}
__device__ __forceinline__ void s3_unit(Frame& F, const Unit u, int l) {
    LAS char* lds = (LAS char*)F.lds; const f16* P = WSP(f16, WS_PC);
    TP_BEGIN(1);
    const int lane = F.lane, wid = F.wave, r32 = lane & 31, hi = lane >> 5, li = wid & 3;
    __syncthreads();
    stage_common(F, u, l, lds);
    __syncthreads(); TP(1);
    { const LAS float* cw = (const LAS float*)(lds + CW_OFF);
      hy::Raw3 r[8];
#pragma unroll
      for (int k = 0; k < 8; ++k) { const int e = F.tid + k * NTHREADS, q = e & 31; r[k] = xbc_load3(P, u, e >> 5, 512 + (q >> 4) * 128 + (q & 15) * 8); }
#pragma unroll
      for (int k = 0; k < 8; ++k) { const int e = F.tid + k * NTHREADS, i = e >> 5, q = e & 31, isc = q >> 4, ck = q & 15;
          *(LAS u32x4*)(lds + (isc ? XS_OFF : BM_OFF) + i * KROWB + ck * 16) = conv_silu_pack(r[k], 512 + isc * 128 + ck * 8, cw); } }
    if (F.tid < 256) ((LAS float*)(lds + SSQ_OFF))[F.tid] = 0.f;
    __syncthreads();
    f16x8 qr[8];
#pragma unroll
    for (int d0 = 0; d0 < 8; ++d0) qr[d0] = *(const LAS f16x8*)(lds + XS_OFF + (li * 32 + r32) * KROWB + (d0 * 16 + hi * 8) * 2);
    f32x16 gt[4];
#pragma unroll
    for (int st = 0; st < 4; ++st) { gt[st] = f32x16{};
#pragma unroll
        for (int d0 = 0; d0 < 8; ++d0) { const f16x8 bf = *(const LAS f16x8*)(lds + BM_OFF + (st * 32 + r32) * KROWB + (d0 * 16 + hi * 8) * 2);
            gt[st] = __builtin_amdgcn_mfma_f32_32x32x16_f16(bf, qr[d0], gt[st], 0, 0, 0); } }
    TP(2);
    const int lrow = li * 32 + r32;
    float ssacc[16];
#pragma unroll
    for (int r = 0; r < 16; ++r) ssacc[r] = 0.f;
    f16* GT = WSP(f16, WS_GATED);
    const f16* Sp = (const f16*)(F.ws + WS_SC);
#pragma unroll 1
    for (int hq = 0; hq < 2; ++hq) {
        __syncthreads();
        stage_x(F, u, hq, lds);
        __syncthreads(); TP(3);
#pragma unroll 1
        for (int e2 = 0; e2 < 2; ++e2) {
            const int hx = (wid >> 2) * 2 + e2, hh = hq * 4 + hx, h = u.g * 8 + hh;
            const LAS f32x4* tab = (const LAS f32x4*)(lds + TAB_OFF) + hh * 128;
            const int lane = lane_id_opaque(), r32 = lane & 31, hi = lane >> 5; const int lrow_ = li * 32 + r32;
            const f32x4 tl = tab[lrow_];
            f16x8 pa[8];
#define SSD_W(ST, R) ({ const int s_ = 32 * (ST) + (R & 3) + 8 * (R >> 2) + 4 * hi; const f32x4 ts_ = tab[s_]; \
                const float arg_ = s_ < lrow_ ? tl[0] - ts_[0] : (s_ > lrow_ ? tl[1] - ts_[1] : 0.f); \
                const float mul_ = s_ < lrow_ ? ts_[2] : (s_ > lrow_ ? ts_[3] : ts_[2] + ts_[3]); \
                gt[ST][R] * fast_exp(arg_) * mul_; })
#define SSD_PK4(ST, BASE, OUT) do { const unsigned a0 = pkh(SSD_W(ST, BASE + 0), SSD_W(ST, BASE + 1)), a1 = pkh(SSD_W(ST, BASE + 2), SSD_W(ST, BASE + 3)); \
                const unsigned b0 = pkh(SSD_W(ST, BASE + 4), SSD_W(ST, BASE + 5)), b1 = pkh(SSD_W(ST, BASE + 6), SSD_W(ST, BASE + 7)); \
                auto r0 = __builtin_amdgcn_permlane32_swap(a0, b0, false, false); auto r1 = __builtin_amdgcn_permlane32_swap(a1, b1, false, false); \
                u32x4 w = {r0[0], r1[0], r0[1], r1[1]}; OUT = __builtin_bit_cast(f16x8, w); } while (0)
#define SB_ __builtin_amdgcn_sched_barrier(0)
            SB_; SSD_PK4(0, 0, pa[0]); SB_; SSD_PK4(0, 8, pa[1]); SB_; SSD_PK4(1, 0, pa[2]); SB_; SSD_PK4(1, 8, pa[3]); SB_;
            SSD_PK4(2, 0, pa[4]); SB_; SSD_PK4(2, 8, pa[5]); SB_; SSD_PK4(3, 0, pa[6]); SB_; SSD_PK4(3, 8, pa[7]); SB_;
#undef SB_
#undef SSD_PK4
#undef SSD_W
            TP(4);
            f32x16 o[2] = {f32x16{}, f32x16{}};
            const int xb = (int)(unsigned)(uintptr_t)(lds + XS_OFF + hx * 16384) + v_rd_base(lane);
#define SSD_PV(KS) do { const s16x4 l0 = tr_read<(KS) * 2048>(xb), h0 = tr_read<(KS) * 2048 + 1024>(xb), l1 = tr_read<512 + (KS) * 2048>(xb), h1 = tr_read<512 + (KS) * 2048 + 1024>(xb); \
                asm volatile("s_waitcnt lgkmcnt(0)" ::: "memory"); __builtin_amdgcn_sched_barrier(0); \
                o[0] = __builtin_amdgcn_mfma_f32_32x32x16_f16(pa[KS], SSD_FRAG(l0, h0), o[0], 0, 0, 0); o[1] = __builtin_amdgcn_mfma_f32_32x32x16_f16(pa[KS], SSD_FRAG(l1, h1), o[1], 0, 0, 0); } while (0)
            SSD_PV(0); SSD_PV(1); SSD_PV(2); SSD_PV(3); SSD_PV(4); SSD_PV(5); SSD_PV(6); SSD_PV(7);
#undef SSD_PV
            TP(5);
            { const f16 ef = (f16)fast_exp(tl[0]), eb = (f16)fast_exp(tl[1]);
              const f16* sf = Sp + state_index(u.b, u.sc, h, 0) + (size_t)r32 * 128 + hi * 8; const f16* sb = sf + L_ELEMS;
#define SSD_LD(D0, S) do { S[0] = *(const f16x8*)(sf + (D0) * 16); S[1] = *(const f16x8*)(sf + 32 * 128 + (D0) * 16); S[2] = *(const f16x8*)(sb + (D0) * 16); S[3] = *(const f16x8*)(sb + 32 * 128 + (D0) * 16); } while (0)
#define SSD_ST(D0, S) do { const f16x8 af = qr[D0] * ef, ab = qr[D0] * eb; \
                  o[0] = __builtin_amdgcn_mfma_f32_32x32x16_f16(af, S[0], o[0], 0, 0, 0); o[1] = __builtin_amdgcn_mfma_f32_32x32x16_f16(af, S[1], o[1], 0, 0, 0); \
                  o[0] = __builtin_amdgcn_mfma_f32_32x32x16_f16(ab, S[2], o[0], 0, 0, 0); o[1] = __builtin_amdgcn_mfma_f32_32x32x16_f16(ab, S[3], o[1], 0, 0, 0); } while (0)
              f16x8 s0[4], s1[4];
              __builtin_amdgcn_sched_barrier(0);
              SSD_LD(0, s0); SSD_LD(1, s1); __builtin_amdgcn_sched_barrier(0);
              SSD_ST(0, s0); __builtin_amdgcn_sched_barrier(0); SSD_LD(2, s0); __builtin_amdgcn_sched_barrier(0);
              SSD_ST(1, s1); __builtin_amdgcn_sched_barrier(0); SSD_LD(3, s1); __builtin_amdgcn_sched_barrier(0);
              SSD_ST(2, s0); __builtin_amdgcn_sched_barrier(0); SSD_LD(4, s0); __builtin_amdgcn_sched_barrier(0);
              SSD_ST(3, s1); __builtin_amdgcn_sched_barrier(0); SSD_LD(5, s1); __builtin_amdgcn_sched_barrier(0);
              SSD_ST(4, s0); __builtin_amdgcn_sched_barrier(0); SSD_LD(6, s0); __builtin_amdgcn_sched_barrier(0);
              SSD_ST(5, s1); __builtin_amdgcn_sched_barrier(0); SSD_LD(7, s1); __builtin_amdgcn_sched_barrier(0);
              SSD_ST(6, s0); __builtin_amdgcn_sched_barrier(0); SSD_ST(7, s1); __builtin_amdgcn_sched_barrier(0);
#undef SSD_LD
#undef SSD_ST
            }
            TP(6);
            const float dsk = INP(I_SD, l, 16)[h];
            LAS char* tile = lds + BM_OFF + wid * 4096;
            { u32x4 zt[4];
#pragma unroll
              for (int k = 0; k < 4; ++k) { const int ck = lane >> 5, rw = lane & 31;
                  zt[k] = *(const u32x4*)hy::pcp(P, C_SZ + h * 64 + (2 * k + ck) * 8, u.row0 + u.i0 + li * 32 + rw); }
#pragma unroll
              for (int k = 0; k < 4; ++k) { const int ck = lane >> 5, rw = lane & 31; *(LAS u32x4*)(tile + rw * 128 + (2 * k + ck) * 16) = zt[k]; } }
            f16 zr_[16][2], xr_[16][2];
#pragma unroll
            for (int r = 0; r < 16; ++r)
#pragma unroll
                for (int pt = 0; pt < 2; ++pt) { const int p = 32 * pt + r32, lr = li * 32 + crow(r, hi);
                    zr_[r][pt] = *(const LAS f16*)(tile + crow(r, hi) * 128 + p * 2);
                    xr_[r][pt] = *(const LAS f16*)(lds + XS_OFF + hx * 16384 + v_st<2>(lr, p & ~7) + (p & 7) * 2); }
#pragma unroll
            for (int r = 0; r < 16; ++r)
#pragma unroll
                for (int pt = 0; pt < 2; ++pt) { const int p = 32 * pt + r32;
                    const float gv = (o[pt][r] + (float)xr_[r][pt] * dsk) * siluf_((float)zr_[r][pt]);
                    *(LAS unsigned short*)(tile + crow(r, hi) * 128 + p * 2) = (unsigned short)pkb(gv, 0.f); ssacc[r] += gv * gv; }
#pragma unroll
            for (int k = 0; k < 4; ++k) { const int pc = lane + 64 * k, rw = pc >> 3, ck = pc & 7;
                *(u32x4*)(GT + (size_t)(u.row0 + u.i0 + li * 32 + rw) * 1024 + h * 64 + ck * 8) = *(const LAS u32x4*)(tile + rw * 128 + ck * 16); }
            TP(7);
        }
    }
#pragma unroll
    for (int r = 0; r < 16; ++r) { float v = ssacc[r];
#pragma unroll
        for (int o = 1; o < 32; o <<= 1) v += __shfl_xor(v, o);
        if (r32 == 0) ((LAS float*)(lds + SSQ_OFF))[(wid >> 2) * 128 + li * 32 + crow(r, hi)] = v; }
    asm volatile("s_waitcnt vmcnt(0)" ::: "memory");
    __syncthreads();
    { const LAS float* sq = (const LAS float*)(lds + SSQ_OFF);
      u32x4 v[16];
#pragma unroll
      for (int k = 0; k < 16; ++k) { const int e = F.tid + k * NTHREADS; v[k] = *(const u32x4*)(GT + (size_t)(u.row0 + u.i0 + (e >> 6)) * 1024 + u.g * 512 + (e & 63) * 8); }
#pragma unroll
      for (int k = 0; k < 16; ++k) { const int e = F.tid + k * NTHREADS, i = e >> 6, ck = e & 63;
          const float rs = 1.0f / sqrtf((sq[i] + sq[128 + i]) * (1.f / 512.f) + LN_EPS);
          u32x4 w;
#pragma unroll
          for (int j = 0; j < 4; ++j) w[j] = pkb(bf_lo(v[k][j]) * rs, bf_hi(v[k][j]) * rs);
          *(u32x4*)(GT + (size_t)(u.row0 + u.i0 + i) * 1024 + u.g * 512 + ck * 8) = w; } }
    TP(8); TP_END();
}
__device__ __forceinline__ void s3_phase(Frame& F, int l) {
    const int nsc = l == 0 ? 18 : 16, sc0 = l == 0 ? 0 : 2;
    for (int it = F.bid; it < 4 * nsc * 2; it += F.G) { const int b = it / (nsc * 2), q = it % (nsc * 2); F.lane = lane_id_opaque(); F.tid = F.wave * 64 + F.lane; s3_unit(F, make_unit(b, sc0 + (q >> 1), q & 1), l); }
}
#undef SSD_FRAG
}

#ifndef USE_MFMA_GQA
#define USE_MFMA_GQA 1
#endif
#ifndef USE_MFMA_MLA
#define USE_MFMA_MLA 1
#endif
#ifndef USE_MFMA_HY
#define USE_MFMA_HY 1
#endif
#ifndef STAG_TICKS
#define STAG_TICKS 0
#endif
#ifndef STAG_IN
#define STAG_IN 0
#endif
#ifndef DUP
#define DUP 0
#endif
#define REP(k) for (int rep_ = 0; rep_ < ((DUP == (k)) ? 2 : 1); ++rep_)
#ifndef MK_ONE_LAUNCH
#define MK_ONE_LAUNCH 1
#endif
constexpr int PH_PER_LAYER = 7, N_PHASES = 2 + PH_PER_LAYER * DEPTH;
constexpr int CW_BAR = 4096;

__device__ __forceinline__ int opaque_zero() { int v = 0; asm volatile("" : "+v"(v)); return __builtin_amdgcn_readfirstlane(v); }
__device__ __forceinline__ unsigned long long opaque_u64(unsigned long long x) { unsigned lo = (unsigned)x, hi = (unsigned)(x >> 32); asm volatile("" : "+v"(lo), "+v"(hi));
    lo = __builtin_amdgcn_readfirstlane(lo); hi = __builtin_amdgcn_readfirstlane(hi); return ((unsigned long long)hi << 32) | lo; }
__device__ __forceinline__ int dq_next(Frame& F, int qid) {
    LAS int* slot = (LAS int*)(F.lds + MISC_OFF + 64);
    __syncthreads();
    if (F.tid == 0) *slot = (int)__hip_atomic_fetch_add((unsigned*)(F.ws + WS_CTL) + 8192 + 64 * qid, 1u, __ATOMIC_RELAXED, __HIP_MEMORY_SCOPE_AGENT);
    __syncthreads();
    return *slot;
}
__device__ __forceinline__ void mix2_phase(Frame& F, int l) {
    const int nh0 = F.G == 256 ? 112 : 0;
    const int nhl = 512 - nh0, ngl = 0, ngc = 0, nhc = l == 0 ? 512 : 0, ns2 = 256;
    const int total = nhl + ngl + ngc + nhc + ns2;
    for (;;) {
        int it = dq_next(F, l * 4 + 0); if (it >= total) break;
        F.lane = lane_id_opaque(); F.tid = F.wave * 64 + F.lane;
        if (it < nhl) { const int j = it + nh0; hy::hyena_unit(F, l, j >> 7, 0, j & 127); continue; } it -= nhl;
        if (it < ngl) { att::UnitDesc u; u.b = it >> 7; u.h = (it >> 6) & 1; u.qb = (it >> 2) & 15; u.hp = it & 3; u.isctx = 0; att::attn_unit<false>(F, u, l, (LAS char*)F.lds); continue; } it -= ngl;
        if (it < ngc) { att::UnitDesc u; u.b = it >> 4; u.h = (it >> 3) & 1; u.qb = (it >> 2) & 1; u.hp = it & 3; u.isctx = 1; att::attn_unit<false>(F, u, l, (LAS char*)F.lds); continue; } it -= ngc;
        if (it < nhc) { hy::hyena_unit(F, l, it >> 7, 1, it & 127); continue; } it -= nhc;
        ssd::s2_piece(F, it);
    }
}
__device__ __forceinline__ void mix3_phase(Frame& F, int l) {
    const int nsc = l == 0 ? 18 : 16, sc0 = l == 0 ? 0 : 2, n3 = 4 * nsc * 2, nml = 256, nmc = l == 0 ? 32 : 0, ngl = 512, ngc = l == 0 ? 64 : 0;
    const int total = n3 + nml + nmc + ngl + ngc;
    for (;;) {
        int it = dq_next(F, l * 4 + 1); if (it >= total) break;
        F.lane = lane_id_opaque(); F.tid = F.wave * 64 + F.lane;
        if (it < n3) { const int b = it / (nsc * 2), q = it % (nsc * 2); ssd::s3_unit(F, ssd::make_unit(b, sc0 + (q >> 1), q & 1), l); continue; } it -= n3;
        att::UnitDesc u; u.hp = 0;
        if (it < nml + nmc) {
            if (it < nml) { u.b = it >> 6; u.h = (it >> 3) & 7; u.qb = it & 7; u.isctx = 0; } else { const int q = it - nml; u.b = q >> 3; u.h = q & 7; u.qb = 0; u.isctx = 1; }
            att::attn_unit<true>(F, u, l, (LAS char*)F.lds); continue; }
        it -= nml + nmc;
        if (it < ngl) { u.b = it >> 7; u.h = (it >> 6) & 1; u.qb = (it >> 2) & 15; u.hp = it & 3; u.isctx = 0; }
        else { const int q = it - ngl; u.b = q >> 4; u.h = (q >> 3) & 1; u.qb = (q >> 2) & 1; u.hp = q & 3; u.isctx = 1; }
        att::attn_unit<false>(F, u, l, (LAS char*)F.lds);
    }
}
__global__ void __launch_bounds__(NTHREADS, 2) fwd_kernel(Args args) {
    extern __shared__ __attribute__((aligned(16))) unsigned char lds_raw[];
    Frame F;
    F.lds = (LAS unsigned char*)lds_raw; F.ws = args.ws; F.in = args.in; F.out = args.out;
    F.wave = __builtin_amdgcn_readfirstlane((int)threadIdx.x >> 6); F.lane = lane_id_opaque(); F.tid = F.wave * 64 + F.lane;
    F.G = gridDim.x; F.bid = blockIdx.x; F.gw = F.bid * NWAVES + F.wave; F.NGW = F.G * NWAVES; F.zin = 0;
    volatile LAS unsigned* MISC = (volatile LAS unsigned*)(F.lds + MISC_OFF);
    for (int u = F.tid; u < (LDS_BYTES - LDSCTL_OFF) / 4; u += NTHREADS) ((LAS unsigned*)(F.lds + LDSCTL_OFF))[u] = 0u;
    __syncthreads();
    XcdBarrier bar; bar.bar = (unsigned*)(F.ws + WS_CTL) + CW_BAR; bar.x = 0; bar.st = nullptr;
    if (MK_ONE_LAUNCH) bar = xcd_barrier_post((unsigned*)(F.ws + WS_CTL) + CW_BAR, MISC + 8);
    const int lo = args.ph_lo, hi = args.ph_hi;
#define IN_PH(k) (lo <= (k) && (k) < hi)
#define FENCE() do { const int z_ = opaque_zero(); F.lane = lane_id_opaque(); F.tid = F.wave * 64 + F.lane; F.ws += z_; F.zin = z_; } while (0)
#ifdef PHPROBE
    unsigned long long tph_prev = __builtin_amdgcn_s_memrealtime(), tph_val = 0;
#define SEAM(k) do { if (IN_PH(k) && IN_PH((k) + 1)) xcd_barrier(bar); { const unsigned long long n_ = __builtin_amdgcn_s_memrealtime(); if ((k) == PHPROBE) tph_val = n_ - tph_prev; tph_prev = n_; } } while (0)
#else
#define SEAM(k) do { if (IN_PH(k) && IN_PH((k) + 1)) xcd_barrier(bar); } while (0)
#endif

    if (IN_PH(0)) { FENCE(); pa_weights(F); if (DUP == 20) { FENCE(); pa_weights(F); } FENCE(); pa_mod(F); FENCE(); pa_rope(F); FENCE(); pa_filters(F); __syncthreads(); } SEAM(0);
    if (IN_PH(1)) { FENCE(); pb_w8(F); FENCE(); filter_gemm(F); FENCE(); prologue_b(F); } SEAM(1);
#define LAYER_BODY(LL) { constexpr int l = LL; constexpr int base = 2 + PH_PER_LAYER * l; constexpr int mrows = (l == DEPTH - 1) ? NLAT : MROWS; \
        if (IN_PH(base + 0)) { FENCE(); \
            if (STAG_IN > 0) { const int grp = (F.bid >> 3) & 3; \
                if (grp) { const unsigned long long t0 = __builtin_amdgcn_s_memrealtime(); while (__builtin_amdgcn_s_memrealtime() - t0 < (unsigned long long)(grp * STAG_IN)) __builtin_amdgcn_s_sleep(16); } } \
            { typedef pg8::Shape<NGATE, DM / 2, DM / 2, DM / 2, 1, 0, 0, 2> SH8;       \
              pg8::Gemm g8{(const f16*)(F.ws + WS_H8), (const f16*)(F.ws + ws_w8(l))}; \
              pg8::GateOrderL0 S8; S8.init(mrows, F.G, F.bid); \
              EpiGate E8{F.ws + WS_G, WSP(float, WS_HS), WSP(float, WS_CS) + (size_t)l * NGATE}; \
              pg8::gemm_phase<SH8, EpiGate>(F.lds, g8, S8, E8, F.wave); } \
            FENCE(); \
            typedef pg8::Shape<NPAD, DM, DM, DM, 1, 0, 0, IN_BF16 ? 1 : 0> SH; \
            pg8::Gemm g{WSP(f16, WS_H), WSP(f16, WS_WTIN) + (size_t)l * NTOT * DM}; \
            EpiInProj E{WSP(f16, WS_P), WSP(f16, WS_G), WSP(f16, WS_PC)}; \
            if (l == DEPTH - 1) { pg8::POrderL1 S; S.init(NLAT, F.G, F.bid); pg8::gemm_phase<SH, EpiInProj>(F.lds, g, S, E, F.wave); } \
            else { pg8::StaticOrder<NPAD / 256, 1> S; S.init(MROWS, F.G, (F.bid + F.G / 2) % F.G);   \
                   pg8::gemm_phase<SH, EpiInProj>(F.lds, g, S, E, F.wave); } } \
        SEAM(base + 0); \
        if (IN_PH(base + 1)) { FENCE(); prep_naive(F, l); FENCE(); ssd::s1_phase(F, l); \
            if (F.G == 256 && F.bid >= 144) { FENCE(); hy::hyena_unit(F, l, (F.bid - 144) >> 7, 0, (F.bid - 144) & 127); } }   \
        SEAM(base + 1); \
        if (IN_PH(base + 2)) { FENCE(); \
            { typedef pg8::Shape<1536, 512, NPAD, 512, 1, 0, 0> SH; \
              pg8::Gemm g{WSP(f16, WS_P) + C_CQ, WSP(f16, WS_WTUQ) + (size_t)l * 1536 * 512}; \
                \
              pg8::StaticOrder<6, 1> S; if (F.G == 256) S.init(mrows, 112, F.bid - 144); else S.init(mrows, F.G, F.bid); \
              EpiRowScale E{WSP(f16, WS_QM), 1536, WSP(float, WS_RS)}; \
              if (F.G != 256 || F.bid >= 144) pg8::gemm_phase<SH, EpiRowScale>(F.lds, g, S, E, F.wave); } \
            FENCE(); \
            { typedef pg8::Shape<2048, 256, NPAD, 256, 1, 0, 0> SH; \
              pg8::Gemm g{WSP(f16, WS_P) + C_CKV, WSP(f16, WS_WTUKV) + (size_t)l * 2048 * 256}; \
              pg8::StaticOrder<8, 1> S; if (F.G == 256) S.init(MROWS, 112, (F.bid - 144 + 56) % 112); else S.init(MROWS, F.G, (F.bid + 128) % F.G); \
              EpiRowScale E{WSP(f16, WS_KVM), 2048, WSP(float, WS_RS) + MROWS}; \
              if (F.G != 256 || F.bid >= 144) pg8::gemm_phase<SH, EpiRowScale>(F.lds, g, S, E, F.wave); } \
            FENCE(); mix2_phase(F, l); } \
        SEAM(base + 2); \
        if (IN_PH(base + 3)) { FENCE(); mix3_phase(F, l); } \
        SEAM(base + 3); \
        if (IN_PH(base + 4)) { FENCE(); \
            if (STAG_TICKS > 0) { const int grp = (F.bid >> 3) & 3;        \
                if (grp) { const unsigned long long t0 = __builtin_amdgcn_s_memrealtime(); while (__builtin_amdgcn_s_memrealtime() - t0 < (unsigned long long)(grp * STAG_TICKS)) __builtin_amdgcn_s_sleep(16); } } \
            typedef pg8::Shape<DM, 1024, 1024, 1024, 4, (long)MROWS * 1024, (long)DM * 1024, 1> SH;     \
            pg8::Gemm g{WSP(f16, WS_GATED), WSP(f16, WS_WTBR) + (size_t)l * 4 * DM * 1024}; \
            pg8::StaticOrder<8, 4> S; S.init(NLAT, F.G, F.bid); \
            EpiMerge E{F.ws + WS_G, WSP(f16, WS_MIX)}; \
            pg8::gemm_phase<SH, EpiMerge>(F.lds, g, S, E, F.wave); \
            if (l == 0) { FENCE(); pg8::TailOrder T; T.init(F.G, F.bid, 0, 128); \
                EpiMergeSlab EA{F.ws + WS_G, (f16*)(F.ws + WS_SA)}; \
                pg8::gemm_phase<SH, EpiMergeSlab>(F.lds, g, T, EA, F.wave); \
                if (MK_ONE_LAUNCH) xcd_barrier(bar);               \
                FENCE(); merge_ctx_reduce(F); } } \
        SEAM(base + 4); \
        if (IN_PH(base + 5)) { FENCE(); \
            typedef pg8::Shape<DM, DM, DM, DM, 1, 0, 0, 1> SH;     \
            pg8::Gemm g{WSP(f16, WS_MIX), WSP(f16, WS_WTOUT) + (size_t)l * DM * DM}; \
            pg8::StaticOrder<8, 1> S; S.init(NLAT, F.G, F.bid); \
            EpiOut<(l > 0)> E{l == 0 ? (const void*)F.in[F.zin + I_X] : (const void*)WSP(f16, WS_X1), l == 0 ? (const void*)F.in[F.zin + I_CTX] : (const void*)(WSP(f16, WS_X1) + (size_t)NLAT * DM), WSP(float, WS_MOD) + (size_t)l * 5 * 6144, WSP(f16, WS_Y) + (size_t)MROWS * DM}; \
            pg8::gemm_phase<SH, EpiOut<(l > 0)> >(F.lds, g, S, E, F.wave); \
            if (l == 0) { FENCE(); typedef pg8::Shape<DM, 512, DM, DM, 4, 512, 512, 1> SHQ; pg8::TailOrder T; T.init(F.G, F.bid, 128, 128); \
                EpiOutSlab EA{WSP(float, WS_MOD) + (size_t)l * 5 * 6144, (f16*)(F.ws + WS_SA) + (size_t)4 * NCTX * DM}; \
                pg8::gemm_phase<SHQ, EpiOutSlab>(F.lds, g, T, EA, F.wave); } } \
        SEAM(base + 5); \
        if (IN_PH(base + 6)) { FENCE(); ln_phase(F, l); if (DUP == 9) { FENCE(); ln_phase(F, l); } } \
        SEAM(base + 6); }
    LAYER_BODY(0)
    LAYER_BODY(1)
#undef LAYER_BODY
#ifdef PHPROBE
    xcd_barrier(bar);
    if (F.bid == 0 && F.tid == 0) F.out[0] += ((float)tph_val * 0.01f - (float)PHBASE) * 0.125f;
#endif
#ifdef TPROBE
    xcd_barrier(bar);
    if (F.bid == 0 && F.tid == 0) { const unsigned* tm = (const unsigned*)(F.ws + WS_CTL) + 32768; const float us = (float)__hip_atomic_load(tm, __ATOMIC_RELAXED, __HIP_MEMORY_SCOPE_AGENT) * 0.01f / (float)__hip_atomic_load(tm + 15, __ATOMIC_RELAXED, __HIP_MEMORY_SCOPE_AGENT); F.out[0] += us * 0.125f; }
#endif
#undef IN_PH
#undef SEAM
}

extern "C" void kernel_launch(void* const* d_in, const int* in_sizes, int n_in, void* d_out, int out_size, void* d_ws, size_t ws_size, hipStream_t stream) {
    static int grid = 0;
    if (grid == 0) {
        if (n_in != N_IN || out_size != NLAT * DM || ws_size < WS_END) { fprintf(stderr, "kernel_launch: unexpected shapes: n_in %d out %d ws %zu (need %zu)\n", n_in, out_size, ws_size, (size_t)WS_END); grid = -1; return; }
        int dev = 0, cus = 0, per_cu = 0;
        if (hipGetDevice(&dev) != hipSuccess || hipDeviceGetAttribute(&cus, hipDeviceAttributeMultiprocessorCount, dev) != hipSuccess) { grid = -1; return; }
        if (hipFuncSetAttribute((const void*)fwd_kernel, hipFuncAttributeMaxDynamicSharedMemorySize, LDS_BYTES) != hipSuccess) { fprintf(stderr, "kernel_launch: hipFuncSetAttribute failed\n"); grid = -1; return; }
        if (hipOccupancyMaxActiveBlocksPerMultiprocessor(&per_cu, (const void*)fwd_kernel, NTHREADS, LDS_BYTES) != hipSuccess || per_cu < 1) { fprintf(stderr, "kernel_launch: occupancy query says %d blocks per CU\n", per_cu); (void)hipGetLastError(); grid = -1; return; }
        grid = cus;
    }
    if (grid < 0) return;
    (void)hipMemsetAsync((char*)d_ws + WS_CTL, 0, CTL_BYTES, stream);
    Args a{};
    for (int i = 0; i < N_IN; ++i) a.in[i] = (const float*)d_in[i];
    a.out = (float*)d_out; a.ws = (unsigned char*)d_ws;
#if MK_ONE_LAUNCH
    a.ph_lo = 0; a.ph_hi = N_PHASES;
    hipLaunchKernelGGL(fwd_kernel, dim3(grid), dim3(NTHREADS), LDS_BYTES, stream, a);
#else
    for (int ph = 0; ph < N_PHASES; ++ph) { a.ph_lo = ph; a.ph_hi = ph + 1; hipLaunchKernelGGL(fwd_kernel, dim3(grid), dim3(NTHREADS), LDS_BYTES, stream, a); }
#endif
}
```
